# Optimizing an MI355X kernel written in HIP

```python
import math
import jax
import jax.numpy as jnp
from jax import lax
import numpy as np

D_MODEL = 1024
BATCH = 2
SEQ = 16384
DEPTH = 2

GRID_W = 64
CTX_LEN = 256
N_BRANCH = 3
BRANCH_WIDTH = D_MODEL // 2
POOL_WINDOWS = (2, 4, 8, 16)
POOL_GROUPS = len(POOL_WINDOWS)
POOL_GROUP_DIM = BRANCH_WIDTH // POOL_GROUPS
DIFF_HEAD_DIM = 64
DIFF_HEADS = BRANCH_WIDTH // (2 * DIFF_HEAD_DIM)
DIFF_V_DIM = 2 * DIFF_HEAD_DIM
DIFF_QK_WIDTH = DIFF_HEADS * 2 * DIFF_HEAD_DIM
DIFF_V_WIDTH = DIFF_HEADS * DIFF_V_DIM
ROPE_AXIS_FREQS = DIFF_HEAD_DIM // 4
ROPE_THETA = 10000.0
Q_BLOCK = 128
RWKV_HEAD = 64
RWKV_HEADS = BRANCH_WIDTH // RWKV_HEAD
RWKV_WIDTH = RWKV_HEADS * RWKV_HEAD
DECAY_LORA = 64
AAA_LORA = 64
GATE_LORA = 128
RWKV_SPLITS = (RWKV_WIDTH, RWKV_WIDTH, RWKV_WIDTH, 2 * DECAY_LORA, 2 * AAA_LORA, GATE_LORA)
RWKV_IN = 3 * RWKV_WIDTH + 2 * DECAY_LORA + 2 * AAA_LORA + GATE_LORA
IN_SPLITS = (BRANCH_WIDTH, DIFF_QK_WIDTH, DIFF_QK_WIDTH, DIFF_V_WIDTH, RWKV_IN, N_BRANCH * D_MODEL)
IN_WIDTH = BRANCH_WIDTH + 2 * DIFF_QK_WIDTH + DIFF_V_WIDTH + RWKV_IN + N_BRANCH * D_MODEL
N_GROUPS = 4
EXPERTS_PER_GROUP = 8
N_EXPERTS = N_GROUPS * EXPERTS_PER_GROUP
TOP_K = 2
EXPERT_FF = D_MODEL // 2
MOE_BLOCK = 128
N_MOD = 6
NORM_EPS = 1e-6
GN_EPS = 64e-5

kernel_name = 'hybrid_pool_diffattn_rwkv7_hmoe_dit'


def split_cols(p, sizes):
    return jnp.split(p, [int(s) for s in np.cumsum(sizes)[:-1]], axis=-1)


def rms_norm(x, g):
    xf = x.astype(jnp.float32)
    y = xf * lax.rsqrt(jnp.mean(xf * xf, axis=-1, keepdims=True) + NORM_EPS)
    return (y * g.astype(jnp.float32)).astype(x.dtype)


def modulate(x, g, shift, scale):
    return rms_norm(x, g) * (1 + scale) + shift


def centred_window_mean(u, win):
    L = u.shape[1]
    cs = jnp.pad(jnp.cumsum(u.astype(jnp.float32), axis=1), ((0, 0), (1, 0), (0, 0)))
    t = jnp.arange(L)
    lo = jnp.clip(t - win // 2, 0, L - 1)
    hi = jnp.clip(t + win // 2 - 1, 0, L - 1)
    cnt = (hi - lo + 1).astype(jnp.float32)
    return (cs[:, hi + 1] - cs[:, lo]) / cnt[None, :, None]


def pool_mixer(u, w_pool, pool_scale):
    B, L, _ = u.shape
    ug = u.reshape(B, L, POOL_GROUPS, POOL_GROUP_DIM)
    pooled = jnp.stack([centred_window_mean(ug[:, :, i], w) for i, w in enumerate(POOL_WINDOWS)], axis=2)
    diff = pooled.astype(u.dtype) - ug
    y = jnp.einsum('blgc,gcd->blgd', diff, w_pool)
    return y.reshape(B, L, BRANCH_WIDTH) * pool_scale


def rope_rotate(u, ang):
    u1, u2 = jnp.split(u, 2, axis=-1)
    cs = jnp.cos(ang).astype(u.dtype)
    sn = jnp.sin(ang).astype(u.dtype)
    return jnp.concatenate([u1 * cs - u2 * sn, u2 * cs + u1 * sn], axis=-1)


def axial_rope(x, ang_r, ang_c):
    xr, xc = jnp.split(x, 2, axis=-1)
    ar = ang_r[None, :, None, None, :]
    ac = ang_c[None, :, None, None, :]
    return jnp.concatenate([rope_rotate(xr, ar), rope_rotate(xc, ac)], axis=-1)


def diff_qkv(pq, pk, pv, qn_g, kn_g):
    B, L, _ = pq.shape
    q = rms_norm(pq.reshape(B, L, DIFF_HEADS, 2, DIFF_HEAD_DIM), qn_g)
    k = rms_norm(pk.reshape(B, L, DIFF_HEADS, 2, DIFF_HEAD_DIM), kn_g)
    v = pv.reshape(B, L, DIFF_HEADS, DIFF_V_DIM)
    return q, k, v


def diff_attn_block(qb, keys, vals, lam):
    s = jnp.einsum('bqhmd,bkhmd->bhmqk', qb, keys).astype(jnp.float32) * (DIFF_HEAD_DIM ** -0.5)
    p = jax.nn.softmax(s, axis=-1)
    a = p[:, :, 0] - lam * p[:, :, 1]
    return jnp.einsum('bhqk,bkhv->bqhv', a.astype(vals.dtype), vals)


def diff_attn_latent(q, keys, vals, lam):
    B, L = q.shape[:2]
    nb = L // Q_BLOCK
    qb = jnp.moveaxis(q.reshape(B, nb, Q_BLOCK, DIFF_HEADS, 2, DIFF_HEAD_DIM), 1, 0)
    out = lax.map(lambda blk: diff_attn_block(blk, keys, vals, lam), qb)
    return jnp.moveaxis(out, 0, 1).reshape(B, L, DIFF_HEADS, DIFF_V_DIM)


def diff_post(o, subln_g, lam_init):
    B, L = o.shape[:2]
    return (rms_norm(o, subln_g) * (1 - lam_init)).reshape(B, L, DIFF_V_WIDTH)


def token_shift_centred(u, mu):
    prev = jnp.pad(u, ((0, 0), (1, 0), (0, 0)))[:, :-1]
    nxt = jnp.pad(u, ((0, 0), (0, 1), (0, 0)))[:, 1:]
    return u + (prev - u) * mu[0] + (nxt - u) * mu[1]


def rwkv_prepare(pr, shift_mu, w0, w2, a0, a2, g2, k_k, k_a):
    B, L, _ = pr.shape
    u = token_shift_centred(pr, shift_mu)
    r, k, v, wl, al, gl = split_cols(u, RWKV_SPLITS)
    wl = wl.reshape(B, L, 2, DECAY_LORA)
    al = al.reshape(B, L, 2, AAA_LORA)
    w_log = -jax.nn.softplus(-(w0 + jnp.einsum('bldr,drc->bldc', jnp.tanh(wl), w2))) - 0.5
    decay = jnp.exp(-jnp.exp(w_log.astype(jnp.float32)))
    a = jax.nn.sigmoid(a0 + jnp.einsum('bldr,drc->bldc', al, a2))
    g = jax.nn.sigmoid(gl) @ g2
    kk = (k * k_k).reshape(B, L, RWKV_HEADS, RWKV_HEAD).astype(jnp.float32)
    kk = kk / jnp.maximum(jnp.sqrt(jnp.sum(kk * kk, axis=-1, keepdims=True)), 1e-12)
    kk = kk.reshape(B, L, RWKV_WIDTH).astype(k.dtype)
    k_mod = k[:, :, None] * (1 + (a - 1) * k_a)
    b_vec = kk[:, :, None] * a
    return r, k_mod, v, decay, -kk, b_vec, g


def to_scan(u):
    B, L = u.shape[:2]
    u = jnp.stack([u[:, :, 0], jnp.flip(u[:, :, 1], axis=1)], axis=0)
    return jnp.moveaxis(u.reshape(2, B, L, RWKV_HEADS, RWKV_HEAD), 2, 0).astype(jnp.float32)


def wkv_step(S, inp):
    r, w, k, v, a, b = inp
    sa = jnp.einsum('dbhvk,dbhk->dbhv', S, a)
    S = S * w[..., None, :] + sa[..., None] * b[..., None, :] + v[..., None] * k[..., None, :]
    return S, jnp.einsum('dbhvk,dbhk->dbhv', S, r)


def wkv_bidir(S0, r, k_mod, v, decay, a_vec, b_vec):
    B, L, C = r.shape
    both = lambda u: jnp.broadcast_to(u[:, :, None], (B, L, 2, C))
    xs = tuple(to_scan(u) for u in (both(r), decay, k_mod, both(v), both(a_vec), b_vec))
    S, ys = lax.scan(wkv_step, S0, xs)
    y = ys[:, 0] + jnp.flip(ys[:, 1], axis=0)
    return S, jnp.moveaxis(y, 0, 1)


def rwkv_output(y, prep, r_k, gn_w, gn_b):
    r, k_mod, v, g = prep[0], prep[1], prep[2], prep[6]
    B, L, _ = r.shape
    mu = jnp.mean(y, axis=-1, keepdims=True)
    var = jnp.mean(jnp.square(y - mu), axis=-1, keepdims=True)
    yn = ((y - mu) * lax.rsqrt(var + GN_EPS)).reshape(B, L, RWKV_WIDTH) * gn_w + gn_b
    coef = jnp.sum((r[:, :, None] * k_mod * r_k.reshape(-1)).reshape(B, L, 2, RWKV_HEADS, RWKV_HEAD), axis=(2, 4))
    bonus = (coef[..., None] * v.reshape(B, L, RWKV_HEADS, RWKV_HEAD)).reshape(B, L, RWKV_WIDTH)
    return (yn.astype(r.dtype) + bonus) * g


def merge_branches(branches, gates, w_br, w_out):
    B, L, _ = gates.shape
    g = jax.nn.sigmoid(gates.reshape(B, L, N_BRANCH, D_MODEL))
    merged = g[:, :, 0] * (branches[0] @ w_br[0])
    for n in range(1, N_BRANCH):
        merged = merged + g[:, :, n] * (branches[n] @ w_br[n])
    return merged @ w_out


def expert_dispatch(h, eid, gates, w_g, w_u, w_d):
    T, D = h.shape
    A = T * TOP_K
    flat_e = eid.reshape(A)
    flat_tok = jnp.repeat(jnp.arange(T, dtype=jnp.int32), TOP_K)
    order = jnp.argsort(flat_e)
    e_sorted = flat_e[order]
    counts = jnp.bincount(flat_e, length=N_EXPERTS)
    padded = (counts + MOE_BLOCK - 1) // MOE_BLOCK * MOE_BLOCK
    start = jnp.cumsum(counts) - counts
    pend = jnp.cumsum(padded)
    pstart = pend - padded
    slot = pstart[e_sorted] + jnp.arange(A, dtype=jnp.int32) - start[e_sorted]
    P = -(-A // MOE_BLOCK) * MOE_BLOCK + N_EXPERTS * MOE_BLOCK
    n_blk = P // MOE_BLOCK
    slot_tok = jnp.full((P,), T, jnp.int32).at[slot].set(flat_tok[order])
    slot_gate = jnp.zeros((P,), h.dtype).at[slot].set(gates.reshape(A)[order])
    blk_e = jnp.minimum(jnp.searchsorted(pend, jnp.arange(n_blk, dtype=jnp.int32) * MOE_BLOCK, side='right'), N_EXPERTS - 1)
    xb = jnp.concatenate([h, jnp.zeros((1, D), h.dtype)], axis=0)[slot_tok].reshape(n_blk, MOE_BLOCK, D)

    def block_ffn(args):
        xblk, e = args
        return (jax.nn.silu(xblk @ w_g[e]) * (xblk @ w_u[e])) @ w_d[e]

    yb = lax.map(block_ffn, (xb, blk_e)).reshape(P, D)
    return jax.ops.segment_sum(yb * slot_gate[:, None], slot_tok, num_segments=T + 1)[:T]


def hier_moe(h, w_rg, w_re, w_g, w_u, w_d):
    T = h.shape[0]
    lg = (h @ w_rg).astype(jnp.float32)
    grp = jnp.argmax(lg, axis=-1)
    p_grp = jnp.take_along_axis(jax.nn.softmax(lg, axis=-1), grp[:, None], axis=-1)
    le = (h @ w_re).astype(jnp.float32).reshape(T, N_GROUPS, EXPERTS_PER_GROUP)
    le = jnp.take_along_axis(le, grp[:, None, None], axis=1)[:, 0]
    top_v, top_i = lax.top_k(le, TOP_K)
    gates = p_grp * jax.nn.softmax(top_v, axis=-1)
    eid = (grp[:, None] * EXPERTS_PER_GROUP + top_i).astype(jnp.int32)
    return expert_dispatch(h, eid, gates.astype(h.dtype), w_g, w_u, w_d)


def setup_inputs(seed: int = 0) -> dict:
    key = jax.random.key(seed)
    keys = jax.random.split(key, 40)
    cnt = [0]

    def nk():
        cnt[0] += 1
        return keys[cnt[0] - 1]

    def nrm(shape, scale):
        return scale * jax.random.normal(nk(), shape, jnp.float32)

    def uni(shape, lo, hi):
        return jax.random.uniform(nk(), shape, jnp.float32, lo, hi)

    D = D_MODEL
    return {
        'x': nrm((BATCH, SEQ, D), 1.0),
        'c': nrm((BATCH, D), 1.0),
        'ctx': nrm((BATCH, CTX_LEN, D), 1.0),
        'c_ctx': nrm((D,), 1.0),
        'w_ada': nrm((DEPTH, D, N_MOD * D), 0.5 * D ** -0.5),
        'b_ada': nrm((DEPTH, N_MOD * D), 0.02),
        'norm1_g': 1.0 + nrm((DEPTH, D), 0.05),
        'norm2_g': 1.0 + nrm((DEPTH, D), 0.05),
        'w_in': nrm((DEPTH, D, IN_WIDTH), D ** -0.5),
        'pool_w': nrm((DEPTH, POOL_GROUPS, POOL_GROUP_DIM, POOL_GROUP_DIM), POOL_GROUP_DIM ** -0.5),
        'pool_scale': 1.0 + nrm((DEPTH, BRANCH_WIDTH), 0.1),
        'q_norm_g': 1.0 + nrm((DEPTH, DIFF_HEAD_DIM), 0.05),
        'k_norm_g': 1.0 + nrm((DEPTH, DIFF_HEAD_DIM), 0.05),
        'lambda_qk': nrm((DEPTH, 4, DIFF_HEAD_DIM), 0.1),
        'subln_g': 1.0 + nrm((DEPTH, DIFF_V_DIM), 0.05),
        'shift_mu': uni((DEPTH, 2, RWKV_IN), 0.0, 0.5),
        'decay_w0': uni((DEPTH, 2, RWKV_WIDTH), -4.0, 1.0),
        'decay_w2': nrm((DEPTH, 2, DECAY_LORA, RWKV_WIDTH), 0.5 * DECAY_LORA ** -0.5),
        'aaa_a0': nrm((DEPTH, 2, RWKV_WIDTH), 0.5),
        'aaa_a2': nrm((DEPTH, 2, AAA_LORA, RWKV_WIDTH), 0.5 * AAA_LORA ** -0.5),
        'gate_w2': nrm((DEPTH, GATE_LORA, RWKV_WIDTH), GATE_LORA ** -0.5),
        'k_k': 0.85 + nrm((DEPTH, RWKV_WIDTH), 0.1),
        'k_a': 1.0 + nrm((DEPTH, RWKV_WIDTH), 0.1),
        'r_k': nrm((DEPTH, RWKV_HEADS, RWKV_HEAD), 0.1),
        'gn_w': 1.0 + nrm((DEPTH, RWKV_WIDTH), 0.05),
        'gn_b': nrm((DEPTH, RWKV_WIDTH), 0.02),
        'w_br': nrm((DEPTH, N_BRANCH, BRANCH_WIDTH, D), BRANCH_WIDTH ** -0.5),
        'w_out': nrm((DEPTH, D, D), D ** -0.5),
        'w_router_group': nrm((DEPTH, D, N_GROUPS), D ** -0.5),
        'w_router_expert': nrm((DEPTH, D, N_EXPERTS), D ** -0.5),
        'w_exp_gate': nrm((DEPTH, N_EXPERTS, D, EXPERT_FF), D ** -0.5),
        'w_exp_up': nrm((DEPTH, N_EXPERTS, D, EXPERT_FF), D ** -0.5),
        'w_exp_down': nrm((DEPTH, N_EXPERTS, EXPERT_FF, D), EXPERT_FF ** -0.5),
    }


def reference(x, c, ctx, c_ctx, w_ada, b_ada, norm1_g, norm2_g, w_in, pool_w, pool_scale, q_norm_g, k_norm_g,
              lambda_qk, subln_g, shift_mu, decay_w0, decay_w2, aaa_a0, aaa_a2, gate_w2, k_k, k_a, r_k, gn_w, gn_b,
              w_br, w_out, w_router_group, w_router_expert, w_exp_gate, w_exp_up, w_exp_down):
    B, L, D = x.shape
    C = ctx.shape[1]
    rows = L // GRID_W
    row_idx = jnp.repeat(jnp.arange(rows), GRID_W).astype(jnp.float32)
    col_idx = jnp.tile(jnp.arange(GRID_W), rows).astype(jnp.float32)
    inv_freq = ROPE_THETA ** (-jnp.arange(ROPE_AXIS_FREQS, dtype=jnp.float32) / ROPE_AXIS_FREQS)
    ang_r = row_idx[:, None] * inv_freq
    ang_c = col_idx[:, None] * inv_freq
    s_lat = jax.nn.silu(c)
    s_ctx = jax.nn.silu(c_ctx)
    S0 = jnp.zeros((2, B, RWKV_HEADS, RWKV_HEAD, RWKV_HEAD), jnp.float32)

    for l in range(DEPTH):
        last = l == DEPTH - 1
        mod = (s_lat @ w_ada[l] + b_ada[l]).reshape(B, N_MOD, 1, D)
        mod_c = (s_ctx @ w_ada[l] + b_ada[l]).reshape(N_MOD, 1, 1, D)

        p_l = modulate(x, norm1_g[l], mod[:, 0], mod[:, 1]) @ w_in[l]
        p_c = modulate(ctx, norm1_g[l], mod_c[0], mod_c[1]) @ w_in[l]
        pool_l, q_l, k_l, v_l, rw_l, gate_l = split_cols(p_l, IN_SPLITS)
        pool_c, q_c, k_c, v_c, rw_c, gate_c = split_cols(p_c, IN_SPLITS)

        lam_init = 0.8 - 0.6 * math.exp(-0.3 * l)
        lq = lambda_qk[l].astype(jnp.float32)
        lam = jnp.exp(jnp.sum(lq[0] * lq[1])) - jnp.exp(jnp.sum(lq[2] * lq[3])) + lam_init
        qh_l, kh_l, vh_l = diff_qkv(q_l, k_l, v_l, q_norm_g[l], k_norm_g[l])
        qh_l = axial_rope(qh_l, ang_r, ang_c)
        kh_l = axial_rope(kh_l, ang_r, ang_c)
        qh_c, kh_c, vh_c = diff_qkv(q_c, k_c, v_c, q_norm_g[l], k_norm_g[l])
        keys = jnp.concatenate([kh_c, kh_l], axis=1)
        vals = jnp.concatenate([vh_c, vh_l], axis=1)
        att_l = diff_post(diff_attn_latent(qh_l, keys, vals, lam), subln_g[l], lam_init)

        rw_par = (shift_mu[l], decay_w0[l], decay_w2[l], aaa_a0[l], aaa_a2[l], gate_w2[l], k_k[l], k_a[l])
        prep_c = rwkv_prepare(rw_c, *rw_par)
        S_c, y_c = wkv_bidir(S0, *prep_c[:6])
        prep_l = rwkv_prepare(rw_l, *rw_par)
        _, y_l = wkv_bidir(S_c, *prep_l[:6])
        rwo_l = rwkv_output(y_l, prep_l, r_k[l], gn_w[l], gn_b[l])

        mix_l = merge_branches((pool_mixer(pool_l, pool_w[l], pool_scale[l]), att_l, rwo_l), gate_l, w_br[l], w_out[l])
        x = x + mod[:, 2] * mix_l
        if not last:
            att_c = diff_post(diff_attn_block(qh_c, kh_c, vh_c, lam), subln_g[l], lam_init)
            rwo_c = rwkv_output(y_c, prep_c, r_k[l], gn_w[l], gn_b[l])
            mix_c = merge_branches((pool_mixer(pool_c, pool_w[l], pool_scale[l]), att_c, rwo_c), gate_c, w_br[l], w_out[l])
            ctx = ctx + mod_c[2] * mix_c

        moe_par = (w_router_group[l], w_router_expert[l], w_exp_gate[l], w_exp_up[l], w_exp_down[l])
        f_l = modulate(x, norm2_g[l], mod[:, 3], mod[:, 4]).reshape(B * L, D)
        if last:
            x = x + mod[:, 5] * hier_moe(f_l, *moe_par).reshape(B, L, D)
        else:
            f_c = modulate(ctx, norm2_g[l], mod_c[3], mod_c[4]).reshape(B * C, D)
            y = hier_moe(jnp.concatenate([f_c, f_l], axis=0), *moe_par)
            ctx = ctx + mod_c[5] * y[:B * C].reshape(B, C, D)
            x = x + mod[:, 5] * y[B * C:].reshape(B, L, D)
    return x
```

```cpp
#include <hip/hip_runtime.h>
#include <stdint.h>
#include <stdio.h>
#include <stddef.h>
#include <utility>

#ifndef MK_ONE_LAUNCH
#define MK_ONE_LAUNCH 1
#endif
#ifndef EN_MOE
#define EN_MOE 1
#endif
#ifndef EN_LAYERS
#define EN_LAYERS 2
#endif

#define LAS __attribute__((address_space(3)))
#define DI __device__ __forceinline__
typedef unsigned short bf16_t;
typedef short bf16x8 __attribute__((ext_vector_type(8)));
typedef float f32x4 __attribute__((ext_vector_type(4)));
typedef float f32x2 __attribute__((ext_vector_type(2)));
typedef float f32x16 __attribute__((ext_vector_type(16)));
typedef unsigned u32x4 __attribute__((ext_vector_type(4)));
typedef unsigned u32x2 __attribute__((ext_vector_type(2)));
typedef __bf16 bfv2 __attribute__((ext_vector_type(2)));

constexpr int DM = 1024, NB = 2, SEQ = 16384, CTXL = 256, NCTX = NB * CTXL  , MROWS = NCTX + NB * SEQ  ;
constexpr int NPAN = MROWS / 256;
constexpr int IN_W = 7040, N_INP = 4096  , N_GATE = 3072, N_INT = N_INP + N_GATE  ;
constexpr int RW_IN = 1920, LORA_K = 384, LORA_N = 2560;
constexpr int NEXP = 32, FF = 512;
constexpr int PMAX = 74752;
constexpr int KEYS = CTXL + SEQ;
constexpr size_t U_EL = (size_t)MROWS * 512;
constexpr size_t U_B = U_EL * 2;
constexpr size_t OFF_CTL = 0, OFF_MOD = 65536, OFF_CTX = 327680, OFF_WIN = 2424832, OFF_WMG = 17104896, OFF_WOUT = 20250624, OFF_WLORA = 22347776, OFF_WRT = 24313856;
constexpr size_t R1 = 25165824, R2 = R1 + 4 * U_B, R3 = R2 + 5 * U_B, R4 = R3 + 4 * U_B, R6 = R4 + 2 * U_B, RVT = R6 + 2 * U_B, WS_END = RVT + U_B;
constexpr size_t OFF_POOL = R1, OFF_Q = R1 + U_B, OFF_K = R1 + 2 * U_B, OFF_V = R1 + 3 * U_B;
constexpr size_t OFF_RWRAW = R2, OFF_EF = R2, OFF_EB = R2 + U_B, OFF_AF = R2 + 2 * U_B, OFF_AB = R2 + 3 * U_B, OFF_GG = R2 + 4 * U_B;
constexpr size_t OFF_RR = R3, OFF_RK = R3 + U_B, OFF_RV = R3 + 2 * U_B, OFF_RKK = R3 + 3 * U_B;
constexpr size_t OFF_YF = R4, OFF_YB = R4 + U_B;
constexpr size_t OFF_MP = R1 + U_B;
constexpr size_t OFF_NS = R6 + U_B;
constexpr int NCHUNK = KEYS / 64;
constexpr size_t OFF_PDIFF = R6, OFF_ALORA = R6 + U_B, OFF_XN = R6;
constexpr size_t OFF_XN2 = R1 + 2 * U_B;
constexpr size_t OFF_G = R2;
constexpr size_t OFF_MERGED = R3 + U_B;
constexpr size_t OFF_WE1 = R3, OFF_WE2 = R3 + (size_t)NEXP * 1024 * 1024 * 2;
constexpr size_t OFF_XB = R1, OFF_ACT = R1 + (size_t)PMAX * 2048, OFF_YBUF = R1;
constexpr size_t OFF_LOGITS = R4, OFF_ROUTE = R4 + (size_t)MROWS * 64 * 4, OFF_SLOTTOK = OFF_ROUTE + (size_t)MROWS * 32;
constexpr int CW_BAR = 0, CW_CNT = 4096, CW_CUR = 4096 + 64, CW_END = 4096 + 128;
constexpr int LDS_BYTES = 151552, MISC_OFF = 147456;

DI int launder(int x) { asm volatile("" : "+v"(x)); return x; }
DI int lane_id() { return (int)__builtin_amdgcn_mbcnt_hi(~0u, __builtin_amdgcn_mbcnt_lo(~0u, 0u)); }
DI float bf2f(bf16_t v) { return __uint_as_float(((unsigned)v) << 16); }
DI unsigned pk2(float lo, float hi) { f32x2 v = {lo, hi}; bfv2 r = __builtin_convertvector(v, bfv2); return __builtin_bit_cast(unsigned, r); }
DI bf16_t f2bf(float f) { return (bf16_t)(pk2(f, 0.f) & 0xffffu); }
DI float lo_f(unsigned w) { return __uint_as_float(w << 16); }
DI float hi_f(unsigned w) { return __uint_as_float(w & 0xffff0000u); }
DI void unpack8(const u32x4 w, float (&f)[8]) { f[0] = lo_f(w.x); f[1] = hi_f(w.x); f[2] = lo_f(w.y); f[3] = hi_f(w.y); f[4] = lo_f(w.z); f[5] = hi_f(w.z); f[6] = lo_f(w.w); f[7] = hi_f(w.w); }
DI u32x4 pack8(const float (&f)[8]) { u32x4 w; w.x = pk2(f[0], f[1]); w.y = pk2(f[2], f[3]); w.z = pk2(f[4], f[5]); w.w = pk2(f[6], f[7]); return w; }
DI float sigmoidf_(float x) { return __builtin_amdgcn_rcpf(1.0f + __expf(-x)); }
DI float wave_sum(float v) { v += __shfl_xor(v, 1); v += __shfl_xor(v, 2); v += __shfl_xor(v, 4); v += __shfl_xor(v, 8); v += __shfl_xor(v, 16); v += __shfl_xor(v, 32); return v; }
DI float sum8(float v) { v += __shfl_xor(v, 1); v += __shfl_xor(v, 2); v += __shfl_xor(v, 4); return v; }
template <int CTRL> DI float dppf(float v) { return __builtin_bit_cast(float, __builtin_amdgcn_update_dpp(0, __builtin_bit_cast(int, v), CTRL, 0xf, 0xf, true)); }
DI float allsum16(float v) { v += dppf<0xB1>(v); v += dppf<0x4E>(v); v += dppf<0x141>(v); v += dppf<0x140>(v); return v; }

#define XB_TMO      128
#define XB_XCNT(j)  (256  + 64 * (j))
#define XB_XSUB(j)  (1280 + 64 * (j))
#define XB_XGEN(j)  (2304 + 64 * (j))
#define XB_TOP      3328
#define XB_TOPGEN   3392
#define XCD_BAR_WORDS 3456
#define XB_SPIN_CAP (1u << 22)
DI unsigned xb_ld(unsigned* p)              { return __hip_atomic_load(p, __ATOMIC_RELAXED, __HIP_MEMORY_SCOPE_AGENT); }
DI unsigned xb_add(unsigned* p, unsigned v) { return __hip_atomic_fetch_add(p, v, __ATOMIC_RELAXED, __HIP_MEMORY_SCOPE_AGENT); }
DI unsigned xb_xcc_id() { return (unsigned)__builtin_amdgcn_s_getreg((3 << 11) | 20) & 0xFu; }
#define XB_SPIN(cond, bar) do { unsigned _sp = 0; while (cond) { __builtin_amdgcn_s_sleep(1); \
    if ((++_sp & 255u) == 0u) { if (xb_ld(&(bar)[XB_TMO])) break; if (_sp > XB_SPIN_CAP) { atomicAdd(&(bar)[XB_TMO], 1u); break; } } } } while (0)
struct XcdBarrier { unsigned* bar; unsigned x; volatile LAS unsigned* st; bool t0; };
DI XcdBarrier xcd_barrier_post(unsigned* bar, volatile LAS unsigned* st) {
    XcdBarrier b; b.bar = bar; b.x = xb_xcc_id(); b.st = st; b.t0 = threadIdx.x == 0;
    if (b.t0) (void)xb_add(&bar[XB_XCNT(b.x)], 1u);
    return b;
}
DI void xcd_barrier_complete(unsigned* bar, unsigned x, unsigned& nloc, unsigned& nx) {
    const unsigned G = gridDim.x * gridDim.y * gridDim.z;
    unsigned sum, cnt, mine, sp = 0u;
    for (;;) {
        sum = 0u; cnt = 0u; mine = 0u;
#pragma unroll
        for (unsigned j = 0; j < 16; ++j) { const unsigned c = xb_ld(&bar[XB_XCNT(j)]); sum += c; cnt += (c > 0u) ? 1u : 0u; mine = (j == x) ? c : mine; }
        if (sum == G) break;
        __builtin_amdgcn_s_sleep(1);
        if ((++sp & 255u) == 0u) { if (xb_ld(&bar[XB_TMO])) break; if (sp > XB_SPIN_CAP) { atomicAdd(&bar[XB_TMO], 1u); break; } }
    }
    nloc = mine > 0u ? mine : 1u; nx = cnt > 0u ? cnt : 1u;
}
DI void xcd_barrier(const XcdBarrier& b) {
    asm volatile("s_waitcnt vmcnt(0)" ::: "memory");
    __syncthreads();
    if (b.t0) {
        unsigned* bar = b.bar;
        __builtin_amdgcn_s_waitcnt(0);
        unsigned nloc = b.st[0], nx = b.st[1];
        if (nloc == 0u) { xcd_barrier_complete(bar, b.x, nloc, nx); b.st[0] = nloc; b.st[1] = nx; }
        const unsigned old = xb_add(&bar[XB_XSUB(b.x)], 1u);
        const unsigned gen = old / nloc;
        if (old + 1u == (gen + 1u) * nloc) {
            __builtin_amdgcn_fence(__ATOMIC_RELEASE, "agent");
            asm volatile("s_waitcnt vmcnt(0)" ::: "memory");
            const unsigned og = xb_add(&bar[XB_TOP], 1u);
            const unsigned tg = og / nx;
            if (og + 1u == (tg + 1u) * nx) xb_add(&bar[XB_TOPGEN], 1u);
            else XB_SPIN(xb_ld(&bar[XB_TOPGEN]) == tg, bar);
            __builtin_amdgcn_fence(__ATOMIC_ACQUIRE, "agent");
            xb_add(&bar[XB_XGEN(b.x)], 1u);
            asm volatile("s_waitcnt vmcnt(0)" ::: "memory");
        } else {
            XB_SPIN(xb_ld(&bar[XB_XGEN(b.x)]) == gen, bar);
            __builtin_amdgcn_fence(__ATOMIC_ACQUIRE, "agent");
            asm volatile("s_waitcnt vmcnt(0)" ::: "memory");
        }
    }
    __syncthreads();
}

namespace pg8 {
constexpr int BM = 256, BK = 64, HALF = 128, HTB = HALF * BK * 2, STAGE_BYTES = 8 * HTB, NXCD = 8, WGM = 8;
DI int lds_byte(int r, int c) { const int st = (r >> 4) * 2 + (c >> 5), rr = r & 15, cc = c & 31, ob = rr * 64 + cc * 2; return st * 1024 + (ob ^ (((ob >> 9) & 1) << 5)); }
DI void stage_rc(int b, int& R, int& C) { const int st = b / 1024, sb = b % 1024, swz = sb ^ (((sb >> 9) & 1) << 5); R = (st >> 1) * 16 + swz / 64; C = (st & 1) * 32 + (swz % 64) / 2; }
DI int perm32(int rho) { const int n = rho >> 4, i = rho & 15; return 8 * (i >> 2) + 4 * n + (i & 3); }
struct Unit { int pm, pn, pb; };
struct Gemm { const bf16_t* A; const bf16_t* Bt; int K; const bf16_t* A1; const bf16_t* A2; };
struct StaticOrder {
    static constexpr bool GATHER = false;
    int nM, nN, nwg, G, c, pm0;
    DI void init(int M, int N, int G_, int c_, int pm0_ = 0) { pm0 = pm0_; nM = M / BM - pm0_; nN = N / BM; nwg = nM * nN; G = G_; c = c_; }
    DI bool next(int i, Unit& u) const {
        const long L = (long)i * G + c; if (L >= nwg) return false;
        int wgid = (int)L; { const int q = nwg / NXCD, r = nwg % NXCD, xcd = wgid % NXCD, off = wgid / NXCD; wgid = (xcd < r ? xcd * (q + 1) : r * (q + 1) + (xcd - r) * q) + off; }
        const int nig = WGM * nN, gid = wgid / nig, fm = gid * WGM, gsz = (nM - fm) < WGM ? (nM - fm) : WGM;
        u.pm = pm0 + fm + ((wgid % nig) % gsz); u.pn = (wgid % nig) / gsz; u.pb = u.pn; return true;
    }
};
template <bool GATHER_> struct MoeOrder {
    static constexpr bool GATHER = GATHER_;
    const LAS int* tab; int NT, G, c; const int* slot_tok;
    DI bool next(int i, Unit& u) const {
        int L = i * G + c; const int np = tab[32], nwg = np * NT; if (L >= nwg) return false;
        { const int q = nwg / NXCD, r = nwg % NXCD, xcd = L % NXCD, off = L / NXCD; L = (xcd < r ? xcd * (q + 1) : r * (q + 1) + (xcd - r) * q) + off; }
        const int p = L / NT, pn = L % NT; int e = 0;
#pragma unroll 1
        for (int j = 1; j < 32; ++j) e = (tab[j] <= p) ? j : e;
        u.pm = p; u.pn = pn; u.pb = e * NT + pn; return true;
    }
};

template <class Epi, class Sched>
DI void gemm_phase(LAS unsigned char* lds, const Gemm g, const Sched& S, const Epi& E, int tid_) {
    const int tid = launder(tid_), wid = __builtin_amdgcn_readfirstlane(tid >> 6), lane = tid & 63, wr = wid >> 2, wc = wid & 3, fr = lane & 15, fq = lane >> 4;
    const int K = g.K, nt = K / BK, lda = Epi::SEG ? 512 : K;
    unsigned voffA[2], voffB[2];
#pragma unroll
    for (int i = 0; i < 2; ++i) { int R, C; stage_rc(tid * 16 + i * 8192, R, C); const int Rb = Epi::PERM ? ((R & ~31) + perm32(R & 31)) : R;
        voffA[i] = (unsigned)(R * lda + C) * 2u; voffB[i] = (unsigned)(Rb * K + C) * 2u; }
    const size_t kstep = (size_t)(BK * 2);
    const size_t hstep = (size_t)HALF * K * 2;
    const size_t tstep = 2 * hstep;
    const size_t hstepA = (size_t)HALF * lda * 2, tstepA = 2 * hstepA;
    constexpr bool GA = Sched::GATHER;
    unsigned cv[2][2], nv[2][2]; int gR[2], gC[2];
#pragma unroll
    for (int i = 0; i < 2; ++i) { stage_rc(tid * 16 + i * 8192, gR[i], gC[i]); cv[0][i] = cv[1][i] = nv[0][i] = nv[1][i] = 0u; }
#define PG8_GVOFF(v, pm_) do { _Pragma("unroll") for (int h_ = 0; h_ < 2; ++h_) _Pragma("unroll") for (int i_ = 0; i_ < 2; ++i_) \
        (v)[h_][i_] = ((unsigned)S.slot_tok[(pm_) * 256 + h_ * 128 + gR[i_]] * (unsigned)lda + (unsigned)gC[i_]) * 2u; } while (0)
#define PG8_ATILE(ub, t) (Epi::SEG ? (const char*)((t) < 8 ? g.A : ((t) < 16 ? g.A1 : g.A2)) + (ub) + (size_t)((t) & 7) * kstep : (const char*)g.A + (ub) + (size_t)(t) * kstep)
    const unsigned ldsw = (unsigned)wid * 1024u;
    const int aoff = lds_byte(wr * 64 + fr, fq * 8), boff = lds_byte(wc * 32 + fr, fq * 8);
#define PG8_SA(b, h) (((b) * 2 + (h)) * HTB)
#define PG8_SB(b, h) ((4 + (b) * 2 + (h)) * HTB)
#define PG8_STAGE(bufoff, gbase, voff) do { _Pragma("unroll") for (int _i = 0; _i < 2; ++_i) \
        __builtin_amdgcn_global_load_lds((const unsigned*)((const char*)(gbase) + (voff)[_i]), (LAS unsigned*)(lds + (bufoff) + ldsw + _i * 8192), 16, 0, 0); } while (0)
#define PG8_LDA(dst, b, h) do { _Pragma("unroll") for (int m = 0; m < 4; ++m) _Pragma("unroll") for (int k = 0; k < 2; ++k) dst[m][k] = *(const LAS bf16x8*)(lds + PG8_SA(b, h) + aoff + m * 2048 + k * 1024); } while (0)
#define PG8_LDB(dst, b, h) do { _Pragma("unroll") for (int n = 0; n < 2; ++n) _Pragma("unroll") for (int k = 0; k < 2; ++k) dst[n][k] = *(const LAS bf16x8*)(lds + PG8_SB(b, h) + boff + n * 2048 + k * 1024); } while (0)
#define PG8_MMA(ai, bj, At, Bt) do { __builtin_amdgcn_s_setprio(1); _Pragma("unroll") for (int m = 0; m < 4; ++m) _Pragma("unroll") for (int n = 0; n < 2; ++n) _Pragma("unroll") for (int k = 0; k < 2; ++k) \
        acc[ai][bj][m][n] = __builtin_amdgcn_mfma_f32_16x16x32_bf16(Bt[n][k], At[m][k], acc[ai][bj][m][n], 0, 0, 0); __builtin_amdgcn_s_setprio(0); } while (0)
#define PG8_WAIT_V(n) asm volatile("s_waitcnt vmcnt(" #n ")" ::: "memory")
#define PG8_WAIT_L(n) asm volatile("s_waitcnt lgkmcnt(" #n ")" ::: "memory")
#define PG8_BAR __builtin_amdgcn_s_barrier()
#define PG8_SCHED __builtin_amdgcn_sched_barrier(0)
    Unit cur, nxt; int ui = 0;
    if (!S.next(0, cur)) return;
    f32x4 acc[2][2][4][2];
#pragma unroll
    for (int a = 0; a < 2; ++a)
#pragma unroll
        for (int b = 0; b < 2; ++b)
#pragma unroll
            for (int m = 0; m < 4; ++m)
#pragma unroll
                for (int n = 0; n < 2; ++n) acc[a][b][m][n] = (f32x4){0.f, 0.f, 0.f, 0.f};
    bf16x8 At[4][2], B0[2][2], B1[2][2];
    size_t ubA = (size_t)cur.pm * tstepA; const char* cA = PG8_ATILE(ubA, 0); const char* cB = (const char*)g.Bt + (size_t)cur.pb * tstep;
    const char* const gA = (const char*)g.A;
    if constexpr (GA) { PG8_GVOFF(cv, cur.pm); }
    PG8_STAGE(PG8_SB(0, 0), cB, voffB);
    if constexpr (GA) PG8_STAGE(PG8_SA(0, 0), gA, cv[0]); else PG8_STAGE(PG8_SA(0, 0), cA, voffA);
    PG8_STAGE(PG8_SB(0, 1), cB + hstep, voffB);
    if constexpr (GA) PG8_STAGE(PG8_SA(0, 1), gA, cv[1]); else PG8_STAGE(PG8_SA(0, 1), cA + hstepA, voffA);
    if (wr == 1) PG8_BAR;
    PG8_WAIT_V(4); PG8_BAR;
    PG8_STAGE(PG8_SB(1, 0), cB + kstep, voffB);
    if constexpr (GA) PG8_STAGE(PG8_SA(1, 0), gA + kstep, cv[0]); else PG8_STAGE(PG8_SA(1, 0), cA + kstep, voffA);
    PG8_STAGE(PG8_SB(1, 1), cB + hstep + kstep, voffB);
    PG8_WAIT_V(6); PG8_BAR;
    for (;;) {
        const bool has_next = S.next(ui + 1, nxt);
        const size_t nubA = has_next ? (size_t)nxt.pm * tstepA : ubA;
        const char* nA = PG8_ATILE(nubA, 0); const char* nB = has_next ? (const char*)g.Bt + (size_t)nxt.pb * tstep : cB;
        if constexpr (GA) { if (has_next) { PG8_GVOFF(nv, nxt.pm); } else {
#pragma unroll
            for (int h_ = 0; h_ < 2; ++h_) { nv[h_][0] = cv[h_][0]; nv[h_][1] = cv[h_][1]; } } }
        for (int t = 0; t < nt; t += 2) {
            const bool last = (t == nt - 2);
            const char* a1 = PG8_ATILE(ubA, t + 1);
            const char* a2 = last ? nA : PG8_ATILE(ubA, t + 2); const char* b2 = last ? nB : cB + (size_t)(t + 2) * kstep;
            const char* a3 = a2 + kstep; const char* b3 = b2 + kstep;
            const char* gk2 = gA + (last ? (size_t)0 : (size_t)(t + 2) * kstep);
            unsigned s0[2] = {last ? nv[0][0] : cv[0][0], last ? nv[0][1] : cv[0][1]}, s1[2] = {last ? nv[1][0] : cv[1][0], last ? nv[1][1] : cv[1][1]};
            PG8_LDB(B0, 0, 0); PG8_SCHED; PG8_LDA(At, 0, 0);
            if constexpr (GA) PG8_STAGE(PG8_SA(1, 1), gA + (size_t)(t + 1) * kstep, cv[1]); else PG8_STAGE(PG8_SA(1, 1), a1 + hstepA, voffA);
            PG8_WAIT_L(8); PG8_BAR; PG8_WAIT_L(0); PG8_MMA(0, 0, At, B0); PG8_BAR; PG8_SCHED;
            PG8_LDB(B1, 0, 1); PG8_STAGE(PG8_SB(0, 0), b2, voffB);
            PG8_BAR; PG8_WAIT_L(0); PG8_MMA(0, 1, At, B1); PG8_BAR;
            PG8_LDA(At, 0, 1); if constexpr (GA) PG8_STAGE(PG8_SA(0, 0), gk2, s0); else PG8_STAGE(PG8_SA(0, 0), a2, voffA);
            PG8_BAR; PG8_WAIT_L(0); PG8_MMA(1, 0, At, B0); PG8_BAR; PG8_SCHED;
            PG8_STAGE(PG8_SB(0, 1), b2 + hstep, voffB);
            PG8_WAIT_V(6); PG8_BAR; PG8_MMA(1, 1, At, B1); PG8_BAR;
            PG8_LDB(B0, 1, 0); PG8_SCHED; PG8_LDA(At, 1, 0); if constexpr (GA) PG8_STAGE(PG8_SA(0, 1), gk2, s1); else PG8_STAGE(PG8_SA(0, 1), a2 + hstepA, voffA);
            PG8_WAIT_L(8); PG8_BAR; PG8_WAIT_L(0); PG8_MMA(0, 0, At, B0); PG8_BAR; PG8_SCHED;
            PG8_LDB(B1, 1, 1); PG8_STAGE(PG8_SB(1, 0), b3, voffB);
            PG8_BAR; PG8_WAIT_L(0); PG8_MMA(0, 1, At, B1); PG8_BAR;
            PG8_LDA(At, 1, 1); if constexpr (GA) PG8_STAGE(PG8_SA(1, 0), gk2 + kstep, s0); else PG8_STAGE(PG8_SA(1, 0), a3, voffA);
            PG8_BAR; PG8_WAIT_L(0); PG8_MMA(1, 0, At, B0); PG8_BAR; PG8_SCHED;
            PG8_STAGE(PG8_SB(1, 1), b3 + hstep, voffB);
            PG8_WAIT_V(6); PG8_BAR; PG8_MMA(1, 1, At, B1); PG8_BAR;
            if constexpr (Epi::SEG) { if (((t + 2) & 7) == 0 && !last) E.mid(acc, cur, (t + 2) >> 3, wr, wc, fr, fq); }
        }
        E(acc, cur, wr, wc, fr, fq);
        if (!has_next) break;
#pragma unroll
        for (int a = 0; a < 2; ++a)
#pragma unroll
            for (int b = 0; b < 2; ++b)
#pragma unroll
                for (int m = 0; m < 4; ++m)
#pragma unroll
                    for (int n = 0; n < 2; ++n) acc[a][b][m][n] = (f32x4){0.f, 0.f, 0.f, 0.f};
        cur = nxt; cA = nA; cB = nB; ubA = nubA; ++ui;
        if constexpr (GA) {
#pragma unroll
            for (int h_ = 0; h_ < 2; ++h_) { cv[h_][0] = nv[h_][0]; cv[h_][1] = nv[h_][1]; } }
    }
    PG8_WAIT_V(0);
    if (wr == 0) PG8_BAR;
    PG8_BAR;
#undef PG8_ATILE
#undef PG8_GVOFF
#undef PG8_SA
#undef PG8_SB
#undef PG8_STAGE
#undef PG8_LDA
#undef PG8_LDB
#undef PG8_MMA
#undef PG8_WAIT_V
#undef PG8_WAIT_L
#undef PG8_BAR
#undef PG8_SCHED
}
}

struct Args { const float* in[33]; float* out; unsigned char* ws; int ph_lo, ph_hi; };
static_assert(offsetof(Args, out) == 264 && offsetof(Args, ws) == 272, "kernarg layout");
typedef const float* cfptr_t;
typedef __attribute__((address_space(4))) const cfptr_t* kain_t;
typedef __attribute__((address_space(4))) const unsigned char* kab_t;
struct Frame {
    kain_t in; float* out; unsigned char* ws; LAS unsigned char* lds;
    int tid, lane, wid, G, bid;
};
enum { I_X = 0, I_C, I_CTX, I_CCTX, I_WADA, I_BADA, I_N1G, I_N2G, I_WIN, I_POOLW, I_POOLS, I_QNG, I_KNG, I_LAMQK, I_SUBLN, I_SHMU, I_DW0, I_DW2, I_AA0, I_AA2, I_GW2, I_KK, I_KA, I_RK, I_GNW, I_GNB,
       I_WBR, I_WOUT, I_WRG, I_WRE, I_WEG, I_WEU, I_WED };
template <class T> DI T* wsp(const Frame& F, size_t off) { return (T*)(F.ws + off); }
DI const float* xrow_ptr(const Frame& F, const float* xlat, int r) { return r < NCTX ? wsp<const float>(F, OFF_CTX) + (size_t)r * DM : xlat + (size_t)(r - NCTX) * DM; }
DI Frame phase_frame(const Frame& F0) { Frame F = F0; F.lane = launder(lane_id()); F.wid = F0.wid; F.tid = (F.wid << 6) | F.lane;
    kab_t ka = (kab_t)__builtin_amdgcn_kernarg_segment_ptr(); asm volatile("" : "+s"(ka));
    F.in = (kain_t)ka; F.out = *(float* const __attribute__((address_space(4)))*)(ka + 264); F.ws = *(unsigned char* const __attribute__((address_space(4)))*)(ka + 272); return F; }
DI int row_cond(int r) { return r < NCTX ? 2 : (r - NCTX) / SEQ; }
DI const float* modp(const Frame& F, int l, int cond, int j) { return wsp<const float>(F, OFF_MOD) + ((size_t)(l * 3 + cond) * 6 + j) * DM; }

DI void convT_tile(const Frame& F, const float* src, int src_ld, int k0, int n0, bf16_t* dst, int dst_ld, int drow0) {
    LAS float* tile = (LAS float*)F.lds;
    const int t = F.tid;
    { const int k = t >> 3, n8 = (t & 7) * 8; const float* p = src + (size_t)(k0 + k) * src_ld + n0 + n8;
      const f32x4 a = *(const f32x4*)p, b = *(const f32x4*)(p + 4);
      LAS float* q = tile + k * 65 + n8; q[0] = a[0]; q[1] = a[1]; q[2] = a[2]; q[3] = a[3]; q[4] = b[0]; q[5] = b[1]; q[6] = b[2]; q[7] = b[3]; }
    __syncthreads();
    { const int n = t >> 3, k8 = (t & 7) * 8; float f[8];
#pragma unroll
      for (int j = 0; j < 8; ++j) f[j] = tile[(k8 + j) * 65 + n];
      *(u32x4*)(dst + (size_t)(drow0 + n) * dst_ld + k0 + k8) = pack8(f); }
    __syncthreads();
}
DI void convT(const Frame& F, const float* src, int src_ld, int K, int n_lo, int n_hi, bf16_t* dst, int dst_ld, int drow_base, int rot) {
    const int tk = K / 64, tn = (n_hi - n_lo) / 64, ntile = tk * tn;
    for (int t = (F.bid + rot) % F.G; t < ntile; t += F.G) { const int kt = t % tk, nt_ = t / tk; convT_tile(F, src, src_ld, kt * 64, n_lo + nt_ * 64, dst, dst_ld, drow_base + nt_ * 64); }
}

DI void conv_small_weights(const Frame& F, int l) {
    const int gt = F.bid * 512 + F.tid, gn = F.G * 512;
    bf16_t* win = wsp<bf16_t>(F, OFF_WIN);
    const float* w_in = F.in[I_WIN] + (size_t)l * DM * IN_W;
    convT(F, w_in, IN_W, DM, 0, 3968, win, DM, 0, 0);
    convT(F, w_in, IN_W, DM, 3968, IN_W, win, DM, 4096, 64);
    for (int i = gt; i < 128 * DM / 8; i += gn) *(u32x4*)(win + (size_t)3968 * DM + (size_t)i * 8) = (u32x4){0u, 0u, 0u, 0u};
    bf16_t* wmg = wsp<bf16_t>(F, OFF_WMG);
    const float* w_br = F.in[I_WBR] + (size_t)l * 3 * 512 * DM;
    convT(F, w_br + (size_t)1 * 512 * DM, DM, 512, 0, DM, wmg + 512, 1536, 0, 128);
    convT(F, w_br + (size_t)2 * 512 * DM, DM, 512, 0, DM, wmg + 1024, 1536, 0, 192);
    {
        const float* pw = F.in[I_POOLW] + (size_t)l * 4 * 128 * 128; const float* ps = F.in[I_POOLS] + (size_t)l * 512;
        for (int i = gt; i < DM * 64; i += gn) {
            const int n = i & 1023, c8 = i >> 10, k0 = c8 * 8, g = k0 >> 7, c0 = k0 & 127; float acc[8];
#pragma unroll
            for (int j = 0; j < 8; ++j) acc[j] = 0.f;
            for (int d = 0; d < 128; ++d) { const float wb = ps[g * 128 + d] * w_br[(size_t)(g * 128 + d) * DM + n];
#pragma unroll
                for (int j = 0; j < 8; ++j) acc[j] += pw[(size_t)(g * 128 + c0 + j) * 128 + d] * wb; }
            *(u32x4*)(wmg + (size_t)n * 1536 + k0) = pack8(acc);
        }
    }
    convT(F, F.in[I_WOUT] + (size_t)l * DM * DM, DM, DM, 0, DM, wsp<bf16_t>(F, OFF_WOUT), DM, 0, 32);
    {
        bf16_t* wl = wsp<bf16_t>(F, OFF_WLORA);
        const float* dw2 = F.in[I_DW2] + (size_t)l * 2 * 64 * 512; const float* aa2 = F.in[I_AA2] + (size_t)l * 2 * 64 * 512; const float* gw2 = F.in[I_GW2] + (size_t)l * 128 * 512;
        for (int i = gt; i < LORA_N * (LORA_K / 8); i += gn) {
            const int n = i % LORA_N, k0 = (i / LORA_N) * 8, kind = n >> 9, c = n & 511; float f[8];
#pragma unroll
            for (int j = 0; j < 8; ++j) { const int k = k0 + j; float v = 0.f;
                if (kind < 2) { if (k >= kind * 64 && k < kind * 64 + 64) v = dw2[((size_t)kind * 64 + (k - kind * 64)) * 512 + c]; }
                else if (kind < 4) { const int d = kind - 2; if (k >= 128 + d * 64 && k < 192 + d * 64) v = aa2[((size_t)d * 64 + (k - 128 - d * 64)) * 512 + c]; }
                else { if (k >= 256) v = gw2[(size_t)(k - 256) * 512 + c]; }
                f[j] = v; }
            *(u32x4*)(wl + (size_t)n * LORA_K + k0) = pack8(f);
        }
    }
}
DI void conv_expert_weights(const Frame& F, int l) {
    const int gt = F.bid * 512 + F.tid, gn = F.G * 512;
    bf16_t* w1 = wsp<bf16_t>(F, OFF_WE1); bf16_t* w2 = wsp<bf16_t>(F, OFF_WE2);
    const float* wg = F.in[I_WEG] + (size_t)l * NEXP * DM * FF; const float* wu = F.in[I_WEU] + (size_t)l * NEXP * DM * FF; const float* wd = F.in[I_WED] + (size_t)l * NEXP * FF * DM;
    const int tt = F.tid, lk = tt >> 3, l8 = (tt & 7) * 8;
    const int NT = NEXP * 384;
#define EXP_TILE(t_, srcp_, dstp_) do { const int e_ = (t_) / 384, r_ = (t_) % 384; \
        if (r_ < 256) { const int up_ = r_ >> 7, q_ = r_ & 127, kt_ = q_ & 15, nt_ = q_ >> 4, ff0_ = nt_ * 64, drow_ = 256 * (ff0_ >> 7) + 128 * up_ + (ff0_ & 127); \
            srcp_ = (up_ ? wu : wg) + (size_t)e_ * DM * FF + (size_t)(kt_ * 64 + lk) * FF + ff0_ + l8; dstp_ = w1 + (size_t)e_ * 1024 * 1024 + (size_t)(drow_ + lk) * DM + kt_ * 64 + l8; } \
        else { const int q_ = r_ - 256, kt_ = q_ & 7, nt_ = q_ >> 3; \
            srcp_ = wd + (size_t)e_ * FF * DM + (size_t)(kt_ * 64 + lk) * DM + nt_ * 64 + l8; dstp_ = w2 + (size_t)e_ * 1024 * 512 + (size_t)(nt_ * 64 + lk) * FF + kt_ * 64 + l8; } } while (0)
    for (int base = F.bid; base < NT; base += 4 * F.G) {
        f32x4 ra[4], rb[4]; bf16_t* dp[4];
#pragma unroll
        for (int s_ = 0; s_ < 4; ++s_) { const int t = base + s_ * F.G < NT ? base + s_ * F.G : base; const float* sp; EXP_TILE(t, sp, dp[s_]); ra[s_] = *(const f32x4*)sp; rb[s_] = *(const f32x4*)(sp + 4); }
#pragma unroll
        for (int s_ = 0; s_ < 4; ++s_) { LAS float* q = (LAS float*)F.lds + s_ * (64 * 65) + lk * 65 + l8; const f32x4 a = ra[s_], b = rb[s_]; q[0] = a[0]; q[1] = a[1]; q[2] = a[2]; q[3] = a[3]; q[4] = b[0]; q[5] = b[1]; q[6] = b[2]; q[7] = b[3]; }
        __syncthreads();
#pragma unroll
        for (int s_ = 0; s_ < 4; ++s_) { if (base + s_ * F.G >= NT) break; const LAS float* tile = (const LAS float*)F.lds + s_ * (64 * 65); float f[8];
#pragma unroll
            for (int j = 0; j < 8; ++j) f[j] = tile[(l8 + j) * 65 + lk];
            *(u32x4*)dp[s_] = pack8(f); }
        __syncthreads();
    }
#undef EXP_TILE
}
DI void conv_router_weights(const Frame& F, int l) {
    const int gt = F.bid * 512 + F.tid, gn = F.G * 512;
    bf16_t* wr = wsp<bf16_t>(F, OFF_WRT);
    const float* wrg = F.in[I_WRG] + (size_t)l * DM * 4; const float* wre = F.in[I_WRE] + (size_t)l * DM * 32;
    for (int i = gt; i < 256 * (DM / 8); i += gn) { const int n = i & 255, k0 = (i >> 8) * 8; float f[8];
#pragma unroll
        for (int j = 0; j < 8; ++j) f[j] = n < 4 ? wrg[(size_t)(k0 + j) * 4 + n] : (n < 36 ? wre[(size_t)(k0 + j) * 32 + (n - 4)] : 0.f);
        *(u32x4*)(wr + (size_t)n * DM + k0) = pack8(f); }
}
DI void p0_prologue(const Frame& F) {
    LAS float* sl = (LAS float*)F.lds;
    LAS float* red = sl + 3 * DM;
    for (int i = F.tid; i < 3 * DM; i += 512) { const int cond = i >> 10, k = i & 1023; const float v = cond < 2 ? F.in[I_C][cond * DM + k] : F.in[I_CCTX][k]; sl[i] = v * sigmoidf_(v); }
    __syncthreads();
    for (int cg = F.bid; cg < 192; cg += F.G) {
        const int l = cg / 96, col = (cg % 96) * 64 + F.lane;
        const float* W = F.in[I_WADA] + (size_t)l * DM * 6144 + col;
        float s0 = 0.f, s1 = 0.f, s2 = 0.f;
        const int kb = F.wid * 128;
#pragma unroll 8
        for (int k = kb; k < kb + 128; ++k) { const float w = W[(size_t)k * 6144]; s0 += sl[k] * w; s1 += sl[DM + k] * w; s2 += sl[2 * DM + k] * w; }
        red[(F.wid * 3 + 0) * 64 + F.lane] = s0; red[(F.wid * 3 + 1) * 64 + F.lane] = s1; red[(F.wid * 3 + 2) * 64 + F.lane] = s2;
        __syncthreads();
        if (F.tid < 192) { const int cond = F.tid >> 6, ln = F.tid & 63; float s = 0.f;
#pragma unroll
            for (int w = 0; w < 8; ++w) s += red[(w * 3 + cond) * 64 + ln];
            const int n = (cg % 96) * 64 + ln;
            wsp<float>(F, OFF_MOD)[(size_t)(l * 3 + cond) * 6144 + n] = s + F.in[I_BADA][(size_t)l * 6144 + n]; }
        __syncthreads();
    }
    { const int gt = F.bid * 512 + F.tid, gn = F.G * 512; float* cx = wsp<float>(F, OFF_CTX);
      for (int i = gt; i < NCTX * DM / 4; i += gn) ((f32x4*)cx)[i] = ((const f32x4*)F.in[I_CTX])[i]; }
    __syncthreads();
    conv_small_weights(F, 0);
}

DI void norm_rows(const Frame& F, const float* xlat, const float* g, int l, int j_shift, int j_scale, bf16_t* dst, int r_begin = 0) {
    const int gw = F.bid * 8 + F.wid, nw = F.G * 8;
    f32x4 gv[4];
#pragma unroll
    for (int j = 0; j < 4; ++j) gv[j] = *(const f32x4*)(g + 4 * F.lane + 256 * j);
    for (int r0 = r_begin + gw * 4; r0 < MROWS; r0 += nw * 4) {
        f32x4 v[4][4]; float ss[4];
#pragma unroll
        for (int q = 0; q < 4; ++q) { const float* xr = xrow_ptr(F, xlat, r0 + q);
#pragma unroll
            for (int j = 0; j < 4; ++j) v[q][j] = *(const f32x4*)(xr + 4 * F.lane + 256 * j); }
        const int cond = row_cond(r0); const float* sh = modp(F, l, cond, j_shift); const float* sc = modp(F, l, cond, j_scale);
        f32x4 s4v[4], c4v[4];
#pragma unroll
        for (int j = 0; j < 4; ++j) { s4v[j] = *(const f32x4*)(sh + 4 * F.lane + 256 * j); c4v[j] = *(const f32x4*)(sc + 4 * F.lane + 256 * j); }
#pragma unroll
        for (int q = 0; q < 4; ++q) { float a = 0.f;
#pragma unroll
            for (int j = 0; j < 4; ++j) a += v[q][j][0] * v[q][j][0] + v[q][j][1] * v[q][j][1] + v[q][j][2] * v[q][j][2] + v[q][j][3] * v[q][j][3];
            ss[q] = a; }
#pragma unroll
        for (int sft = 1; sft < 64; sft <<= 1) {
#pragma unroll
            for (int q = 0; q < 4; ++q) ss[q] += __shfl_xor(ss[q], sft); }
#pragma unroll
        for (int j = 0; j < 4; ++j) { const f32x4 s4 = s4v[j], c4 = c4v[j];
#pragma unroll
            for (int q = 0; q < 4; ++q) { const float inv = rsqrtf(ss[q] * (1.0f / DM) + 1e-6f); float o[4];
#pragma unroll
                for (int e = 0; e < 4; ++e) o[e] = (v[q][j][e] * inv * gv[j][e]) * (1.0f + c4[e]) + s4[e];
                u32x2 w; w.x = pk2(o[0], o[1]); w.y = pk2(o[2], o[3]);
                *(u32x2*)(dst + (size_t)(r0 + q) * DM + 4 * F.lane + 256 * j) = w; } }
    }
}

struct EpiInproj {
    static constexpr bool PERM = true, SEG = false;
    unsigned char* ws;
    DI void operator()(const f32x4 (&acc)[2][2][4][2], const pg8::Unit& u, int wr, int wc, int fr, int fq) const {
        bf16_t* dst; int ld, colt;
        if (u.pn < 8) { dst = (bf16_t*)(ws + R1) + (size_t)(u.pn >> 1) * U_EL; ld = 512; colt = (u.pn & 1) * 256; } else { dst = (bf16_t*)(ws + OFF_RWRAW); ld = 2048; colt = (u.pn - 8) * 256; }
        const int row0 = u.pm * 256 + wr * 64 + fr, col0 = colt + wc * 32 + 8 * fq;
#pragma unroll
        for (int ai = 0; ai < 2; ++ai)
#pragma unroll
            for (int m = 0; m < 4; ++m) { bf16_t* rowp = dst + (size_t)(row0 + ai * 128 + m * 16) * ld + col0;
#pragma unroll
                for (int bj = 0; bj < 2; ++bj) { const f32x4 v0 = acc[ai][bj][m][0], v1 = acc[ai][bj][m][1]; u32x4 w; w.x = pk2(v0[0], v0[1]); w.y = pk2(v0[2], v0[3]); w.z = pk2(v1[0], v1[1]); w.w = pk2(v1[2], v1[3]);
                    *(u32x4*)(rowp + bj * 128) = w; } }
    }
};
struct EpiLora {
    static constexpr bool PERM = true, SEG = false;
    unsigned char* ws; const float* w0; const float* a0;
    DI void operator()(const f32x4 (&acc)[2][2][4][2], const pg8::Unit& u, int wr, int wc, int fr, int fq) const {
        fr = launder(fr); fq = launder(fq);
        const int kind = u.pn >> 1; bf16_t* dst = (bf16_t*)(ws + R2) + (size_t)kind * U_EL; const int colt = (u.pn & 1) * 256;
        const int row0 = u.pm * 256 + wr * 64 + fr, col0 = colt + wc * 32 + 8 * fq;
        const float* bias = kind < 2 ? w0 + kind * 512 : a0 + ((kind - 2) & 1) * 512;
        const float mul = kind < 2 ? 0.60653065971f : 1.0f;
        if (kind < 4) {
#pragma unroll
            for (int bj = 0; bj < 2; ++bj) { const f32x4 b0 = *(const f32x4*)(bias + col0 + bj * 128), b1 = *(const f32x4*)(bias + col0 + bj * 128 + 4);
#pragma unroll
                for (int ai = 0; ai < 2; ++ai)
#pragma unroll
                    for (int m = 0; m < 4; ++m) { bf16_t* rowp = dst + (size_t)(row0 + ai * 128 + m * 16) * 512 + col0;
                        f32x4 v0 = acc[ai][bj][m][0], v1 = acc[ai][bj][m][1];
#pragma unroll
                        for (int e = 0; e < 4; ++e) { v0[e] = mul * sigmoidf_(v0[e] + b0[e]); v1[e] = mul * sigmoidf_(v1[e] + b1[e]); }
                        u32x4 w; w.x = pk2(v0[0], v0[1]); w.y = pk2(v0[2], v0[3]); w.z = pk2(v1[0], v1[1]); w.w = pk2(v1[2], v1[3]);
                        *(u32x4*)(rowp + bj * 128) = w; }
                asm volatile("" ::: "memory"); }
        } else {
#pragma unroll
            for (int bj = 0; bj < 2; ++bj)
#pragma unroll
                for (int ai = 0; ai < 2; ++ai)
#pragma unroll
                    for (int m = 0; m < 4; ++m) { bf16_t* rowp = dst + (size_t)(row0 + ai * 128 + m * 16) * 512 + col0;
                        const f32x4 v0 = acc[ai][bj][m][0], v1 = acc[ai][bj][m][1];
                        u32x4 w; w.x = pk2(v0[0], v0[1]); w.y = pk2(v0[2], v0[3]); w.z = pk2(v1[0], v1[1]); w.w = pk2(v1[2], v1[3]);
                        *(u32x4*)(rowp + bj * 128) = w; }
        }
    }
};
struct EpiGates {
    static constexpr bool PERM = true, SEG = false;
    bf16_t* G;
    DI void operator()(const f32x4 (&acc)[2][2][4][2], const pg8::Unit& u, int wr, int wc, int fr, int fq) const {
        const int row0 = u.pm * 256 + wr * 64 + fr, col0 = u.pn * 256 + wc * 32 + 8 * fq;
#pragma unroll
        for (int ai = 0; ai < 2; ++ai)
#pragma unroll
            for (int m = 0; m < 4; ++m) { bf16_t* rowp = G + (size_t)(row0 + ai * 128 + m * 16) * N_GATE + col0;
#pragma unroll
                for (int bj = 0; bj < 2; ++bj) { f32x4 v0 = acc[ai][bj][m][0], v1 = acc[ai][bj][m][1];
#pragma unroll
                    for (int e = 0; e < 4; ++e) { v0[e] = sigmoidf_(v0[e]); v1[e] = sigmoidf_(v1[e]); }
                    u32x4 w; w.x = pk2(v0[0], v0[1]); w.y = pk2(v0[2], v0[3]); w.z = pk2(v1[0], v1[1]); w.w = pk2(v1[2], v1[3]);
                    *(u32x4*)(rowp + bj * 128) = w; } }
    }
};
struct EpiMerge {
    static constexpr bool PERM = true, SEG = true;
    const bf16_t* G; bf16_t* mg;
    DI void mid(f32x4 (&acc)[2][2][4][2], const pg8::Unit& u, int seg, int wr, int wc, int fr, int fq) const {
        const int row0 = u.pm * 256 + wr * 64 + fr, col0 = u.pn * 256 + wc * 32 + 8 * fq;
#pragma unroll
        for (int ai = 0; ai < 2; ++ai)
#pragma unroll
            for (int m = 0; m < 4; ++m) { const bf16_t* gp = G + (size_t)(row0 + ai * 128 + m * 16) * N_GATE + (seg - 1) * DM + col0;
#pragma unroll
                for (int bj = 0; bj < 2; ++bj) { float ga[8], gb[8]; unpack8(*(const u32x4*)(gp + bj * 128), ga); unpack8(*(const u32x4*)(gp + DM + bj * 128), gb);
#pragma unroll
                    for (int e = 0; e < 4; ++e) { acc[ai][bj][m][0][e] *= fmaxf(ga[e], 1e-30f) * __builtin_amdgcn_rcpf(fmaxf(gb[e], 1e-30f)); acc[ai][bj][m][1][e] *= fmaxf(ga[4 + e], 1e-30f) * __builtin_amdgcn_rcpf(fmaxf(gb[4 + e], 1e-30f)); } }
                asm volatile("" ::: "memory"); }
    }
    DI void operator()(const f32x4 (&acc)[2][2][4][2], const pg8::Unit& u, int wr, int wc, int fr, int fq) const {
        const int row0 = u.pm * 256 + wr * 64 + fr, col0 = u.pn * 256 + wc * 32 + 8 * fq;
#pragma unroll
        for (int ai = 0; ai < 2; ++ai)
#pragma unroll
            for (int m = 0; m < 4; ++m) { const size_t row = (size_t)(row0 + ai * 128 + m * 16);
#pragma unroll
                for (int bj = 0; bj < 2; ++bj) { const f32x4 v0 = acc[ai][bj][m][0], v1 = acc[ai][bj][m][1];
                    float gv[8], o[8]; unpack8(*(const u32x4*)(G + row * N_GATE + 2 * DM + col0 + bj * 128), gv);
#pragma unroll
                    for (int e = 0; e < 4; ++e) { o[e] = fmaxf(gv[e], 1e-30f) * v0[e]; o[4 + e] = fmaxf(gv[4 + e], 1e-30f) * v1[e]; }
                    *(u32x4*)(mg + row * DM + col0 + bj * 128) = pack8(o); }
                asm volatile("" ::: "memory"); }
    }
};
struct EpiResid {
    static constexpr bool PERM = false, SEG = false;
    const float* xlat_in; float* xlat_out; float* ctxb; const float* modl;
    DI void operator()(const f32x4 (&acc)[2][2][4][2], const pg8::Unit& u, int wr, int wc, int fr, int fq) const {
        const int col0 = u.pn * 256 + wc * 32 + 4 * fq; const bool isctx = u.pm < 2; const int cond = isctx ? 2 : (u.pm - 2) / 64;
        const float* src = isctx ? ctxb + (size_t)u.pm * 256 * DM : xlat_in + (size_t)(u.pm - 2) * 256 * DM;
        float* dst = isctx ? ctxb + (size_t)u.pm * 256 * DM : xlat_out + (size_t)(u.pm - 2) * 256 * DM;
        const float* gate = modl + (size_t)(cond * 6 + 2) * DM + col0;
#pragma unroll
        for (int bj = 0; bj < 2; ++bj)
#pragma unroll
            for (int n = 0; n < 2; ++n) { const f32x4 gv = *(const f32x4*)(gate + bj * 128 + n * 16);
#pragma unroll
                for (int ai = 0; ai < 2; ++ai) { f32x4 xo[4];
#pragma unroll
                    for (int m = 0; m < 4; ++m) xo[m] = *(const f32x4*)(src + (size_t)(wr * 64 + fr + ai * 128 + m * 16) * DM + col0 + bj * 128 + n * 16);
#pragma unroll
                    for (int m = 0; m < 4; ++m) *(f32x4*)(dst + (size_t)(wr * 64 + fr + ai * 128 + m * 16) * DM + col0 + bj * 128 + n * 16) = xo[m] + gv * acc[ai][bj][m][n];
                    asm volatile("" ::: "memory"); } }
    }
};
struct EpiLogits {
    static constexpr bool PERM = false, SEG = false;
    float* lg;
    DI void operator()(const f32x4 (&acc)[2][2][4][2], const pg8::Unit& u, int wr, int wc, int fr, int fq) const {
        if (wc >= 2) return;
        const int row0 = u.pm * 256 + wr * 64 + fr, col0 = wc * 32 + 4 * fq;
#pragma unroll
        for (int ai = 0; ai < 2; ++ai)
#pragma unroll
            for (int m = 0; m < 4; ++m)
#pragma unroll
                for (int n = 0; n < 2; ++n) *(f32x4*)(lg + (size_t)(row0 + ai * 128 + m * 16) * 64 + col0 + n * 16) = acc[ai][0][m][n];
    }
};
struct EpiAct {
    static constexpr bool PERM = true, SEG = false;
    bf16_t* act;
    DI void operator()(const f32x4 (&acc)[2][2][4][2], const pg8::Unit& u, int wr, int wc, int fr, int fq) const {
        const int row0 = u.pm * 256 + wr * 64 + fr, col0 = u.pn * 128 + wc * 32 + 8 * fq;
#pragma unroll
        for (int ai = 0; ai < 2; ++ai)
#pragma unroll
            for (int m = 0; m < 4; ++m) { float o[8];
#pragma unroll
                for (int n = 0; n < 2; ++n)
#pragma unroll
                    for (int e = 0; e < 4; ++e) { const float gt = acc[ai][0][m][n][e], up = acc[ai][1][m][n][e]; o[4 * n + e] = gt * sigmoidf_(gt) * up; }
                *(u32x4*)(act + (size_t)(row0 + ai * 128 + m * 16) * FF + col0) = pack8(o); }
    }
};
struct EpiY {
    static constexpr bool PERM = true, SEG = false;
    bf16_t* y;
    DI void operator()(const f32x4 (&acc)[2][2][4][2], const pg8::Unit& u, int wr, int wc, int fr, int fq) const {
        const int row0 = u.pm * 256 + wr * 64 + fr, col0 = u.pn * 256 + wc * 32 + 8 * fq;
#pragma unroll
        for (int ai = 0; ai < 2; ++ai)
#pragma unroll
            for (int m = 0; m < 4; ++m) { bf16_t* rowp = y + (size_t)(row0 + ai * 128 + m * 16) * DM + col0;
#pragma unroll
                for (int bj = 0; bj < 2; ++bj) { const f32x4 v0 = acc[ai][bj][m][0], v1 = acc[ai][bj][m][1]; u32x4 w; w.x = pk2(v0[0], v0[1]); w.y = pk2(v0[2], v0[3]); w.z = pk2(v1[0], v1[1]); w.w = pk2(v1[2], v1[3]);
                    *(u32x4*)(rowp + bj * 128) = w; } }
    }
};

DI void seq_of_row(int r, int& t, int& len) { if (r < NCTX) { t = r & 255; len = CTXL; } else { t = (r - NCTX) & (SEQ - 1); len = SEQ; } }

DI void phaseC_rows(const Frame& F, int l) {
    const int gw = F.bid * 8 + F.wid, nw = F.G * 8, lane = F.lane;
    bf16_t* Q = wsp<bf16_t>(F, OFF_Q); bf16_t* Kp = wsp<bf16_t>(F, OFF_K);
    const bf16_t* POOL = wsp<bf16_t>(F, OFF_POOL); bf16_t* PD = wsp<bf16_t>(F, OFF_PDIFF);
    const bf16_t* RW = wsp<bf16_t>(F, OFF_RWRAW); bf16_t* AL = wsp<bf16_t>(F, OFF_ALORA);
    bf16_t* RR = wsp<bf16_t>(F, OFF_RR); bf16_t* RK = wsp<bf16_t>(F, OFF_RK); bf16_t* RV = wsp<bf16_t>(F, OFF_RV); bf16_t* RKK = wsp<bf16_t>(F, OFF_RKK);
    const int i8 = lane & 7, axis = i8 >> 2, sec = (i8 >> 1) & 1, fb = (i8 & 1) * 8;
    float qg[8], kg[8];
#pragma unroll
    for (int e = 0; e < 8; ++e) { qg[e] = F.in[I_QNG][l * 64 + i8 * 8 + e]; kg[e] = F.in[I_KNG][l * 64 + i8 * 8 + e]; }
    LAS float* mul_ = (LAS float*)(F.lds + 32768);
    { const float* mu = F.in[I_SHMU] + (size_t)l * 2 * RW_IN; const float* kkw = F.in[I_KK] + (size_t)l * 512;
      for (int i = F.tid; i < 2 * RW_IN + 512; i += 512) mul_[i] = i < 2 * RW_IN ? mu[i] : kkw[i - 2 * RW_IN]; }
    __syncthreads();
    const float QSCALE = 0.125f * 1.4426950408889634f;
    for (int r = gw; r < MROWS; r += nw) {
        int t, len; seq_of_row(r, t, len);
        const int half = 1 << (lane >> 4); const int lo = max(t - half, 0), hi = min(t + half - 1, len - 1);
        const bool hp = t > 0, hn = t < len - 1; const bf16_t* cur = RW + (size_t)r * 2048;
        u32x4 wq, wk, wself, xw[16], rc[4], rp[4], rn[4];
        __builtin_amdgcn_sched_barrier(0);
        wq = *(const u32x4*)(Q + (size_t)r * 512 + 8 * lane); wk = *(const u32x4*)(Kp + (size_t)r * 512 + 8 * lane);
        wself = *(const u32x4*)(POOL + (size_t)r * 512 + 8 * lane);
#pragma unroll
        for (int j = 0; j < 16; ++j) { const int tt = t - 8 + j; const bool ok = tt >= lo && tt <= hi; xw[j] = *(const u32x4*)(POOL + (size_t)(ok ? r + (tt - t) : r) * 512 + 8 * lane); }
#pragma unroll
        for (int ch = 0; ch < 4; ++ch) { const int c0 = ch * 512 + 8 * (ch == 3 ? min(lane, 47) : lane);
            rc[ch] = *(const u32x4*)(cur + c0); rp[ch] = *(const u32x4*)(cur - (hp ? 2048 : 0) + c0); rn[ch] = *(const u32x4*)(cur + (hn ? 2048 : 0) + c0); }
        __builtin_amdgcn_sched_barrier(0);
        float cs[8], sn[8];
        if (r >= NCTX) { const float pos = (float)(axis ? (t & 63) : (t >> 6));
#pragma unroll
            for (int e = 0; e < 8; ++e) { const float invf = __builtin_amdgcn_exp2f(-(float)(fb + e) * 0.83048202372184059f); const float rev = (pos * invf) * 0.15915494309189535f;
                cs[e] = __builtin_amdgcn_cosf(rev); sn[e] = __builtin_amdgcn_sinf(rev); }
        } else {
#pragma unroll
            for (int e = 0; e < 8; ++e) { cs[e] = 1.f; sn[e] = 0.f; } }
#pragma unroll
        for (int which = 0; which < 2; ++which) {
            bf16_t* p = (which ? Kp : Q) + (size_t)r * 512 + 8 * lane; float x[8]; unpack8(which ? wk : wq, x);
            float ss = 0.f;
#pragma unroll
            for (int e = 0; e < 8; ++e) ss += x[e] * x[e];
            ss = sum8(ss); const float rinv = rsqrtf(ss * (1.0f / 64.0f) + 1e-6f);
            float o[8];
#pragma unroll
            for (int e = 0; e < 8; ++e) { const float y = x[e] * rinv * (which ? kg[e] : qg[e]); const float yp = __shfl_xor(y, 2);
                o[e] = y * cs[e] + (sec ? yp : -yp) * sn[e]; if (!which) o[e] *= QSCALE; }
            *(u32x4*)p = pack8(o);
        }
        {
            float s[8], self[8];
#pragma unroll
            for (int e = 0; e < 8; ++e) s[e] = 0.f;
            unpack8(wself, self);
#pragma unroll
            for (int j = 0; j < 16; ++j) { const int tt = t - 8 + j; const float mk = (tt >= lo && tt <= hi) ? 1.0f : 0.0f; float x[8]; unpack8(xw[j], x);
#pragma unroll
                for (int e = 0; e < 8; ++e) s[e] += mk * x[e]; }
            const float ic = 1.0f / (float)(hi - lo + 1); float o[8];
#pragma unroll
            for (int e = 0; e < 8; ++e) o[e] = s[e] * ic - self[e];
            *(u32x4*)(PD + (size_t)r * 512 + 8 * lane) = pack8(o);
        }
        {
#pragma unroll
            for (int ch = 0; ch < 4; ++ch) {
                if (ch == 3 && lane >= 48) break;
                const int c0 = ch * 512 + 8 * lane; float x[8], xp[8], xn[8], u[8];
                unpack8(rc[ch], x); unpack8(rp[ch], xp); unpack8(rn[ch], xn);
                if (!hp) {
#pragma unroll
                    for (int e = 0; e < 8; ++e) xp[e] = 0.f; }
                if (!hn) {
#pragma unroll
                    for (int e = 0; e < 8; ++e) xn[e] = 0.f; }
                const f32x4 m0a = *(const LAS f32x4*)(mul_ + c0), m0b = *(const LAS f32x4*)(mul_ + c0 + 4), m1a = *(const LAS f32x4*)(mul_ + RW_IN + c0), m1b = *(const LAS f32x4*)(mul_ + RW_IN + c0 + 4);
#pragma unroll
                for (int e = 0; e < 8; ++e) { const float m0 = e < 4 ? m0a[e & 3] : m0b[e & 3], m1 = e < 4 ? m1a[e & 3] : m1b[e & 3]; u[e] = x[e] + (xp[e] - x[e]) * m0 + (xn[e] - x[e]) * m1; }
                if (ch == 0) *(u32x4*)(RR + (size_t)r * 512 + 8 * lane) = pack8(u);
                else if (ch == 2) *(u32x4*)(RV + (size_t)r * 512 + 8 * lane) = pack8(u);
                else if (ch == 1) {
                    *(u32x4*)(RK + (size_t)r * 512 + 8 * lane) = pack8(u);
                    const f32x4 kka = *(const LAS f32x4*)(mul_ + 2 * RW_IN + 8 * lane), kkb = *(const LAS f32x4*)(mul_ + 2 * RW_IN + 8 * lane + 4); float kk[8], ss = 0.f;
#pragma unroll
                    for (int e = 0; e < 8; ++e) { kk[e] = u[e] * (e < 4 ? kka[e & 3] : kkb[e & 3]); ss += kk[e] * kk[e]; }
                    ss = sum8(ss); const float inv = 1.0f / fmaxf(sqrtf(ss), 1e-12f);
#pragma unroll
                    for (int e = 0; e < 8; ++e) kk[e] *= inv;
                    *(u32x4*)(RKK + (size_t)r * 512 + 8 * lane) = pack8(kk);
                } else {
                    float o[8];
#pragma unroll
                    for (int e = 0; e < 8; ++e) { if (lane < 16) { const float ex = __expf(2.0f * u[e]); o[e] = 1.0f - 2.0f * __builtin_amdgcn_rcpf(ex + 1.0f); } else if (lane < 32) o[e] = u[e]; else o[e] = sigmoidf_(u[e]); }
                    *(u32x4*)(AL + (size_t)r * LORA_K + 8 * lane) = pack8(o);
                }
            }
        }
    }
}
DI void phaseC_vt(const Frame& F) {
    const bf16_t* V = wsp<bf16_t>(F, OFF_V); bf16_t* VT = wsp<bf16_t>(F, RVT);
    LAS bf16_t* T = (LAS bf16_t*)F.lds;
    for (int task = F.bid; task < NB * 4 * (KEYS / 64); task += F.G) {
        const int kb = task % (KEYS / 64), bh = task / (KEYS / 64), b = bh >> 2, h = bh & 3;
        const int row0 = kb < 4 ? b * CTXL + kb * 64 : NCTX + b * SEQ + (kb - 4) * 64;
#pragma unroll
        for (int i = 0; i < 2; ++i) { const int ci = F.tid + 512 * i, j = ci >> 4, c = ci & 15;
            const u32x4 w = *(const u32x4*)(V + (size_t)(row0 + j) * 512 + h * 128 + c * 8);
            LAS unsigned* q = (LAS unsigned*)(T + j * 136 + c * 8); q[0] = w.x; q[1] = w.y; q[2] = w.z; q[3] = w.w; }
        __syncthreads();
#pragma unroll
        for (int i = 0; i < 2; ++i) { const int ci = F.tid + 512 * i, vd = ci >> 3, p8 = ci & 7; unsigned w[4];
#pragma unroll
            for (int e2 = 0; e2 < 4; ++e2) { unsigned pr = 0;
#pragma unroll
                for (int q = 0; q < 2; ++q) { const int p = p8 * 8 + e2 * 2 + q, gq = p >> 4, pp = p & 15, hh = pp >> 3, ee = pp & 7, ko = 8 * (ee >> 2) + 4 * hh + (ee & 3);
                    pr |= ((unsigned)T[(gq * 16 + ko) * 136 + vd]) << (16 * q); }
                w[e2] = pr; }
            *(u32x4*)(VT + ((size_t)bh * 128 + vd) * KEYS + kb * 64 + p8 * 8) = (u32x4){w[0], w[1], w[2], w[3]}; }
        __syncthreads();
    }
}

#define MFMA32(a, b, c) __builtin_amdgcn_mfma_f32_32x32x16_bf16((a), (b), (c), 0, 0, 0)
constexpr int ATT_KB = 16384, ATT_STG = 32768;
DI void attn_phase(const Frame& F, int l, int nunits) {
    const int tid = F.tid, wid = F.wid, lane = F.lane, l32 = lane & 31, hh = lane >> 5, g = wid >> 1, m = wid & 1;
    const bf16_t* Q = wsp<bf16_t>(F, OFF_Q); const bf16_t* Kg = wsp<bf16_t>(F, OFF_K); const bf16_t* VT = wsp<bf16_t>(F, RVT); bf16_t* ATT = wsp<bf16_t>(F, OFF_POOL);
    const float* lq = F.in[I_LAMQK] + (size_t)l * 256;
    float d0 = lq[lane] * lq[64 + lane], d1 = lq[128 + lane] * lq[192 + lane]; d0 = wave_sum(d0); d1 = wave_sum(d1);
    const float lam_init = 0.8f - 0.6f * expf(-0.3f * (float)l);
    const float lam = expf(d0) - expf(d1) + lam_init, lamfac = 1.0f - lam_init;
    const float* sg = F.in[I_SUBLN] + (size_t)l * 128;
    LAS float* xch = (LAS float*)F.lds;
    LAS float* sgl = (LAS float*)(F.lds + MISC_OFF + 2048);
    if (wid < 2) sgl[wid * 64 + lane] = sg[wid * 64 + lane];
    (void)tid;
    for (int u = F.bid; u < nunits; u += F.G) {
        int b, h, qrow0, nkt;
        if (u < 512) { const int bh = u & 7, qt = ((u >> 3) & 31) + 32 * (u >> 8); b = bh >> 2; h = bh & 3; qrow0 = NCTX + b * SEQ + qt * 256; nkt = KEYS / 64; } else { const int uu = u - 512; b = uu >> 2; h = uu & 3; qrow0 = b * CTXL; nkt = 4; }
        bf16x8 qf[2][4];
#pragma unroll
        for (int qs = 0; qs < 2; ++qs) { const bf16_t* qp = Q + (size_t)(qrow0 + g * 64 + qs * 32 + l32) * 512 + h * 128 + m * 64 + hh * 8;
#pragma unroll
            for (int ks = 0; ks < 4; ++ks) qf[qs][ks] = *(const bf16x8*)(qp + ks * 16); }
        f32x16 o[2][4];
#pragma unroll
        for (int qs = 0; qs < 2; ++qs)
#pragma unroll
            for (int vt = 0; vt < 4; ++vt)
#pragma unroll
                for (int i = 0; i < 16; ++i) o[qs][vt][i] = 0.f;
        float lsum[2] = {0.f, 0.f};
        const bf16_t* vtb = VT + (size_t)(b * 4 + h) * 128 * KEYS;
#define KROW0(kt) ((kt) < 4 ? b * CTXL + (kt) * 64 : NCTX + b * SEQ + ((kt) - 4) * 64)
#define ISSUE_TILE(kt, buf) do { const int ln_ = launder(lane); const int kr0_ = KROW0(kt); _Pragma("unroll") for (int q_ = 0; q_ < 2; ++q_) { const int j_ = 2 * wid + q_; \
            { const int row_ = 4 * j_ + (ln_ >> 4), c_ = (ln_ & 15) ^ (row_ & 15); \
              __builtin_amdgcn_global_load_lds((const unsigned*)(Kg + (size_t)(kr0_ + row_) * 512 + h * 128 + c_ * 8), (LAS unsigned*)(F.lds + (buf) * ATT_STG + j_ * 1024), 16, 0, 0); } \
            { const int row_ = 8 * j_ + (ln_ >> 3), c_ = (ln_ & 7) ^ ((row_ >> 1) & 7); \
              __builtin_amdgcn_global_load_lds((const unsigned*)(vtb + (size_t)row_ * KEYS + (kt) * 64 + c_ * 8), (LAS unsigned*)(F.lds + (buf) * ATT_STG + ATT_KB + j_ * 1024), 16, 0, 0); } } } while (0)
        __syncthreads();
        ISSUE_TILE(0, 0);
        for (int kt = 0; kt < nkt; ++kt) {
            const int buf = kt & 1;
            asm volatile("s_waitcnt vmcnt(0)" ::: "memory");
            __syncthreads();
            if (kt + 1 < nkt) ISSUE_TILE(kt + 1, buf ^ 1);
            const int ln = launder(lane); const int l32b = ln & 31, hb = ln >> 5;
            const LAS unsigned char* Kb = F.lds + buf * ATT_STG + l32b * 256; const int kx = l32b & 15;
            const LAS unsigned char* Vb = F.lds + buf * ATT_STG + ATT_KB + l32b * 128; const int vx = (l32b >> 1) & 7;
#pragma unroll
            for (int kk = 0; kk < 2; ++kk) {
                f32x16 sv[2];
#pragma unroll
                for (int qs = 0; qs < 2; ++qs)
#pragma unroll
                    for (int i = 0; i < 16; ++i) sv[qs][i] = 0.f;
#pragma unroll
                for (int ks = 0; ks < 4; ++ks) { const bf16x8 kf = *(const LAS bf16x8*)(Kb + kk * 8192 + (((m * 8 + ks * 2 + hb) ^ kx) << 4));
                    sv[0] = MFMA32(kf, qf[0][ks], sv[0]); sv[1] = MFMA32(kf, qf[1][ks], sv[1]); }
                bf16x8 pb[2][2];
#pragma unroll
                for (int qs = 0; qs < 2; ++qs)
#pragma unroll
                    for (int jp = 0; jp < 2; ++jp) { u32x4 w; float p[8];
#pragma unroll
                        for (int e = 0; e < 8; ++e) { p[e] = __builtin_amdgcn_exp2f(sv[qs][8 * jp + e]); lsum[qs] += p[e]; }
                        w.x = pk2(p[0], p[1]); w.y = pk2(p[2], p[3]); w.z = pk2(p[4], p[5]); w.w = pk2(p[6], p[7]); pb[qs][jp] = __builtin_bit_cast(bf16x8, w); }
#pragma unroll
                for (int vt = 0; vt < 4; ++vt)
#pragma unroll
                    for (int jp = 0; jp < 2; ++jp) { const bf16x8 vf = *(const LAS bf16x8*)(Vb + vt * 4096 + (((kk * 4 + jp * 2 + hb) ^ vx) << 4));
                        o[0][vt] = MFMA32(vf, pb[0][jp], o[0][vt]); o[1][vt] = MFMA32(vf, pb[1][jp], o[1][vt]); }
            }
        }
#undef ISSUE_TILE
#undef KROW0
        __syncthreads();
        float cm[2];
#pragma unroll
        for (int qs = 0; qs < 2; ++qs) { const float lt = lsum[qs] + __shfl_xor(lsum[qs], 32); cm[qs] = m ? lam / lt : 1.0f / lt; }
        if (m) {
#pragma unroll
            for (int qs = 0; qs < 2; ++qs)
#pragma unroll
                for (int vt = 0; vt < 4; ++vt)
#pragma unroll
                    for (int i = 0; i < 16; ++i) xch[((g * 2 + qs) * 64 + vt * 16 + i) * 64 + lane] = o[qs][vt][i] * cm[qs];
        }
        __syncthreads();
        if (!m) {
#pragma unroll
            for (int qs = 0; qs < 2; ++qs) {
                float ss = 0.f;
#pragma unroll
                for (int vt = 0; vt < 4; ++vt)
#pragma unroll
                    for (int i = 0; i < 16; ++i) { const float v = o[qs][vt][i] * cm[qs] - xch[((g * 2 + qs) * 64 + vt * 16 + i) * 64 + lane]; o[qs][vt][i] = v; ss += v * v; }
                ss += __shfl_xor(ss, 32);
                const float rn = rsqrtf(ss * (1.0f / 128.0f) + 1e-6f) * lamfac;
                bf16_t* op = ATT + (size_t)(qrow0 + g * 64 + qs * 32 + l32) * 512 + h * 128;
#pragma unroll
                for (int vt = 0; vt < 4; ++vt)
#pragma unroll
                    for (int q4 = 0; q4 < 4; ++q4) { const int vd = vt * 32 + q4 * 8 + hh * 4; const f32x4 g4 = *(const LAS f32x4*)(sgl + vd);
                        u32x2 w; w.x = pk2(o[qs][vt][4 * q4] * rn * g4[0], o[qs][vt][4 * q4 + 1] * rn * g4[1]); w.y = pk2(o[qs][vt][4 * q4 + 2] * rn * g4[2], o[qs][vt][4 * q4 + 3] * rn * g4[3]);
                        *(u32x2*)(op + vd) = w; }
            }
        }
    }
}

DI int crow_(int reg, int h) { return (reg & 3) + 8 * (reg >> 2) + 4 * h; }
DI int swz(int row, int chunk) { return row * 128 + ((chunk ^ ((row >> 1) & 7)) << 4); }
constexpr int SL_A = 0, SL_B = 8192, SL_K = 16384, SL_V = 24576, SL_T = 32768, SL_R = 40960, WAVE_LDS = 49152;
typedef LAS unsigned char* lds_t;
DI bf16x8 fragN(lds_t base, int row, int k0, int h) { return *(const LAS bf16x8*)(base + swz(row, (k0 >> 3) + h)); }
DI bf16x8 fragK(lds_t base, int row, int kt, int s, int h) { const int c0 = 4 * kt + 2 * s; const u32x2 a = *(const LAS u32x2*)(base + swz(row, c0) + 8 * h), b = *(const LAS u32x2*)(base + swz(row, c0 + 1) + 8 * h);
    return __builtin_bit_cast(bf16x8, (u32x4){a.x, a.y, b.x, b.y}); }
DI void zero_acc(f32x16 (&acc)[2][2]) {
#pragma unroll
    for (int a = 0; a < 2; ++a)
#pragma unroll
        for (int b = 0; b < 2; ++b)
#pragma unroll
            for (int i = 0; i < 16; ++i) acc[a][b][i] = 0.f; }
DI void mm_nn(f32x16 (&acc)[2][2], lds_t A, lds_t B, int l32, int h) {
    l32 = launder(l32); h = launder(h);
    bf16x8 af[4][2], bf[4][2];
#pragma unroll
    for (int ks = 0; ks < 4; ++ks)
#pragma unroll
        for (int q = 0; q < 2; ++q) { af[ks][q] = fragN(A, 32 * q + l32, 16 * ks, h); bf[ks][q] = fragN(B, 32 * q + l32, 16 * ks, h); }
#pragma unroll
    for (int ks = 0; ks < 4; ++ks)
#pragma unroll
        for (int ra = 0; ra < 2; ++ra)
#pragma unroll
            for (int cb = 0; cb < 2; ++cb) acc[ra][cb] = MFMA32(af[ks][ra], bf[ks][cb], acc[ra][cb]);
}
DI void mm_nn_lp(f32x16 (&acc)[2][2], lds_t A, lds_t B, int l32, int h) {
    l32 = launder(l32); h = launder(h);
#pragma unroll
    for (int kp = 0; kp < 2; ++kp) { bf16x8 af[2][2], bf[2][2];
#pragma unroll
        for (int ks = 0; ks < 2; ++ks)
#pragma unroll
            for (int q = 0; q < 2; ++q) { af[ks][q] = fragN(A, 32 * q + l32, 16 * (2 * kp + ks), h); bf[ks][q] = fragN(B, 32 * q + l32, 16 * (2 * kp + ks), h); }
#pragma unroll
        for (int ks = 0; ks < 2; ++ks)
#pragma unroll
            for (int ra = 0; ra < 2; ++ra)
#pragma unroll
                for (int cb = 0; cb < 2; ++cb) acc[ra][cb] = MFMA32(af[ks][ra], bf[ks][cb], acc[ra][cb]); }
}
DI void mm_xt(f32x16 (&acc)[2][2], const bf16x8 (&xf)[2][2][2], lds_t Y, int l32, int h) {
    l32 = launder(l32); h = launder(h);
#pragma unroll
    for (int it = 0; it < 2; ++it)
#pragma unroll
        for (int s = 0; s < 2; ++s) { bf16x8 yf[2];
#pragma unroll
            for (int vt = 0; vt < 2; ++vt) yf[vt] = fragK(Y, 32 * vt + l32, it, s, h);
#pragma unroll
            for (int tt = 0; tt < 2; ++tt)
#pragma unroll
                for (int vt = 0; vt < 2; ++vt) acc[vt][tt] = MFMA32(yf[vt], xf[it][tt][s], acc[vt][tt]); }
}
DI void mm_st(f32x16 (&acc)[2][2], lds_t A, const bf16x8 (&sf)[2][2][2], int l32, int h) {
    l32 = launder(l32); h = launder(h);
#pragma unroll
    for (int ct = 0; ct < 2; ++ct)
#pragma unroll
        for (int s = 0; s < 2; ++s) { bf16x8 af[2];
#pragma unroll
            for (int tt = 0; tt < 2; ++tt) af[tt] = fragK(A, 32 * tt + l32, ct, s, h);
#pragma unroll
            for (int tt = 0; tt < 2; ++tt)
#pragma unroll
                for (int vt = 0; vt < 2; ++vt) acc[vt][tt] = MFMA32(sf[ct][vt][s], af[tt], acc[vt][tt]); }
}
DI bf16x8 pack_regs(const f32x16& x, int s) { u32x4 w; w.x = pk2(x[8 * s], x[8 * s + 1]); w.y = pk2(x[8 * s + 2], x[8 * s + 3]); w.z = pk2(x[8 * s + 4], x[8 * s + 5]); w.w = pk2(x[8 * s + 6], x[8 * s + 7]); return __builtin_bit_cast(bf16x8, w); }
template <int INCL> DI void pack_masked(const f32x16 (&acc)[2][2], bf16x8 (&xf)[2][2][2], int l32, int h) {
#pragma unroll
    for (int it = 0; it < 2; ++it)
#pragma unroll
        for (int tt = 0; tt < 2; ++tt) { f32x16 m;
#pragma unroll
            for (int r = 0; r < 16; ++r) { const int i = 32 * it + crow_(r, h), t = 32 * tt + l32; m[r] = (INCL ? i <= t : i < t) ? acc[it][tt][r] : 0.f; }
            xf[it][tt][0] = pack_regs(m, 0); xf[it][tt][1] = pack_regs(m, 1); }
}
DI void store_tm(const f32x16 (&acc)[2][2], lds_t img, int l32, int h) {
    l32 = launder(l32); h = launder(h);
#pragma unroll
    for (int a = 0; a < 2; ++a)
#pragma unroll
        for (int b = 0; b < 2; ++b)
#pragma unroll
            for (int q = 0; q < 4; ++q) { u32x2 w; w.x = pk2(acc[a][b][4 * q], acc[a][b][4 * q + 1]); w.y = pk2(acc[a][b][4 * q + 2], acc[a][b][4 * q + 3]);
                *(LAS u32x2*)(img + swz(32 * b + l32, 4 * a + q) + 8 * h) = w; }
}
DI void solve_rows(lds_t rhs, lds_t tab, lds_t out, int lane) {
    lane = launder(lane);
    lds_t orow = out + lane * 128; const int sw = (lane >> 1) & 7; const int rb = ((lane >> 3) << 4), rl = (lane & 7) * 2;
    const int l32 = lane & 31, h = lane >> 5;
#define DOT4(a, cw, xw, j0) asm volatile("v_dot2c_f32_bf16 %0, %4, %20\n\tv_dot2c_f32_bf16 %1, %8, %20\n\tv_dot2c_f32_bf16 %2, %12, %20\n\tv_dot2c_f32_bf16 %3, %16, %20\n\t" \
                              "v_dot2c_f32_bf16 %0, %5, %21\n\tv_dot2c_f32_bf16 %1, %9, %21\n\tv_dot2c_f32_bf16 %2, %13, %21\n\tv_dot2c_f32_bf16 %3, %17, %21\n\t" \
                              "v_dot2c_f32_bf16 %0, %6, %22\n\tv_dot2c_f32_bf16 %1, %10, %22\n\tv_dot2c_f32_bf16 %2, %14, %22\n\tv_dot2c_f32_bf16 %3, %18, %22\n\t" \
                              "v_dot2c_f32_bf16 %0, %7, %23\n\tv_dot2c_f32_bf16 %1, %11, %23\n\tv_dot2c_f32_bf16 %2, %15, %23\n\tv_dot2c_f32_bf16 %3, %19, %23\n\ts_nop 3" \
                : "+v"(a[j0]), "+v"(a[j0 + 1]), "+v"(a[j0 + 2]), "+v"(a[j0 + 3]) \
                : "v"(cw[j0].x), "v"(cw[j0].y), "v"(cw[j0].z), "v"(cw[j0].w), "v"(cw[j0 + 1].x), "v"(cw[j0 + 1].y), "v"(cw[j0 + 1].z), "v"(cw[j0 + 1].w), \
                  "v"(cw[j0 + 2].x), "v"(cw[j0 + 2].y), "v"(cw[j0 + 2].z), "v"(cw[j0 + 2].w), "v"(cw[j0 + 3].x), "v"(cw[j0 + 3].y), "v"(cw[j0 + 3].z), "v"(cw[j0 + 3].w), \
                  "v"(xw.x), "v"(xw.y), "v"(xw.z), "v"(xw.w))
    f32x16 u0[2], u1[2], zero;
#pragma unroll
    for (int i = 0; i < 16; ++i) { zero[i] = 0.f; u1[0][i] = 0.f; u1[1][i] = 0.f; u0[0][i] = 0.f; u0[1][i] = 0.f; }
#pragma unroll
    for (int b = 0; b < 4; ++b) {
        const int tA = 16 * b, tB = tA + 8, cA = 2 * b, cB = cA + 1;
        float a[8], a2[8]; u32x4 dg0[8], cw[8], dg1[8];
#pragma unroll
        for (int j = 0; j < 8; ++j) { const int t = tA + j, u = tB + j;
            a[j] = bf2f(*(const LAS bf16_t*)(rhs + t * 128 + (rb ^ (((t >> 1) & 7) << 4)) + rl)); a2[j] = bf2f(*(const LAS bf16_t*)(rhs + u * 128 + (rb ^ (((u >> 1) & 7) << 4)) + rl)); }
#pragma unroll
        for (int j = 0; j < 8; ++j) { const int t = tA + j, u = tB + j;
            dg0[j] = *(const LAS u32x4*)(tab + t * 128 + ((cA ^ ((t >> 1) & 7)) << 4)); cw[j] = *(const LAS u32x4*)(tab + u * 128 + ((cA ^ ((u >> 1) & 7)) << 4)); dg1[j] = *(const LAS u32x4*)(tab + u * 128 + ((cB ^ ((u >> 1) & 7)) << 4)); }
        if (b > 0) { const int k0 = 16 * (b - 1); const bf16x8 xb0 = fragN(out, l32, k0, h), xb1 = fragN(out, 32 + l32, k0, h);
            if (b == 1) { const bf16x8 af0 = fragN(tab, l32, k0, h); u0[0] = MFMA32(af0, xb0, zero); u0[1] = MFMA32(af0, xb1, zero); }
            const bf16x8 af1 = fragN(tab, 32 + l32, k0, h); u1[0] = MFMA32(af1, xb0, u1[0]); u1[1] = MFMA32(af1, xb1, u1[1]);
            const int R0 = (b == 2) ? 0 : 8;
#pragma unroll
            for (int i = 0; i < 8; ++i) { const float X = (b == 1) ? u0[0][R0 + i] : u1[0][R0 + i], Y = (b == 1) ? u0[1][R0 + i] : u1[1][R0 + i];
                const auto r = __builtin_amdgcn_permlane32_swap(__float_as_uint(X), __float_as_uint(Y), false, false);
                const float lo = __uint_as_float(r[0]), hi = __uint_as_float(r[1]);
                if (i < 4) { a[i] += lo; a[4 + i] += hi; } else { a2[i - 4] += lo; a2[i] += hi; } }
        }
#pragma unroll
        for (int j = 1; j < 8; ++j) { float cf[8]; unpack8(dg0[j], cf);
#pragma unroll
            for (int q = 0; q < 8; ++q) if (q < j) a[j] += cf[q] * a[q]; }
        const u32x4 x0 = pack8(a);
        *(LAS u32x4*)(orow + ((cA ^ sw) << 4)) = x0;
        DOT4(a2, cw, x0, 0); DOT4(a2, cw, x0, 4);
#pragma unroll
        for (int j = 1; j < 8; ++j) { float cf[8]; unpack8(dg1[j], cf);
#pragma unroll
            for (int q = 0; q < 8; ++q) if (q < j) a2[j] += cf[q] * a2[q]; }
        *(LAS u32x4*)(orow + ((cB ^ sw) << 4)) = pack8(a2);
    }
#undef DOT4
}
struct ScanTask { int chain, h, r0, sgn; };
DI int scan_order(int q) { const int rbk = q >> 5, j = q & 31, dir = j & 1, bh = j >> 1, chain = dir * 16 + bh;
    const int ck = dir ? (rbk < 4 ? 3 - rbk : 4 + 255 - (rbk - 4)) : rbk; return chain * NCHUNK + ck; }
DI int scan_deal(int bid, int slot3, int trip, int G) {
    if (G != 256) { const int q = bid * 3 + slot3 + trip * G * 3; return q < 32 * NCHUNK ? scan_order(q) : -1; }
    const int xcd = bid & 7, sl = (bid >> 3) * 3 + slot3, grp = (trip * 8 + xcd) * 6 + sl / 16, mem = sl % 16;
    if (grp >= 2 * NCHUNK) return -1;
    const int rbk = grp >> 1, b = grp & 1, dir = mem & 1, hd = mem >> 1, chain = dir * 16 + b * 8 + hd;
    const int ck = dir ? (rbk < 4 ? 3 - rbk : 4 + 255 - (rbk - 4)) : rbk; return chain * NCHUNK + ck; }

DI ScanTask scan_task(int task) { ScanTask T; T.chain = task / NCHUNK; const int ck = task % NCHUNK, dir = T.chain >> 4, b = (T.chain >> 3) & 1; T.h = T.chain & 7;
    int base, len, c2; if (ck < 4) { base = b * CTXL; len = CTXL; c2 = ck; } else { base = NCTX + b * SEQ; len = SEQ; c2 = ck - 4; }
    T.r0 = dir ? base + len - 1 - 64 * c2 : base + 64 * c2; T.sgn = dir ? -1 : 1; return T; }
DI void write_cm_row(lds_t img, const unsigned (&pk)[32], int lane) {
    lane = launder(lane);
#pragma unroll
    for (int ch = 0; ch < 8; ++ch) *(LAS u32x4*)(img + swz(lane, ch)) = (u32x4){pk[4 * ch], pk[4 * ch + 1], pk[4 * ch + 2], pk[4 * ch + 3]};
}
DI void stage_raw(const bf16_t* src, const ScanTask& T, lds_t dst, int lane) {
    lane = launder(lane);
#pragma unroll
    for (int i = 0; i < 8; ++i) { const int q = lane + 64 * i, t = q >> 3, c8 = q & 7;
        *(LAS u32x4*)(dst + swz(t, c8)) = *(const u32x4*)(src + (size_t)(T.r0 + T.sgn * t) * 512 + T.h * 64 + c8 * 8); }
}
template <int N> DI void stage_raw_n(const bf16_t* const (&src)[N], const int (&slot)[N], const ScanTask& T, lds_t wl, int lane) {
    lane = launder(lane);
    u32x4 v[N][8];
    __builtin_amdgcn_sched_barrier(0);
#pragma unroll
    for (int p = 0; p < N; ++p)
#pragma unroll
        for (int i = 0; i < 8; ++i) { const int q = lane + 64 * i, t = q >> 3, c8 = q & 7; v[p][i] = *(const u32x4*)(src[p] + (size_t)(T.r0 + T.sgn * t) * 512 + T.h * 64 + c8 * 8); }
    __builtin_amdgcn_sched_barrier(0);
#pragma unroll
    for (int p = 0; p < N; ++p)
#pragma unroll
        for (int i = 0; i < 8; ++i) { const int q = lane + 64 * i, t = q >> 3, c8 = q & 7; *(LAS u32x4*)(wl + slot[p] + swz(t, c8)) = v[p][i]; }
    __builtin_amdgcn_sched_barrier(0);
}
DI void read_col(lds_t img, unsigned (&pk)[32], int lane) {
    lane = launder(lane);
    const int tw = ((lane >> 3) << 4), tb = (lane & 7) * 2;
    unsigned lo[32], hi[32];
#pragma unroll
    for (int t2 = 0; t2 < 32; ++t2) { const int ta = 2 * t2, tc = 2 * t2 + 1;
        lo[t2] = *(const LAS bf16_t*)(img + ta * 128 + (tw ^ (((ta >> 1) & 7) << 4)) + tb); hi[t2] = *(const LAS bf16_t*)(img + tc * 128 + (tw ^ (((tc >> 1) & 7) << 4)) + tb); }
#pragma unroll
    for (int t2 = 0; t2 < 32; ++t2) pk[t2] = lo[t2] | (hi[t2] << 16);
}
template <bool P3>
DI float scan_prep(const Frame& F, int l, const ScanTask& T, lds_t wl, int lane) {
    const int dir = T.chain >> 4;
    if (P3) { const bf16_t* const src[6] = {wsp<bf16_t>(F, OFF_RKK), wsp<bf16_t>(F, OFF_RK), wsp<bf16_t>(F, dir ? OFF_AB : OFF_AF), wsp<bf16_t>(F, dir ? OFF_EB : OFF_EF), wsp<bf16_t>(F, OFF_RV), wsp<bf16_t>(F, OFF_RR)};
        const int slot[6] = {SL_A, SL_K, SL_B, SL_T, SL_V, SL_R}; stage_raw_n<6>(src, slot, T, wl, lane); }
    else { const bf16_t* const src[5] = {wsp<bf16_t>(F, OFF_RKK), wsp<bf16_t>(F, OFF_RK), wsp<bf16_t>(F, dir ? OFF_AB : OFF_AF), wsp<bf16_t>(F, dir ? OFF_EB : OFF_EF), wsp<bf16_t>(F, OFF_RV)};
        const int slot[5] = {SL_A, SL_K, SL_B, SL_T, SL_V}; stage_raw_n<5>(src, slot, T, wl, lane); }
    const float ka = F.in[I_KA][(size_t)l * 512 + T.h * 64 + lane];
    float E2 = 0.f, gprev = 1.f;
    lane = launder(lane);
    const int tw = ((lane >> 3) << 4), tb = (lane & 7) * 2;
#pragma unroll 1
    for (int t8 = 0; t8 < 8; ++t8) {
        float kk_[8], k_[8], al_[8], e_[8], r_[8]; int off_[8];
#pragma unroll
        for (int j = 0; j < 8; ++j) { const int t = t8 * 8 + j; off_[j] = t * 128 + (tw ^ (((t >> 1) & 7) << 4)) + tb;
            kk_[j] = bf2f(*(const LAS bf16_t*)(wl + SL_A + off_[j])); k_[j] = bf2f(*(const LAS bf16_t*)(wl + SL_K + off_[j])); al_[j] = bf2f(*(const LAS bf16_t*)(wl + SL_B + off_[j]));
            e_[j] = bf2f(*(const LAS bf16_t*)(wl + SL_T + off_[j])); r_[j] = P3 ? bf2f(*(const LAS bf16_t*)(wl + SL_R + off_[j])) : 0.f; }
#pragma unroll
        for (int j = 0; j < 8; ++j) {
            E2 += e_[j] * 1.4426950408889634f;
            const float g = __builtin_amdgcn_exp2f(-E2), ex = __builtin_amdgcn_rcpf(g);
            const float at = -kk_[j] * gprev, bh = kk_[j] * al_[j] * ex, kh = k_[j] * (1.0f + (al_[j] - 1.0f) * ka) * ex;
            gprev = g;
            if (P3) *(LAS bf16_t*)(wl + SL_R + off_[j]) = f2bf(r_[j] * g);
            *(LAS bf16_t*)(wl + SL_A + off_[j]) = f2bf(at); *(LAS bf16_t*)(wl + SL_B + off_[j]) = f2bf(bh); *(LAS bf16_t*)(wl + SL_K + off_[j]) = f2bf(kh);
        }
    }
    { unsigned vcm[32]; read_col(wl + SL_V, vcm, lane); write_cm_row(wl + SL_V, vcm, lane); }
    return gprev;
}
DI void make_table(lds_t wl, int l32, int h, int slot_b = SL_B) {
    l32 = launder(l32); h = launder(h);
    f32x16 acc[2][2]; zero_acc(acc); mm_nn(acc, wl + slot_b, wl + SL_A, l32, h);
#pragma unroll
    for (int it = 0; it < 2; ++it)
#pragma unroll
        for (int tt = 0; tt < 2; ++tt)
#pragma unroll
            for (int q = 0; q < 4; ++q) { const int t = 32 * tt + l32, i0 = 32 * it + 8 * q + 4 * h; float v[4];
#pragma unroll
                for (int e = 0; e < 4; ++e) v[e] = (i0 + e < t) ? acc[it][tt][4 * q + e] : 0.f;
                u32x2 w; w.x = pk2(v[0], v[1]); w.y = pk2(v[2], v[3]);
                *(LAS u32x2*)(wl + SL_T + swz(t, 4 * it + q) + 8 * h) = w; }
}
DI void scan_pass1(const Frame& F, int l) {
    const int lane = F.lane, l32 = lane & 31, h = lane >> 5, pr = F.wid >> 1, role = F.wid & 1;
    lds_t wl = F.lds + (pr < 3 ? pr : 0) * WAVE_LDS; LAS float* gtab = (LAS float*)(F.lds + MISC_OFF + 512 + (pr < 3 ? pr : 0) * 256);
    u32x4* MP = wsp<u32x4>(F, OFF_MP); u32x4* NS = wsp<u32x4>(F, OFF_NS);
    const int ntrip = (32 * NCHUNK + F.G * 3 - 1) / (F.G * 3);
    u32x4 pf[3][8];
#define P1_REQUEST(task_) do { const ScanTask Tq_ = scan_task(task_); const int dq_ = Tq_.chain >> 4; const int ln_ = launder(lane); \
        const bf16_t* s0_ = role ? wsp<bf16_t>(F, OFF_RK) : wsp<bf16_t>(F, OFF_RKK); const bf16_t* s1_ = role ? wsp<bf16_t>(F, OFF_RV) : wsp<bf16_t>(F, dq_ ? OFF_AB : OFF_AF); const bf16_t* s2_ = wsp<bf16_t>(F, dq_ ? OFF_EB : OFF_EF); \
        __builtin_amdgcn_sched_barrier(0); \
        _Pragma("unroll") for (int i_ = 0; i_ < 8; ++i_) { const int q_ = ln_ + 64 * i_, t_ = q_ >> 3, c8_ = q_ & 7; const size_t ro_ = (size_t)(Tq_.r0 + Tq_.sgn * t_) * 512 + Tq_.h * 64 + c8_ * 8; \
            pf[0][i_] = *(const u32x4*)(s0_ + ro_); pf[1][i_] = *(const u32x4*)(s1_ + ro_); if (role == 0) pf[2][i_] = *(const u32x4*)(s2_ + ro_); else asm volatile("" : "=v"(pf[2][i_].x), "=v"(pf[2][i_].y), "=v"(pf[2][i_].z), "=v"(pf[2][i_].w)); } \
        __builtin_amdgcn_sched_barrier(0); } while (0)
#define P1_UNDEF() do { _Pragma("unroll") for (int p_ = 0; p_ < 3; ++p_) _Pragma("unroll") for (int i_ = 0; i_ < 8; ++i_) asm volatile("" : "=v"(pf[p_][i_].x), "=v"(pf[p_][i_].y), "=v"(pf[p_][i_].z), "=v"(pf[p_][i_].w)); } while (0)
    { const int t0_ = pr < 3 ? scan_deal(F.bid, pr, 0, F.G) : -1; if (t0_ >= 0) P1_REQUEST(t0_); else P1_UNDEF(); }
    for (int trip = 0; trip < ntrip; ++trip) {
        const int task_ = pr < 3 ? scan_deal(F.bid, pr, trip, F.G) : -1; const bool on = task_ >= 0; const int task = on ? task_ : 0;
        ScanTask T = scan_task(on ? task : 0); const int dir = T.chain >> 4; (void)dir;
        const int tw = ((launder(lane) >> 3) << 4), tb = (launder(lane) & 7) * 2;
        if (on) { const int ln_ = launder(lane);
#pragma unroll
            for (int i_ = 0; i_ < 8; ++i_) { const int q_ = ln_ + 64 * i_, t_ = q_ >> 3, c8_ = q_ & 7;
                *(LAS u32x4*)(wl + (role ? SL_K : SL_A) + swz(t_, c8_)) = pf[0][i_]; *(LAS u32x4*)(wl + (role ? SL_V : SL_B) + swz(t_, c8_)) = pf[1][i_]; if (role == 0) *(LAS u32x4*)(wl + SL_T + swz(t_, c8_)) = pf[2][i_]; } }
        __syncthreads();
        if (on) {
            const float ka = F.in[I_KA][(size_t)l * 512 + T.h * 64 + lane];
            float E2 = 0.f, gprev = 1.f;
#pragma unroll 1
            for (int t8 = 0; t8 < 8; ++t8) {
                float x_[8], al_[8], e_[8]; int off_[8];
#pragma unroll
                for (int j = 0; j < 8; ++j) { const int t = t8 * 8 + j; off_[j] = t * 128 + (tw ^ (((t >> 1) & 7) << 4)) + tb;
                    x_[j] = bf2f(*(const LAS bf16_t*)(wl + (role ? SL_K : SL_A) + off_[j])); al_[j] = bf2f(*(const LAS bf16_t*)(wl + SL_B + off_[j])); e_[j] = bf2f(*(const LAS bf16_t*)(wl + SL_T + off_[j])); }
#pragma unroll
                for (int j = 0; j < 8; ++j) {
                    E2 += e_[j] * 1.4426950408889634f;
                    const float g = __builtin_amdgcn_exp2f(-E2), ex = __builtin_amdgcn_rcpf(g);
                    if (role == 0) { *(LAS bf16_t*)(wl + SL_A + off_[j]) = f2bf(-x_[j] * gprev); *(LAS bf16_t*)(wl + SL_R + off_[j]) = f2bf(x_[j] * al_[j] * ex); }
                    else *(LAS bf16_t*)(wl + SL_K + off_[j]) = f2bf(x_[j] * (1.0f + (al_[j] - 1.0f) * ka) * ex);
                    gprev = g;
                }
            }
            if (role == 0) gtab[lane] = gprev;
            else { unsigned vcm[32]; read_col(wl + SL_V, vcm, lane); write_cm_row(wl + SL_V, vcm, lane); }
        }
        __syncthreads();
        if (on) {
            if (role == 0) make_table(wl, l32, h, SL_R);
            else { bf16x8 xf[2][2][2];
                { f32x16 acc[2][2]; zero_acc(acc); mm_nn(acc, wl + SL_K, wl + SL_A, l32, h); pack_masked<0>(acc, xf, l32, h); }
                __builtin_amdgcn_sched_barrier(0);
                { f32x16 acc[2][2]; zero_acc(acc); mm_xt(acc, xf, wl + SL_V, l32, h); store_tm(acc, wl + SL_B, l32, h); } }
        }
        __syncthreads();
        if (on) {
            if (role == 0) { unsigned bcm[32]; read_col(wl + SL_R, bcm, lane); __builtin_amdgcn_sched_barrier(0);
                solve_rows(wl + SL_A, wl + SL_T, wl + SL_R, lane); __builtin_amdgcn_sched_barrier(0);
                write_cm_row(wl + SL_A, bcm, lane); }
            else { unsigned kcm[32]; read_col(wl + SL_K, kcm, lane); __builtin_amdgcn_sched_barrier(0);
                solve_rows(wl + SL_B, wl + SL_T, wl + SL_K, lane); __builtin_amdgcn_sched_barrier(0);
                write_cm_row(wl + SL_B, kcm, lane); }
        }
        __syncthreads();
        { const int tn_ = (pr < 3 && trip + 1 < ntrip) ? scan_deal(F.bid, pr, trip + 1, F.G) : -1; if (tn_ >= 0) P1_REQUEST(tn_); else P1_UNDEF(); }
        if (on) {
            if (role == 0) { u32x4* mp = MP + (size_t)task * 512 + launder(lane);
                f32x16 acc[2][2]; zero_acc(acc); mm_nn_lp(acc, wl + SL_R, wl + SL_A, l32, h);
#pragma unroll
                for (int ct = 0; ct < 2; ++ct)
#pragma unroll
                    for (int cp = 0; cp < 2; ++cp) { const float gc = gtab[32 * cp + launder(l32)]; f32x16 m;
#pragma unroll
                        for (int r = 0; r < 16; ++r) m[r] = (acc[ct][cp][r] + ((ct == cp && crow_(r, h) == l32) ? 1.0f : 0.0f)) * gc;
                        mp[((ct * 2 + cp) * 2 + 0) * 64] = __builtin_bit_cast(u32x4, pack_regs(m, 0)); mp[((ct * 2 + cp) * 2 + 1) * 64] = __builtin_bit_cast(u32x4, pack_regs(m, 1)); }
            } else { u32x4* ns = NS + (size_t)task * 512 + launder(lane);
                f32x16 acc[2][2]; zero_acc(acc); mm_nn_lp(acc, wl + SL_A, wl + SL_K, l32, h); mm_nn_lp(acc, wl + SL_B, wl + SL_V, l32, h);
#pragma unroll
                for (int cp = 0; cp < 2; ++cp)
#pragma unroll
                    for (int vt = 0; vt < 2; ++vt) { f32x16 m;
#pragma unroll
                        for (int q = 0; q < 4; ++q) { const f32x4 g4 = *(const LAS f32x4*)(gtab + 32 * cp + 8 * q + 4 * h);
#pragma unroll
                            for (int e = 0; e < 4; ++e) m[4 * q + e] = acc[cp][vt][4 * q + e] * g4[e]; }
                        ns[((cp * 2 + vt) * 2 + 0) * 64] = __builtin_bit_cast(u32x4, pack_regs(m, 0)); ns[((cp * 2 + vt) * 2 + 1) * 64] = __builtin_bit_cast(u32x4, pack_regs(m, 1)); }
            }
        }
        __syncthreads();
    }
#undef P1_REQUEST
#undef P1_UNDEF
}
DI void scan_pass2(const Frame& F) {
    if (F.wid != 0) return;
    const int lane = F.lane;
    for (int task = F.bid; task < 64; task += F.G) {
        const int chain = task >> 1, vt = task & 1;
        const u32x4* MP = wsp<u32x4>(F, OFF_MP) + (size_t)chain * NCHUNK * 512 + lane; u32x4* NS = wsp<u32x4>(F, OFF_NS) + (size_t)chain * NCHUNK * 512 + lane;
        u32x4 sf[2][2], mA[8], nA[2][2], mB[8], nB[2][2], mC[8], nC[2][2];
#define P2_LOAD(m_, n_, ck_) do { _Pragma("unroll") for (int i_ = 0; i_ < 8; ++i_) m_[i_] = MP[(size_t)(ck_) * 512 + i_ * 64]; \
        _Pragma("unroll") for (int a_ = 0; a_ < 2; ++a_) _Pragma("unroll") for (int st_ = 0; st_ < 2; ++st_) n_[a_][st_] = NS[(size_t)(ck_) * 512 + ((a_ * 2 + vt) * 2 + st_) * 64]; } while (0)
#define P2_STEP(m_, n_, ck_) do { \
        _Pragma("unroll") for (int a_ = 0; a_ < 2; ++a_) _Pragma("unroll") for (int st_ = 0; st_ < 2; ++st_) NS[(size_t)(ck_) * 512 + ((a_ * 2 + vt) * 2 + st_) * 64] = sf[a_][st_];        \
        f32x16 acc_[2]; \
        _Pragma("unroll") for (int cp_ = 0; cp_ < 2; ++cp_) _Pragma("unroll") for (int st_ = 0; st_ < 2; ++st_) { float f_[8]; unpack8(n_[cp_][st_], f_); \
            _Pragma("unroll") for (int j_ = 0; j_ < 8; ++j_) acc_[cp_][8 * st_ + j_] = f_[j_]; } \
        _Pragma("unroll") for (int ct_ = 0; ct_ < 2; ++ct_) _Pragma("unroll") for (int st_ = 0; st_ < 2; ++st_) _Pragma("unroll") for (int cp_ = 0; cp_ < 2; ++cp_) \
            acc_[cp_] = MFMA32(__builtin_bit_cast(bf16x8, m_[(ct_ * 2 + cp_) * 2 + st_]), __builtin_bit_cast(bf16x8, sf[ct_][st_]), acc_[cp_]); \
        _Pragma("unroll") for (int ct_ = 0; ct_ < 2; ++ct_) { sf[ct_][0] = __builtin_bit_cast(u32x4, pack_regs(acc_[ct_], 0)); sf[ct_][1] = __builtin_bit_cast(u32x4, pack_regs(acc_[ct_], 1)); } } while (0)
#pragma unroll
        for (int a = 0; a < 2; ++a)
#pragma unroll
            for (int st = 0; st < 2; ++st) sf[a][st] = (u32x4){0u, 0u, 0u, 0u};
        P2_LOAD(mA, nA, 0); P2_LOAD(mB, nB, 1);
        for (int ck = 0; ck < NCHUNK; ck += 3) {
            { const int nx = ck + 2 < NCHUNK ? ck + 2 : NCHUNK - 1; P2_LOAD(mC, nC, nx); }
            P2_STEP(mA, nA, ck);
            if (ck + 1 < NCHUNK) { { const int nx = ck + 3 < NCHUNK ? ck + 3 : NCHUNK - 1; P2_LOAD(mA, nA, nx); } P2_STEP(mB, nB, ck + 1); }
            if (ck + 2 < NCHUNK) { { const int nx = ck + 4 < NCHUNK ? ck + 4 : NCHUNK - 1; P2_LOAD(mB, nB, nx); } P2_STEP(mC, nC, ck + 2); }
        }
#undef P2_LOAD
#undef P2_STEP
    }
}
DI void scan_pass3(const Frame& F, int l) {
    if (F.wid >= 3) return;
    const int lane = F.lane, l32 = lane & 31, h = lane >> 5;
    lds_t wl = F.lds + F.wid * WAVE_LDS;
    const u32x4* NS = wsp<u32x4>(F, OFF_NS);
    const int ntrip3 = (32 * NCHUNK + F.G * 3 - 1) / (F.G * 3);
    for (int trip = 0; trip < ntrip3; ++trip) {
        const int task = scan_deal(F.bid, F.wid, trip, F.G); if (task < 0) continue;
        const ScanTask T = scan_task(task);
        (void)scan_prep<true>(F, l, T, wl, lane);
        make_table(wl, l32, h);
#define SB_ __builtin_amdgcn_sched_barrier(0)
#define LOAD_SF() do { const u32x4* ns = NS + (size_t)task * 512 + lane; _Pragma("unroll") for (int i = 0; i < 8; ++i) sf[i >> 2][(i >> 1) & 1][i & 1] = __builtin_bit_cast(bf16x8, ns[i * 64]); } while (0)
        bf16x8 xf[2][2][2], xg[2][2][2];
        { f32x16 acc[2][2]; zero_acc(acc); mm_nn(acc, wl + SL_K, wl + SL_A, l32, h); pack_masked<0>(acc, xf, l32, h); }
        SB_;
        { bf16x8 sf[2][2][2]; LOAD_SF(); f32x16 acc[2][2]; zero_acc(acc); mm_st(acc, wl + SL_A, sf, l32, h); SB_; mm_xt(acc, xf, wl + SL_V, l32, h); SB_; store_tm(acc, wl + SL_A, l32, h); }
        SB_;
        { f32x16 acc[2][2]; zero_acc(acc); mm_nn(acc, wl + SL_B, wl + SL_R, l32, h); pack_masked<1>(acc, xf, l32, h); }
        SB_;
        solve_rows(wl + SL_A, wl + SL_T, wl + SL_B, lane);
        SB_;
        unsigned tch[7]; const int tn_ = trip + 1 < ntrip3 ? scan_deal(F.bid, F.wid, trip + 1, F.G) : -1;
        if (tn_ >= 0) { const ScanTask Tn = scan_task(tn_); const int dn = Tn.chain >> 4; const size_t ro = (size_t)(Tn.r0 + Tn.sgn * launder(lane)) * 512 + Tn.h * 64;
            tch[0] = *(const unsigned*)(wsp<bf16_t>(F, OFF_RKK) + ro); tch[1] = *(const unsigned*)(wsp<bf16_t>(F, OFF_RK) + ro); tch[2] = *(const unsigned*)(wsp<bf16_t>(F, dn ? OFF_AB : OFF_AF) + ro);
            tch[3] = *(const unsigned*)(wsp<bf16_t>(F, dn ? OFF_EB : OFF_EF) + ro); tch[4] = *(const unsigned*)(wsp<bf16_t>(F, OFF_RV) + ro); tch[5] = *(const unsigned*)(wsp<bf16_t>(F, OFF_RR) + ro);
            tch[6] = *((const unsigned*)(NS + (size_t)tn_ * 512) + launder(lane) * 32); }
        else {
#pragma unroll
            for (int i = 0; i < 7; ++i) tch[i] = 0u; }
        SB_;
        f32x16 y[2][2]; zero_acc(y);
        mm_xt(y, xf, wl + SL_B, l32, h);
        SB_;
        { bf16x8 sf[2][2][2]; LOAD_SF(); mm_st(y, wl + SL_R, sf, l32, h); }
        SB_;
        { f32x16 acc[2][2]; zero_acc(acc); mm_nn(acc, wl + SL_K, wl + SL_R, l32, h); pack_masked<1>(acc, xg, l32, h); }
        SB_;
        mm_xt(y, xg, wl + SL_V, l32, h);
        SB_;
#undef LOAD_SF
        bf16_t* Y = wsp<bf16_t>(F, (T.chain >> 4) ? OFF_YB : OFF_YF);
        store_tm(y, wl + SL_A, l32, h);
        { const int ln = launder(lane);
#pragma unroll
          for (int i = 0; i < 8; ++i) { const int q = ln + 64 * i, t = q >> 3, c8 = q & 7;
              *(u32x4*)(Y + (size_t)(T.r0 + T.sgn * t) * 512 + T.h * 64 + c8 * 8) = *(const LAS u32x4*)(wl + SL_A + swz(t, c8)); } }
#pragma unroll
        for (int i = 0; i < 7; ++i) asm volatile("" :: "v"(tch[i]));
    }
}
DI void rwkv_out_rows(const Frame& F, int l, int r_begin) {
    const int gw = F.bid * 8 + F.wid, nw = F.G * 8, lane = F.lane, c0 = 8 * lane;
    const bf16_t* RR = wsp<bf16_t>(F, OFF_RR); const bf16_t* RK = wsp<bf16_t>(F, OFF_RK); const bf16_t* RV = wsp<bf16_t>(F, OFF_RV);
    const bf16_t* AF = wsp<bf16_t>(F, OFF_AF); const bf16_t* AB = wsp<bf16_t>(F, OFF_AB); const bf16_t* GG = wsp<bf16_t>(F, OFF_GG);
    bf16_t* YF = wsp<bf16_t>(F, OFF_YF); const bf16_t* YB = wsp<bf16_t>(F, OFF_YB);
    float ka[8], rk[8], gw_[8], gb_[8];
#pragma unroll
    for (int e = 0; e < 8; ++e) { ka[e] = F.in[I_KA][(size_t)l * 512 + c0 + e]; rk[e] = F.in[I_RK][(size_t)l * 512 + c0 + e]; gw_[e] = F.in[I_GNW][(size_t)l * 512 + c0 + e]; gb_[e] = F.in[I_GNB][(size_t)l * 512 + c0 + e]; }
    for (int ra = r_begin + gw; ra < MROWS; ra += 2 * nw) {
        const bool two = ra + nw < MROWS; u32x4 w[2][8];
#pragma unroll
        for (int q = 0; q < 2; ++q) { const size_t ro = (size_t)(q && two ? ra + nw : ra) * 512 + c0;
            w[q][0] = *(const u32x4*)(YF + ro); w[q][1] = *(const u32x4*)(YB + ro); w[q][2] = *(const u32x4*)(RR + ro); w[q][3] = *(const u32x4*)(RK + ro); w[q][4] = *(const u32x4*)(RV + ro);
            w[q][5] = *(const u32x4*)(AF + ro); w[q][6] = *(const u32x4*)(AB + ro); w[q][7] = *(const u32x4*)(GG + ro); }
#pragma unroll
        for (int q = 0; q < 2; ++q) { if (q && !two) break;
            const size_t ro = (size_t)(q ? ra + nw : ra) * 512 + c0; float yf[8], yb[8], y[8], rr[8], k[8], v[8], af[8], ab[8], g[8];
            unpack8(w[q][0], yf); unpack8(w[q][1], yb); unpack8(w[q][2], rr); unpack8(w[q][3], k); unpack8(w[q][4], v); unpack8(w[q][5], af); unpack8(w[q][6], ab); unpack8(w[q][7], g);
            float s = 0.f;
#pragma unroll
            for (int e = 0; e < 8; ++e) { y[e] = yf[e] + yb[e]; s += y[e]; }
            const float mean = sum8(s) * (1.0f / 64.0f); float qq = 0.f, cf = 0.f;
#pragma unroll
            for (int e = 0; e < 8; ++e) { const float d = y[e] - mean; qq += d * d; const float kmf = k[e] * (1.0f + (af[e] - 1.0f) * ka[e]), kmb = k[e] * (1.0f + (ab[e] - 1.0f) * ka[e]); cf += rr[e] * (kmf + kmb) * rk[e]; }
            const float rstd = rsqrtf(sum8(qq) * (1.0f / 64.0f) + 64e-5f); cf = sum8(cf);
            float o[8];
#pragma unroll
            for (int e = 0; e < 8; ++e) o[e] = ((y[e] - mean) * rstd * gw_[e] + gb_[e] + cf * v[e]) * g[e];
            *(u32x4*)(YF + ro) = pack8(o); }
    }
}

struct RouteRec { int e0, e1; float g0, g1; int s0, s1; int pad0, pad1; };
DI void route_phase(const Frame& F, int l, int r_begin) {
    LAS int* hist = (LAS int*)(F.lds);
    if (F.tid < 32) hist[F.tid] = 0;
    __syncthreads();
    const float* lg = wsp<const float>(F, OFF_LOGITS); RouteRec* rec = wsp<RouteRec>(F, OFF_ROUTE);
    { int* st = wsp<int>(F, OFF_SLOTTOK); for (int i = F.bid * 512 + F.tid; i < PMAX; i += F.G * 512) st[i] = 0; }
    for (int tok = r_begin + F.bid * 512 + F.tid; tok < MROWS; tok += F.G * 512) {
        const float* p = lg + (size_t)tok * 64; const f32x4 g4 = *(const f32x4*)p;
        int grp = 0; float mx = g4[0];
#pragma unroll
        for (int i = 1; i < 4; ++i) if (g4[i] > mx) { mx = g4[i]; grp = i; }
        float den = 0.f;
#pragma unroll
        for (int i = 0; i < 4; ++i) den += __expf(g4[i] - mx);
        const float pg = 1.0f / den;
        const f32x4 ea = *(const f32x4*)(p + 4 + grp * 8), eb = *(const f32x4*)(p + 8 + grp * 8); float le[8] = {ea[0], ea[1], ea[2], ea[3], eb[0], eb[1], eb[2], eb[3]};
        int i1 = 0; float v1 = le[0];
#pragma unroll
        for (int i = 1; i < 8; ++i) if (le[i] > v1) { v1 = le[i]; i1 = i; }
        int i2 = -1; float v2 = -3.0e38f;
#pragma unroll
        for (int i = 0; i < 8; ++i) if (i != i1 && le[i] > v2) { v2 = le[i]; i2 = i; }
        const float ex = __expf(v2 - v1), w1 = 1.0f / (1.0f + ex), w2 = ex * w1;
        RouteRec rc; rc.e0 = grp * 8 + i1; rc.e1 = grp * 8 + i2; rc.g0 = pg * w1; rc.g1 = pg * w2; rc.s0 = 0; rc.s1 = 0; rc.pad0 = 0; rc.pad1 = 0;
        rec[tok] = rc;
        __hip_atomic_fetch_add(&hist[rc.e0], 1, __ATOMIC_RELAXED, __HIP_MEMORY_SCOPE_WORKGROUP); __hip_atomic_fetch_add(&hist[rc.e1], 1, __ATOMIC_RELAXED, __HIP_MEMORY_SCOPE_WORKGROUP);
    }
    __syncthreads();
    if (F.tid < 32 && hist[F.tid]) atomicAdd(wsp<int>(F, OFF_CTL) + CW_CNT + l * 32 + F.tid, hist[F.tid]);
}
DI void build_tab(const Frame& F, int l, LAS int* tab) {
    if (F.tid < 64) { const int* cnt = wsp<int>(F, OFF_CTL) + CW_CNT + l * 32; const int lane = F.tid;
        int v = lane < 32 ? ((__hip_atomic_load(cnt + lane, __ATOMIC_RELAXED, __HIP_MEMORY_SCOPE_AGENT) + 255) >> 8) : 0;
        int inc = v;
#pragma unroll
        for (int sft = 1; sft < 32; sft <<= 1) { const int o = __shfl_up(inc, sft); if (lane >= sft) inc += o; }
        if (lane < 32) tab[lane] = inc - v;
        if (lane == 31) tab[32] = inc; }
    __syncthreads();
}
DI void assign_gather_phase(const Frame& F, int l, int r_begin) {
    LAS int* tab = (LAS int*)(F.lds + MISC_OFF + 64); LAS int* lcnt = tab + 40; LAS int* gbase = lcnt + 32;
    build_tab(F, l, tab);
    if (F.tid < 32) lcnt[F.tid] = 0;
    __syncthreads();
    const int per = (MROWS - r_begin + F.G - 1) / F.G, t0 = r_begin + F.bid * per, t1 = min(MROWS, t0 + per);
    RouteRec* rec = wsp<RouteRec>(F, OFF_ROUTE);
    int e0 = 0, e1 = 0, r0 = 0, r1 = 0; const int tok = t0 + F.tid; const bool act = tok < t1;
    if (act) { e0 = rec[tok].e0; e1 = rec[tok].e1; r0 = __hip_atomic_fetch_add(&lcnt[e0], 1, __ATOMIC_RELAXED, __HIP_MEMORY_SCOPE_WORKGROUP); r1 = __hip_atomic_fetch_add(&lcnt[e1], 1, __ATOMIC_RELAXED, __HIP_MEMORY_SCOPE_WORKGROUP); }
    __syncthreads();
    if (F.tid < 32) { const int n = lcnt[F.tid]; gbase[F.tid] = tab[F.tid] * 256 + (n ? atomicAdd(wsp<int>(F, OFF_CTL) + CW_CUR + l * 32 + F.tid, n) : 0); }
    __syncthreads();
    if (act) { const int s0 = gbase[e0] + r0, s1 = gbase[e1] + r1; rec[tok].s0 = s0; rec[tok].s1 = s1; int* st = wsp<int>(F, OFF_SLOTTOK); st[s0] = tok; st[s1] = tok; }
}
template <bool NEXT>
DI void combine_rows(const Frame& F, int l, int r_begin, const float* gn, bf16_t* xn) {
    const int gw = F.bid * 8 + F.wid, nw = F.G * 8;
    const RouteRec* rec = wsp<RouteRec>(F, OFF_ROUTE); const bf16_t* YB = wsp<bf16_t>(F, OFF_YBUF); float* ctxb = wsp<float>(F, OFF_CTX);
    for (int r = r_begin + gw; r < MROWS; r += nw) {
        const RouteRec rc = rec[r]; const int cond = row_cond(r); const float* gate = modp(F, l, cond, 5);
        float* xr = r < NCTX ? ctxb + (size_t)r * DM : F.out + (size_t)(r - NCTX) * DM;
        f32x4 xv[2][2]; float ss = 0.f;
        u32x4 wy0[2], wy1[2]; f32x4 xa_[2], xb_[2], ga_[2], gb_[2], g4_[2][2], s4_[2][2], c4_[2][2];
        const float* sh = modp(F, l + 1, cond, 0); const float* sc = modp(F, l + 1, cond, 1);
#pragma unroll
        for (int j = 0; j < 2; ++j) { const int c0 = 8 * F.lane + 512 * j;
            wy0[j] = *(const u32x4*)(YB + (size_t)rc.s0 * DM + c0); wy1[j] = *(const u32x4*)(YB + (size_t)rc.s1 * DM + c0);
            xa_[j] = *(const f32x4*)(xr + c0); xb_[j] = *(const f32x4*)(xr + c0 + 4); ga_[j] = *(const f32x4*)(gate + c0); gb_[j] = *(const f32x4*)(gate + c0 + 4);
            if (NEXT) {
#pragma unroll
                for (int q = 0; q < 2; ++q) { g4_[j][q] = *(const f32x4*)(gn + c0 + 4 * q); s4_[j][q] = *(const f32x4*)(sh + c0 + 4 * q); c4_[j][q] = *(const f32x4*)(sc + c0 + 4 * q); } } }
#pragma unroll
        for (int j = 0; j < 2; ++j) { const int c0 = 8 * F.lane + 512 * j; float y0[8], y1[8];
            unpack8(wy0[j], y0); unpack8(wy1[j], y1);
            f32x4 xa = xa_[j], xb = xb_[j]; const f32x4 ga = ga_[j], gb = gb_[j];
#pragma unroll
            for (int e = 0; e < 4; ++e) { xa[e] += ga[e] * (rc.g0 * y0[e] + rc.g1 * y1[e]); xb[e] += gb[e] * (rc.g0 * y0[4 + e] + rc.g1 * y1[4 + e]); }
            *(f32x4*)(xr + c0) = xa; *(f32x4*)(xr + c0 + 4) = xb;
            if (NEXT) { xv[j][0] = xa; xv[j][1] = xb;
#pragma unroll
                for (int e = 0; e < 4; ++e) ss += xa[e] * xa[e] + xb[e] * xb[e]; } }
        if (NEXT) {
            ss = wave_sum(ss); const float inv = rsqrtf(ss * (1.0f / DM) + 1e-6f);
#pragma unroll
            for (int j = 0; j < 2; ++j) { const int c0 = 8 * F.lane + 512 * j; float o[8];
#pragma unroll
                for (int q = 0; q < 2; ++q) { const f32x4 g4 = g4_[j][q], s4 = s4_[j][q], c4 = c4_[j][q];
#pragma unroll
                    for (int e = 0; e < 4; ++e) o[4 * q + e] = (xv[j][q][e] * inv * g4[e]) * (1.0f + c4[e]) + s4[e]; }
                *(u32x4*)(xn + (size_t)r * DM + c0) = pack8(o); }
        }
    }
}

constexpr int PH_PER_LAYER = 19, N_PHASES = 1 + 2 * PH_PER_LAYER;
#if MK_ONE_LAUNCH
#define GRID_BAR() xcd_barrier(bar)
#else
#define GRID_BAR() do { } while (0)
#endif
#ifndef PH_MASK
#define PH_MASK 0xFFFFFFFFu
#endif
#define PON(j) (((PH_MASK) >> (j)) & 1u)
#ifndef REP_MASK
#define REP_MASK 0u
#endif
#define REPEAT(j) for (int rep_ = 0; rep_ < 1 + (int)(((REP_MASK) >> (j)) & 1u); ++rep_)
#define IN(k) (lo <= (k) && (k) < hi)
#define SEAM(k) do { if (IN((k) + 1)) GRID_BAR(); } while (0)
template <int l, class BarT>
DI void layer_phases(const Frame& F0, const int lo, const int hi, const BarT& bar) {
        const Frame& F = F0;
        constexpr bool LAST = (l == EN_LAYERS - 1);
        constexpr int RB = LAST ? NCTX : 0, PM0 = LAST ? 2 : 0;
        const int pb = 1 + l * PH_PER_LAYER;
        const float* xlat = l == 0 ? F.in[I_X] : F.out;
        const float* modl = wsp<const float>(F, OFF_MOD) + (size_t)l * 3 * 6144;
        if (PON(0) && IN(pb + 0)) { const Frame F = phase_frame(F0); REPEAT(0) {  if (l == 0) norm_rows(F, xlat, F.in[I_N1G] + (size_t)l * DM, l, 0, 1, wsp<bf16_t>(F, OFF_XN));  } if (l == 0) SEAM(pb + 0); }
        if (PON(1) && IN(pb + 1)) { const Frame F = phase_frame(F0); REPEAT(1) {  pg8::Gemm g{wsp<bf16_t>(F, OFF_XN), wsp<bf16_t>(F, OFF_WIN), DM, nullptr, nullptr}; pg8::StaticOrder S; S.init(MROWS, N_INP, F.G, F.bid); EpiInproj E{F.ws};
            pg8::gemm_phase(F.lds, g, S, E, F.tid);  } SEAM(pb + 1); }
        if (PON(2) && IN(pb + 2)) { const Frame F = phase_frame(F0); REPEAT(2) {  phaseC_rows(F, l); __syncthreads(); phaseC_vt(F);  } SEAM(pb + 2); }
        if (PON(3) && IN(pb + 3)) { const Frame F = phase_frame(F0); REPEAT(3) {  pg8::Gemm g{wsp<bf16_t>(F, OFF_ALORA), wsp<bf16_t>(F, OFF_WLORA), LORA_K, nullptr, nullptr}; pg8::StaticOrder S; S.init(MROWS, LORA_N, F.G, F.bid);
            EpiLora E{F.ws, F.in[I_DW0] + (size_t)l * 1024, F.in[I_AA0] + (size_t)l * 1024};
            pg8::gemm_phase(F.lds, g, S, E, F.tid);  } SEAM(pb + 3); }
        if (PON(4) && IN(pb + 4)) { const Frame F = phase_frame(F0); REPEAT(4) {  attn_phase(F, l, LAST ? 512 : 520);  } SEAM(pb + 4); }
        if (PON(5) && IN(pb + 5)) { const Frame F = phase_frame(F0); REPEAT(5) {  scan_pass1(F, l);  } SEAM(pb + 5); }
        if (PON(6) && IN(pb + 6)) { const Frame F = phase_frame(F0); REPEAT(6) {  scan_pass2(F);  } SEAM(pb + 6); }
        if (PON(7) && IN(pb + 7)) { const Frame F = phase_frame(F0); REPEAT(7) {  scan_pass3(F, l);  } SEAM(pb + 7); }
        if (PON(8) && IN(pb + 8)) { const Frame F = phase_frame(F0); REPEAT(8) {  rwkv_out_rows(F, l, RB); norm_rows(F, xlat, F.in[I_N1G] + (size_t)l * DM, l, 0, 1, wsp<bf16_t>(F, OFF_XN2), RB);  } SEAM(pb + 8); }
        if (PON(9) && IN(pb + 9)) { const Frame F = phase_frame(F0); REPEAT(9) {  pg8::Gemm g{wsp<bf16_t>(F, OFF_XN2), wsp<bf16_t>(F, OFF_WIN) + (size_t)N_INP * DM, DM, nullptr, nullptr}; pg8::StaticOrder S; S.init(MROWS, N_GATE, F.G, F.bid, PM0); EpiGates E{wsp<bf16_t>(F, OFF_G)};
            pg8::gemm_phase(F.lds, g, S, E, F.tid);  } SEAM(pb + 9); }
        if (PON(10) && IN(pb + 10)) { const Frame F = phase_frame(F0); REPEAT(10) {
            pg8::Gemm g{wsp<bf16_t>(F, OFF_PDIFF), wsp<bf16_t>(F, OFF_WMG), 1536, wsp<bf16_t>(F, OFF_POOL), wsp<bf16_t>(F, OFF_YF)}; pg8::StaticOrder S; S.init(MROWS, DM, F.G, F.bid, PM0);
            EpiMerge E{wsp<bf16_t>(F, OFF_G), wsp<bf16_t>(F, OFF_MERGED)};
            pg8::gemm_phase(F.lds, g, S, E, F.tid); } SEAM(pb + 10); }
        if (PON(11) && IN(pb + 11)) { const Frame F = phase_frame(F0); REPEAT(11) {  pg8::Gemm g{wsp<bf16_t>(F, OFF_MERGED), wsp<bf16_t>(F, OFF_WOUT), DM, nullptr, nullptr}; pg8::StaticOrder S; S.init(MROWS, DM, F.G, F.bid, PM0); EpiResid E{xlat, F.out, wsp<float>(F, OFF_CTX), modl};
            pg8::gemm_phase(F.lds, g, S, E, F.tid);  } SEAM(pb + 11); }
#if EN_MOE
        if (PON(12) && IN(pb + 12)) { const Frame F = phase_frame(F0); REPEAT(12) {  conv_router_weights(F, l); norm_rows(F, F.out, F.in[I_N2G] + (size_t)l * DM, l, 3, 4, wsp<bf16_t>(F, OFF_XN), RB);  } SEAM(pb + 12); }
        if (PON(13) && IN(pb + 13)) { const Frame F = phase_frame(F0); REPEAT(13) {  pg8::Gemm g{wsp<bf16_t>(F, OFF_XN), wsp<bf16_t>(F, OFF_WRT), DM, nullptr, nullptr}; pg8::StaticOrder S; S.init(MROWS, 256, F.G, F.bid, PM0); EpiLogits E{wsp<float>(F, OFF_LOGITS)};
            pg8::gemm_phase(F.lds, g, S, E, F.tid);  } SEAM(pb + 13); }
        if (PON(14) && IN(pb + 14)) { const Frame F = phase_frame(F0); REPEAT(14) {  route_phase(F, l, RB);  } SEAM(pb + 14); }
        if (PON(15) && IN(pb + 15)) { const Frame F = phase_frame(F0); REPEAT(15) {  assign_gather_phase(F, l, RB); __syncthreads(); conv_expert_weights(F, l);  } SEAM(pb + 15); }
        if (PON(16) && IN(pb + 16)) { const Frame F = phase_frame(F0); REPEAT(16) {  LAS int* tab = (LAS int*)(F.lds + MISC_OFF + 64); build_tab(F, l, tab);
            pg8::Gemm g{wsp<bf16_t>(F, OFF_XN), wsp<bf16_t>(F, OFF_WE1), DM, nullptr, nullptr}; pg8::MoeOrder<true> S{tab, 4, F.G, F.bid, wsp<int>(F, OFF_SLOTTOK)}; EpiAct E{wsp<bf16_t>(F, OFF_ACT)};
            pg8::gemm_phase(F.lds, g, S, E, F.tid);  } SEAM(pb + 16); }
        if (PON(17) && IN(pb + 17)) { const Frame F = phase_frame(F0); REPEAT(17) {  LAS int* tab = (LAS int*)(F.lds + MISC_OFF + 64); build_tab(F, l, tab);
            pg8::Gemm g{wsp<bf16_t>(F, OFF_ACT), wsp<bf16_t>(F, OFF_WE2), FF, nullptr, nullptr}; pg8::MoeOrder<false> S{tab, 4, F.G, F.bid, nullptr}; EpiY E{wsp<bf16_t>(F, OFF_YBUF)};
            pg8::gemm_phase(F.lds, g, S, E, F.tid);  } SEAM(pb + 17); }
        if (PON(18) && IN(pb + 18)) { const Frame F = phase_frame(F0); REPEAT(18) {  if constexpr (!LAST) { conv_small_weights(F, l + 1); combine_rows<true>(F, l, RB, F.in[I_N1G] + (size_t)(l + 1) * DM, wsp<bf16_t>(F, OFF_XN)); } else combine_rows<false>(F, l, RB, nullptr, nullptr);  } SEAM(pb + 18); }
#endif
}
__global__ void __launch_bounds__(512, 2) fwd(Args args) {
    extern __shared__ __attribute__((aligned(16))) unsigned char lds_raw[];
    Frame F0; F0.in = (kain_t)__builtin_amdgcn_kernarg_segment_ptr(); F0.out = args.out; F0.ws = args.ws; F0.lds = (LAS unsigned char*)lds_raw;
    F0.tid = threadIdx.x; F0.lane = F0.tid & 63; F0.wid = __builtin_amdgcn_readfirstlane(F0.tid >> 6); F0.G = gridDim.x; F0.bid = blockIdx.x;
    volatile LAS unsigned* MISC = (volatile LAS unsigned*)(F0.lds + MISC_OFF);
    if (F0.tid < 4) MISC[F0.tid] = 0u;
    __syncthreads();
#if MK_ONE_LAUNCH
    const XcdBarrier bar = xcd_barrier_post((unsigned*)(F0.ws + OFF_CTL) + CW_BAR, MISC);
#else
    const int bar = 0;
#endif
    const int lo = args.ph_lo, hi = args.ph_hi;
    if (PON(31) && IN(0)) { const Frame F = phase_frame(F0); p0_prologue(F); SEAM(0); }
    layer_phases<0>(F0, lo, hi, bar);
#if EN_LAYERS > 1
    layer_phases<1>(F0, lo, hi, bar);
#endif
}

extern "C" void kernel_launch(void* const* d_in, const int* in_sizes, int n_in, void* d_out, int out_size, void* d_ws, size_t ws_size, hipStream_t stream) {
    static int grid = 0;
    if (grid == 0) {
        if (n_in != 33 || out_size != NB * SEQ * DM || ws_size < WS_END) { fprintf(stderr, "kernel_launch: unexpected shapes (n_in %d out %d ws %zu need %zu)\n", n_in, out_size, ws_size, (size_t)WS_END); grid = -1; return; }
        int dev = 0, cus = 0, per_cu = 0;
        if (hipGetDevice(&dev) != hipSuccess || hipDeviceGetAttribute(&cus, hipDeviceAttributeMultiprocessorCount, dev) != hipSuccess) { grid = -1; return; }
        if (hipFuncSetAttribute((const void*)fwd, hipFuncAttributeMaxDynamicSharedMemorySize, LDS_BYTES) != hipSuccess) { fprintf(stderr, "kernel_launch: hipFuncSetAttribute failed\n"); grid = -1; return; }
        if (hipOccupancyMaxActiveBlocksPerMultiprocessor(&per_cu, (const void*)fwd, 512, LDS_BYTES) != hipSuccess || per_cu < 1) { fprintf(stderr, "kernel_launch: occupancy query says %d\n", per_cu); }
        (void)hipGetLastError();
        grid = cus;
    }
    if (grid < 0) return;
    (void)hipMemsetAsync((char*)d_ws + OFF_CTL, 0, 65536, stream);
    Args a{};
    for (int i = 0; i < 33; ++i) a.in[i] = (const float*)d_in[i];
    a.out = (float*)d_out; a.ws = (unsigned char*)d_ws;
#if MK_ONE_LAUNCH
    a.ph_lo = 0; a.ph_hi = N_PHASES;
    hipLaunchKernelGGL(fwd, dim3(grid), dim3(512), LDS_BYTES, stream, a);
#else
    for (int p = 0; p < N_PHASES; ++p) {
        if (p >= 1 + EN_LAYERS * PH_PER_LAYER) break;
#if !EN_MOE
        if (p >= 1 && ((p - 1) % PH_PER_LAYER) >= 12) continue;
#endif
        a.ph_lo = p; a.ph_hi = p + 1;
        hipLaunchKernelGGL(fwd, dim3(grid), dim3(512), LDS_BYTES, stream, a);
    }
#endif
}
```

```cpp
#include <hip/hip_runtime.h>
#include <stdint.h>
#include <stdio.h>
#include <stddef.h>
#include <utility>

#ifndef MK_ONE_LAUNCH
#define MK_ONE_LAUNCH 1
#endif
#ifndef EN_MOE
#define EN_MOE 1
#endif
#ifndef EN_LAYERS
#define EN_LAYERS 2
#endif

#define LAS __attribute__((address_space(3)))
#define DI __device__ __forceinline__
typedef unsigned short bf16_t;
typedef short bf16x8 __attribute__((ext_vector_type(8)));
typedef float f32x4 __attribute__((ext_vector_type(4)));
typedef float f32x2 __attribute__((ext_vector_type(2)));
typedef float f32x16 __attribute__((ext_vector_type(16)));
typedef unsigned u32x4 __attribute__((ext_vector_type(4)));
typedef unsigned u32x2 __attribute__((ext_vector_type(2)));
typedef __bf16 bfv2 __attribute__((ext_vector_type(2)));

constexpr int DM = 1024, NB = 2, SEQ = 16384, CTXL = 256, NCTX = NB * CTXL  , MROWS = NCTX + NB * SEQ  ;
constexpr int NPAN = MROWS / 256;
constexpr int IN_W = 7040, N_INP = 4096  , N_GATE = 3072, N_INT = N_INP + N_GATE  ;
constexpr int RW_IN = 1920, LORA_K = 384, LORA_N = 2560;
constexpr int NEXP = 32, FF = 512;
constexpr int PMAX = 74752;
constexpr int KEYS = CTXL + SEQ;
constexpr size_t U_EL = (size_t)MROWS * 512;
constexpr size_t U_B = U_EL * 2;
constexpr size_t OFF_CTL = 0, OFF_MOD = 65536, OFF_CTX = 327680, OFF_WIN = 2424832, OFF_WMG = 17104896, OFF_WOUT = 20250624, OFF_WLORA = 22347776, OFF_WRT = 24313856;
constexpr size_t R1 = 25165824, R2 = R1 + 4 * U_B, R3 = R2 + 5 * U_B, R4 = R3 + 4 * U_B, R6 = R4 + 2 * U_B, RVT = R6 + 2 * U_B, WS_END = RVT + U_B;
constexpr size_t OFF_POOL = R1, OFF_Q = R1 + U_B, OFF_K = R1 + 2 * U_B, OFF_V = R1 + 3 * U_B;
constexpr size_t OFF_RWRAW = R2, OFF_EF = R2, OFF_EB = R2 + U_B, OFF_AF = R2 + 2 * U_B, OFF_AB = R2 + 3 * U_B, OFF_GG = R2 + 4 * U_B;
constexpr size_t OFF_RR = R3, OFF_RK = R3 + U_B, OFF_RV = R3 + 2 * U_B, OFF_RKK = R3 + 3 * U_B;
constexpr size_t OFF_YF = R4, OFF_YB = R4 + U_B;
constexpr size_t OFF_MP = R1 + U_B;
constexpr size_t OFF_NS = R6 + U_B;
constexpr int NCHUNK = KEYS / 64;
constexpr size_t OFF_PDIFF = R6, OFF_ALORA = R6 + U_B, OFF_XN = R6;
constexpr size_t OFF_XN2 = R1 + 2 * U_B;
constexpr size_t OFF_G = R2;
constexpr size_t OFF_MERGED = R3 + U_B;
constexpr size_t OFF_WE1 = R3, OFF_WE2 = R3 + (size_t)NEXP * 1024 * 1024 * 2;
constexpr size_t OFF_XB = R1, OFF_ACT = R1 + (size_t)PMAX * 2048, OFF_YBUF = R1;
constexpr size_t OFF_LOGITS = R4, OFF_ROUTE = R4 + (size_t)MROWS * 64 * 4, OFF_SLOTTOK = OFF_ROUTE + (size_t)MROWS * 32;
constexpr int CW_BAR = 0, CW_CNT = 4096, CW_CUR = 4096 + 64, CW_END = 4096 + 128;
constexpr int LDS_BYTES = 151552, MISC_OFF = 147456;

DI int launder(int x) { asm volatile("" : "+v"(x)); return x; }
DI int lane_id() { return (int)__builtin_amdgcn_mbcnt_hi(~0u, __builtin_amdgcn_mbcnt_lo(~0u, 0u)); }
DI float bf2f(bf16_t v) { return __uint_as_float(((unsigned)v) << 16); }
DI unsigned pk2(float lo, float hi) { f32x2 v = {lo, hi}; bfv2 r = __builtin_convertvector(v, bfv2); return __builtin_bit_cast(unsigned, r); }
DI bf16_t f2bf(float f) { return (bf16_t)(pk2(f, 0.f) & 0xffffu); }
DI float lo_f(unsigned w) { return __uint_as_float(w << 16); }
DI float hi_f(unsigned w) { return __uint_as_float(w & 0xffff0000u); }
DI void unpack8(const u32x4 w, float (&f)[8]) { f[0] = lo_f(w.x); f[1] = hi_f(w.x); f[2] = lo_f(w.y); f[3] = hi_f(w.y); f[4] = lo_f(w.z); f[5] = hi_f(w.z); f[6] = lo_f(w.w); f[7] = hi_f(w.w); }
DI u32x4 pack8(const float (&f)[8]) { u32x4 w; w.x = pk2(f[0], f[1]); w.y = pk2(f[2], f[3]); w.z = pk2(f[4], f[5]); w.w = pk2(f[6], f[7]); return w; }
DI float sigmoidf_(float x) { return __builtin_amdgcn_rcpf(1.0f + __expf(-x)); }
DI float wave_sum(float v) { v += __shfl_xor(v, 1); v += __shfl_xor(v, 2); v += __shfl_xor(v, 4); v += __shfl_xor(v, 8); v += __shfl_xor(v, 16); v += __shfl_xor(v, 32); return v; }
DI float sum8(float v) { v += __shfl_xor(v, 1); v += __shfl_xor(v, 2); v += __shfl_xor(v, 4); return v; }
template <int CTRL> DI float dppf(float v) { return __builtin_bit_cast(float, __builtin_amdgcn_update_dpp(0, __builtin_bit_cast(int, v), CTRL, 0xf, 0xf, true)); }
DI float allsum16(float v) { v += dppf<0xB1>(v); v += dppf<0x4E>(v); v += dppf<0x141>(v); v += dppf<0x140>(v); return v; }

#define XB_TMO      128
#define XB_XCNT(j)  (256  + 64 * (j))
#define XB_XSUB(j)  (1280 + 64 * (j))
#define XB_XGEN(j)  (2304 + 64 * (j))
#define XB_TOP      3328
#define XB_TOPGEN   3392
#define XCD_BAR_WORDS 3456
#define XB_SPIN_CAP (1u << 22)
DI unsigned xb_ld(unsigned* p)              { return __hip_atomic_load(p, __ATOMIC_RELAXED, __HIP_MEMORY_SCOPE_AGENT); }
DI unsigned xb_add(unsigned* p, unsigned v) { return __hip_atomic_fetch_add(p, v, __ATOMIC_RELAXED, __HIP_MEMORY_SCOPE_AGENT); }
DI unsigned xb_xcc_id() { return (unsigned)__builtin_amdgcn_s_getreg((3 << 11) | 20) & 0xFu; }
#define XB_SPIN(cond, bar) do { unsigned _sp = 0; while (cond) { __builtin_amdgcn_s_sleep(1); \
    if ((++_sp & 255u) == 0u) { if (xb_ld(&(bar)[XB_TMO])) break; if (_sp > XB_SPIN_CAP) { atomicAdd(&(bar)[XB_TMO], 1u); break; } } } } while (0)
struct XcdBarrier { unsigned* bar; unsigned x; volatile LAS unsigned* st; bool t0; };
DI XcdBarrier xcd_barrier_post(unsigned* bar, volatile LAS unsigned* st) {
    XcdBarrier b; b.bar = bar; b.x = xb_xcc_id(); b.st = st; b.t0 = threadIdx.x == 0;
    if (b.t0) (void)xb_add(&bar[XB_XCNT(b.x)], 1u);
    return b;
}
DI void xcd_barrier_complete(unsigned* bar, unsigned x, unsigned& nloc, unsigned& nx) {
    const unsigned G = gridDim.x * gridDim.y * gridDim.z;
    unsigned sum, cnt, mine, sp = 0u;
    for (;;) {
        sum = 0u; cnt = 0u; mine = 0u;
#pragma unroll
        for (unsigned j = 0; j < 16; ++j) { const unsigned c = xb_ld(&bar[XB_XCNT(j)]); sum += c; cnt += (c > 0u) ? 1u : 0u; mine = (j == x) ? c : mine; }
        if (sum == G) break;
        __builtin_amdgcn_s_sleep(1);
        if ((++sp & 255u) == 0u) { if (xb_ld(&bar[XB_TMO])) break; if (sp > XB_SPIN_CAP) { atomicAdd(&bar[XB_TMO], 1u); break; } }
    }
    nloc = mine > 0u ? mine : 1u; nx = cnt > 0u ? cnt : 1u;
}
DI void xcd_barrier(const XcdBarrier& b) {
    asm volatile("s_waitcnt vmcnt(0)" ::: "memory");
    __syncthreads();
    if (b.t0) {
        unsigned* bar = b.bar;
        __builtin_amdgcn_s_waitcnt(0);
        unsigned nloc = b.st[0], nx = b.st[1];
        if (nloc == 0u) { xcd_barrier_complete(bar, b.x, nloc, nx); b.st[0] = nloc; b.st[1] = nx; }
        const unsigned old = xb_add(&bar[XB_XSUB(b.x)], 1u);
        const unsigned gen = old / nloc;
        if (old + 1u == (gen + 1u) * nloc) {
            __builtin_amdgcn_fence(__ATOMIC_RELEASE, "agent");
            asm volatile("s_waitcnt vmcnt(0)" ::: "memory");
            const unsigned og = xb_add(&bar[XB_TOP], 1u);
            const unsigned tg = og / nx;
            if (og + 1u == (tg + 1u) * nx) xb_add(&bar[XB_TOPGEN], 1u);
            else XB_SPIN(xb_ld(&bar[XB_TOPGEN]) == tg, bar);
            __builtin_amdgcn_fence(__ATOMIC_ACQUIRE, "agent");
            xb_add(&bar[XB_XGEN(b.x)], 1u);
            asm volatile("s_waitcnt vmcnt(0)" ::: "memory");
        } else {
            XB_SPIN(xb_ld(&bar[XB_XGEN(b.x)]) == gen, bar);
            __builtin_amdgcn_fence(__ATOMIC_ACQUIRE, "agent");
            asm volatile("s_waitcnt vmcnt(0)" ::: "memory");
        }
    }
    __syncthreads();
}

namespace pg8 {
constexpr int BM = 256, BK = 64, HALF = 128, HTB = HALF * BK * 2, STAGE_BYTES = 8 * HTB, NXCD = 8, WGM = 8;
DI int lds_byte(int r, int c) { const int st = (r >> 4) * 2 + (c >> 5), rr = r & 15, cc = c & 31, ob = rr * 64 + cc * 2; return st * 1024 + (ob ^ (((ob >> 9) & 1) << 5)); }
DI void stage_rc(int b, int& R, int& C) { const int st = b / 1024, sb = b % 1024, swz = sb ^ (((sb >> 9) & 1) << 5); R = (st >> 1) * 16 + swz / 64; C = (st & 1) * 32 + (swz % 64) / 2; }
DI int perm32(int rho) { const int n = rho >> 4, i = rho & 15; return 8 * (i >> 2) + 4 * n + (i & 3); }
struct Unit { int pm, pn, pb; };
struct Gemm { const bf16_t* A; const bf16_t* Bt; int K; const bf16_t* A1; const bf16_t* A2; };
struct StaticOrder {
    static constexpr bool GATHER = false;
    int nM, nN, nwg, G, c, pm0;
    DI void init(int M, int N, int G_, int c_, int pm0_ = 0) { pm0 = pm0_; nM = M / BM - pm0_; nN = N / BM; nwg = nM * nN; G = G_; c = c_; }
    DI bool next(int i, Unit& u) const {
        const long L = (long)i * G + c; if (L >= nwg) return false;
        int wgid = (int)L; { const int q = nwg / NXCD, r = nwg % NXCD, xcd = wgid % NXCD, off = wgid / NXCD; wgid = (xcd < r ? xcd * (q + 1) : r * (q + 1) + (xcd - r) * q) + off; }
        const int nig = WGM * nN, gid = wgid / nig, fm = gid * WGM, gsz = (nM - fm) < WGM ? (nM - fm) : WGM;
        u.pm = pm0 + fm + ((wgid % nig) % gsz); u.pn = (wgid % nig) / gsz; u.pb = u.pn; return true;
    }
};
template <bool GATHER_> struct MoeOrder {
    static constexpr bool GATHER = GATHER_;
    const LAS int* tab; int NT, G, c; const int* slot_tok;
    DI bool next(int i, Unit& u) const {
        int L = i * G + c; const int np = tab[32], nwg = np * NT; if (L >= nwg) return false;
        { const int q = nwg / NXCD, r = nwg % NXCD, xcd = L % NXCD, off = L / NXCD; L = (xcd < r ? xcd * (q + 1) : r * (q + 1) + (xcd - r) * q) + off; }
        const int p = L / NT, pn = L % NT; int e = 0;
#pragma unroll 1
        for (int j = 1; j < 32; ++j) e = (tab[j] <= p) ? j : e;
        u.pm = p; u.pn = pn; u.pb = e * NT + pn; return true;
    }
};

template <class Epi, class Sched>
DI void gemm_phase(LAS unsigned char* lds, const Gemm g, const Sched& S, const Epi& E, int tid_) {
    const int tid = launder(tid_), wid = __builtin_amdgcn_readfirstlane(tid >> 6), lane = tid & 63, wr = wid >> 2, wc = wid & 3, fr = lane & 15, fq = lane >> 4;
    const int K = g.K, nt = K / BK, lda = Epi::SEG ? 512 : K;
    unsigned voffA[2], voffB[2];
#pragma unroll
    for (int i = 0; i < 2; ++i) { int R, C; stage_rc(tid * 16 + i * 8192, R, C); const int Rb = Epi::PERM ? ((R & ~31) + perm32(R & 31)) : R;
        voffA[i] = (unsigned)(R * lda + C) * 2u; voffB[i] = (unsigned)(Rb * K + C) * 2u; }
    const size_t kstep = (size_t)(BK * 2);
    const size_t hstep = (size_t)HALF * K * 2;
    const size_t tstep = 2 * hstep;
    const size_t hstepA = (size_t)HALF * lda * 2, tstepA = 2 * hstepA;
    constexpr bool GA = Sched::GATHER;
    unsigned cv[2][2], nv[2][2]; int gR[2], gC[2];
#pragma unroll
    for (int i = 0; i < 2; ++i) { stage_rc(tid * 16 + i * 8192, gR[i], gC[i]); cv[0][i] = cv[1][i] = nv[0][i] = nv[1][i] = 0u; }
#define PG8_GVOFF(v, pm_) do { _Pragma("unroll") for (int h_ = 0; h_ < 2; ++h_) _Pragma("unroll") for (int i_ = 0; i_ < 2; ++i_) \
        (v)[h_][i_] = ((unsigned)S.slot_tok[(pm_) * 256 + h_ * 128 + gR[i_]] * (unsigned)lda + (unsigned)gC[i_]) * 2u; } while (0)
#define PG8_ATILE(ub, t) (Epi::SEG ? (const char*)((t) < 8 ? g.A : ((t) < 16 ? g.A1 : g.A2)) + (ub) + (size_t)((t) & 7) * kstep : (const char*)g.A + (ub) + (size_t)(t) * kstep)
    const unsigned ldsw = (unsigned)wid * 1024u;
    const int aoff = lds_byte(wr * 64 + fr, fq * 8), boff = lds_byte(wc * 32 + fr, fq * 8);
#define PG8_SA(b, h) (((b) * 2 + (h)) * HTB)
#define PG8_SB(b, h) ((4 + (b) * 2 + (h)) * HTB)
#define PG8_STAGE(bufoff, gbase, voff) do { _Pragma("unroll") for (int _i = 0; _i < 2; ++_i) \
        __builtin_amdgcn_global_load_lds((const unsigned*)((const char*)(gbase) + (voff)[_i]), (LAS unsigned*)(lds + (bufoff) + ldsw + _i * 8192), 16, 0, 0); } while (0)
#define PG8_LDA(dst, b, h) do { _Pragma("unroll") for (int m = 0; m < 4; ++m) _Pragma("unroll") for (int k = 0; k < 2; ++k) dst[m][k] = *(const LAS bf16x8*)(lds + PG8_SA(b, h) + aoff + m * 2048 + k * 1024); } while (0)
#define PG8_LDB(dst, b, h) do { _Pragma("unroll") for (int n = 0; n < 2; ++n) _Pragma("unroll") for (int k = 0; k < 2; ++k) dst[n][k] = *(const LAS bf16x8*)(lds + PG8_SB(b, h) + boff + n * 2048 + k * 1024); } while (0)
#define PG8_MMA(ai, bj, At, Bt) do { __builtin_amdgcn_s_setprio(1); _Pragma("unroll") for (int m = 0; m < 4; ++m) _Pragma("unroll") for (int n = 0; n < 2; ++n) _Pragma("unroll") for (int k = 0; k < 2; ++k) \
        acc[ai][bj][m][n] = __builtin_amdgcn_mfma_f32_16x16x32_bf16(Bt[n][k], At[m][k], acc[ai][bj][m][n], 0, 0, 0); __builtin_amdgcn_s_setprio(0); } while (0)
#define PG8_WAIT_V(n) asm volatile("s_waitcnt vmcnt(" #n ")" ::: "memory")
#define PG8_WAIT_L(n) asm volatile("s_waitcnt lgkmcnt(" #n ")" ::: "memory")
#define PG8_BAR __builtin_amdgcn_s_barrier()
#define PG8_SCHED __builtin_amdgcn_sched_barrier(0)
    Unit cur, nxt; int ui = 0;
    if (!S.next(0, cur)) return;
    f32x4 acc[2][2][4][2];
#pragma unroll
    for (int a = 0; a < 2; ++a)
#pragma unroll
        for (int b = 0; b < 2; ++b)
#pragma unroll
            for (int m = 0; m < 4; ++m)
#pragma unroll
                for (int n = 0; n < 2; ++n) acc[a][b][m][n] = (f32x4){0.f, 0.f, 0.f, 0.f};
    bf16x8 At[4][2], B0[2][2], B1[2][2];
    size_t ubA = (size_t)cur.pm * tstepA; const char* cA = PG8_ATILE(ubA, 0); const char* cB = (const char*)g.Bt + (size_t)cur.pb * tstep;
    const char* const gA = (const char*)g.A;
    if constexpr (GA) { PG8_GVOFF(cv, cur.pm); }
    PG8_STAGE(PG8_SB(0, 0), cB, voffB);
    if constexpr (GA) PG8_STAGE(PG8_SA(0, 0), gA, cv[0]); else PG8_STAGE(PG8_SA(0, 0), cA, voffA);
    PG8_STAGE(PG8_SB(0, 1), cB + hstep, voffB);
    if constexpr (GA) PG8_STAGE(PG8_SA(0, 1), gA, cv[1]); else PG8_STAGE(PG8_SA(0, 1), cA + hstepA, voffA);
    if (wr == 1) PG8_BAR;
    PG8_WAIT_V(4); PG8_BAR;
    PG8_STAGE(PG8_SB(1, 0), cB + kstep, voffB);
    if constexpr (GA) PG8_STAGE(PG8_SA(1, 0), gA + kstep, cv[0]); else PG8_STAGE(PG8_SA(1, 0), cA + kstep, voffA);
    PG8_STAGE(PG8_SB(1, 1), cB + hstep + kstep, voffB);
    PG8_WAIT_V(6); PG8_BAR;
    for (;;) {
        const bool has_next = S.next(ui + 1, nxt);
        const size_t nubA = has_next ? (size_t)nxt.pm * tstepA : ubA;
        const char* nA = PG8_ATILE(nubA, 0); const char* nB = has_next ? (const char*)g.Bt + (size_t)nxt.pb * tstep : cB;
        if constexpr (GA) { if (has_next) { PG8_GVOFF(nv, nxt.pm); } else {
#pragma unroll
            for (int h_ = 0; h_ < 2; ++h_) { nv[h_][0] = cv[h_][0]; nv[h_][1] = cv[h_][1]; } } }
        for (int t = 0; t < nt; t += 2) {
            const bool last = (t == nt - 2);
            const char* a1 = PG8_ATILE(ubA, t + 1);
            const char* a2 = last ? nA : PG8_ATILE(ubA, t + 2); const char* b2 = last ? nB : cB + (size_t)(t + 2) * kstep;
            const char* a3 = a2 + kstep; const char* b3 = b2 + kstep;
            const char* gk2 = gA + (last ? (size_t)0 : (size_t)(t + 2) * kstep);
            unsigned s0[2] = {last ? nv[0][0] : cv[0][0], last ? nv[0][1] : cv[0][1]}, s1[2] = {last ? nv[1][0] : cv[1][0], last ? nv[1][1] : cv[1][1]};
            PG8_LDB(B0, 0, 0); PG8_SCHED; PG8_LDA(At, 0, 0);
            if constexpr (GA) PG8_STAGE(PG8_SA(1, 1), gA + (size_t)(t + 1) * kstep, cv[1]); else PG8_STAGE(PG8_SA(1, 1), a1 + hstepA, voffA);
            PG8_WAIT_L(8); PG8_BAR; PG8_WAIT_L(0); PG8_MMA(0, 0, At, B0); PG8_BAR; PG8_SCHED;
            PG8_LDB(B1, 0, 1); PG8_STAGE(PG8_SB(0, 0), b2, voffB);
            PG8_BAR; PG8_WAIT_L(0); PG8_MMA(0, 1, At, B1); PG8_BAR;
            PG8_LDA(At, 0, 1); if constexpr (GA) PG8_STAGE(PG8_SA(0, 0), gk2, s0); else PG8_STAGE(PG8_SA(0, 0), a2, voffA);
            PG8_BAR; PG8_WAIT_L(0); PG8_MMA(1, 0, At, B0); PG8_BAR; PG8_SCHED;
            PG8_STAGE(PG8_SB(0, 1), b2 + hstep, voffB);
            PG8_WAIT_V(6); PG8_BAR; PG8_MMA(1, 1, At, B1); PG8_BAR;
            PG8_LDB(B0, 1, 0); PG8_SCHED; PG8_LDA(At, 1, 0); if constexpr (GA) PG8_STAGE(PG8_SA(0, 1), gk2, s1); else PG8_STAGE(PG8_SA(0, 1), a2 + hstepA, voffA);
            PG8_WAIT_L(8); PG8_BAR; PG8_WAIT_L(0); PG8_MMA(0, 0, At, B0); PG8_BAR; PG8_SCHED;
            PG8_LDB(B1, 1, 1); PG8_STAGE(PG8_SB(1, 0), b3, voffB);
            PG8_BAR; PG8_WAIT_L(0); PG8_MMA(0, 1, At, B1); PG8_BAR;
            PG8_LDA(At, 1, 1); if constexpr (GA) PG8_STAGE(PG8_SA(1, 0), gk2 + kstep, s0); else PG8_STAGE(PG8_SA(1, 0), a3, voffA);
            PG8_BAR; PG8_WAIT_L(0); PG8_MMA(1, 0, At, B0); PG8_BAR; PG8_SCHED;
            PG8_STAGE(PG8_SB(1, 1), b3 + hstep, voffB);
            PG8_WAIT_V(6); PG8_BAR; PG8_MMA(1, 1, At, B1); PG8_BAR;
            if constexpr (Epi::SEG) { if (((t + 2) & 7) == 0 && !last) E.mid(acc, cur, (t + 2) >> 3, wr, wc, fr, fq); }
        }
        E(acc, cur, wr, wc, fr, fq);
        if (!has_next) break;
#pragma unroll
        for (int a = 0; a < 2; ++a)
#pragma unroll
            for (int b = 0; b < 2; ++b)
#pragma unroll
                for (int m = 0; m < 4; ++m)
#pragma unroll
                    for (int n = 0; n < 2; ++n) acc[a][b][m][n] = (f32x4){0.f, 0.f, 0.f, 0.f};
        cur = nxt; cA = nA; cB = nB; ubA = nubA; ++ui;
        if constexpr (GA) {
#pragma unroll
            for (int h_ = 0; h_ < 2; ++h_) { cv[h_][0] = nv[h_][0]; cv[h_][1] = nv[h_][1]; } }
    }
    PG8_WAIT_V(0);
    if (wr == 0) PG8_BAR;
    PG8_BAR;
#undef PG8_ATILE
#undef PG8_GVOFF
#undef PG8_SA
#undef PG8_SB
#undef PG8_STAGE
#undef PG8_LDA
#undef PG8_LDB
#undef PG8_MMA
#undef PG8_WAIT_V
#undef PG8_WAIT_L
#undef PG8_BAR
#undef PG8_SCHED
}
}

struct Args { const float* in[33]; float* out; unsigned char* ws; int ph_lo, ph_hi; };
static_assert(offsetof(Args, out) == 264 && offsetof(Args, ws) == 272, "kernarg layout");
typedef const float* cfptr_t;
typedef __attribute__((address_space(4))) const cfptr_t* kain_t;
typedef __attribute__((address_space(4))) const unsigned char* kab_t;
struct Frame {
    kain_t in; float* out; unsigned char* ws; LAS unsigned char* lds;
    int tid, lane, wid, G, bid;
};
enum { I_X = 0, I_C, I_CTX, I_CCTX, I_WADA, I_BADA, I_N1G, I_N2G, I_WIN, I_POOLW, I_POOLS, I_QNG, I_KNG, I_LAMQK, I_SUBLN, I_SHMU, I_DW0, I_DW2, I_AA0, I_AA2, I_GW2, I_KK, I_KA, I_RK, I_GNW, I_GNB,
       I_WBR, I_WOUT, I_WRG, I_WRE, I_WEG, I_WEU, I_WED };
template <class T> DI T* wsp(const Frame& F, size_t off) { return (T*)(F.ws + off); }
DI const float* xrow_ptr(const Frame& F, const float* xlat, int r) { return r < NCTX ? wsp<const float>(F, OFF_CTX) + (size_t)r * DM : xlat + (size_t)(r - NCTX) * DM; }
DI Frame phase_frame(const Frame& F0) { Frame F = F0; F.lane = launder(lane_id()); F.wid = F0.wid; F.tid = (F.wid << 6) | F.lane;
    kab_t ka = (kab_t)__builtin_amdgcn_kernarg_segment_ptr(); asm volatile("" : "+s"(ka));
    F.in = (kain_t)ka; F.out = *(float* const __attribute__((address_space(4)))*)(ka + 264); F.ws = *(unsigned char* const __attribute__((address_space(4)))*)(ka + 272); return F; }
DI int row_cond(int r) { return r < NCTX ? 2 : (r - NCTX) / SEQ; }
DI const float* modp(const Frame& F, int l, int cond, int j) { return wsp<const float>(F, OFF_MOD) + ((size_t)(l * 3 + cond) * 6 + j) * DM; }

DI void convT_tile(const Frame& F, const float* src, int src_ld, int k0, int n0, bf16_t* dst, int dst_ld, int drow0) {
    LAS float* tile = (LAS float*)F.lds;
    const int t = F.tid;
    { const int k = t >> 3, n8 = (t & 7) * 8; const float* p = src + (size_t)(k0 + k) * src_ld + n0 + n8;
      const f32x4 a = *(const f32x4*)p, b = *(const f32x4*)(p + 4);
      LAS float* q = tile + k * 65 + n8; q[0] = a[0]; q[1] = a[1]; q[2] = a[2]; q[3] = a[3]; q[4] = b[0]; q[5] = b[1]; q[6] = b[2]; q[7] = b[3]; }
    __syncthreads();
    { const int n = t >> 3, k8 = (t & 7) * 8; float f[8];
#pragma unroll
      for (int j = 0; j < 8; ++j) f[j] = tile[(k8 + j) * 65 + n];
      *(u32x4*)(dst + (size_t)(drow0 + n) * dst_ld + k0 + k8) = pack8(f); }
    __syncthreads();
}
DI void convT(const Frame& F, const float* src, int src_ld, int K, int n_lo, int n_hi, bf16_t* dst, int dst_ld, int drow_base, int rot) {
    const int tk = K / 64, tn = (n_hi - n_lo) / 64, ntile = tk * tn;
    for (int t = (F.bid + rot) % F.G; t < ntile; t += F.G) { const int kt = t % tk, nt_ = t / tk; convT_tile(F, src, src_ld, kt * 64, n_lo + nt_ * 64, dst, dst_ld, drow_base + nt_ * 64); }
}

DI void conv_small_weights(const Frame& F, int l) {
    const int gt = F.bid * 512 + F.tid, gn = F.G * 512;
    bf16_t* win = wsp<bf16_t>(F, OFF_WIN);
    const float* w_in = F.in[I_WIN] + (size_t)l * DM * IN_W;
    convT(F, w_in, IN_W, DM, 0, 3968, win, DM, 0, 0);
    convT(F, w_in, IN_W, DM, 3968, IN_W, win, DM, 4096, 64);
    for (int i = gt; i < 128 * DM / 8; i += gn) *(u32x4*)(win + (size_t)3968 * DM + (size_t)i * 8) = (u32x4){0u, 0u, 0u, 0u};
    bf16_t* wmg = wsp<bf16_t>(F, OFF_WMG);
    const float* w_br = F.in[I_WBR] + (size_t)l * 3 * 512 * DM;
    convT(F, w_br + (size_t)1 * 512 * DM, DM, 512, 0, DM, wmg + 512, 1536, 0, 128);
    convT(F, w_br + (size_t)2 * 512 * DM, DM, 512, 0, DM, wmg + 1024, 1536, 0, 192);
    {
        const float* pw = F.in[I_POOLW] + (size_t)l * 4 * 128 * 128; const float* ps = F.in[I_POOLS] + (size_t)l * 512;
        for (int i = gt; i < DM * 64; i += gn) {
            const int n = i & 1023, c8 = i >> 10, k0 = c8 * 8, g = k0 >> 7, c0 = k0 & 127; float acc[8];
#pragma unroll
            for (int j = 0; j < 8; ++j) acc[j] = 0.f;
            for (int d = 0; d < 128; ++d) { const float wb = ps[g * 128 + d] * w_br[(size_t)(g * 128 + d) * DM + n];
#pragma unroll
                for (int j = 0; j < 8; ++j) acc[j] += pw[(size_t)(g * 128 + c0 + j) * 128 + d] * wb; }
            *(u32x4*)(wmg + (size_t)n * 1536 + k0) = pack8(acc);
        }
    }
    convT(F, F.in[I_WOUT] + (size_t)l * DM * DM, DM, DM, 0, DM, wsp<bf16_t>(F, OFF_WOUT), DM, 0, 32);
    {
        bf16_t* wl = wsp<bf16_t>(F, OFF_WLORA);
        const float* dw2 = F.in[I_DW2] + (size_t)l * 2 * 64 * 512; const float* aa2 = F.in[I_AA2] + (size_t)l * 2 * 64 * 512; const float* gw2 = F.in[I_GW2] + (size_t)l * 128 * 512;
        for (int i = gt; i < LORA_N * (LORA_K / 8); i += gn) {
            const int n = i % LORA_N, k0 = (i / LORA_N) * 8, kind = n >> 9, c = n & 511; float f[8];
#pragma unroll
            for (int j = 0; j < 8; ++j) { const int k = k0 + j; float v = 0.f;
                if (kind < 2) { if (k >= kind * 64 && k < kind * 64 + 64) v = dw2[((size_t)kind * 64 + (k - kind * 64)) * 512 + c]; }
                else if (kind < 4) { const int d = kind - 2; if (k >= 128 + d * 64 && k < 192 + d * 64) v = aa2[((size_t)d * 64 + (k - 128 - d * 64)) * 512 + c]; }
                else { if (k >= 256) v = gw2[(size_t)(k - 256) * 512 + c]; }
                f[j] = v; }
            *(u32x4*)(wl + (size_t)n * LORA_K + k0) = pack8(f);
        }
    }
}
DI void conv_expert_weights(const Frame& F, int l) {
    const int gt = F.bid * 512 + F.tid, gn = F.G * 512;
    bf16_t* w1 = wsp<bf16_t>(F, OFF_WE1); bf16_t* w2 = wsp<bf16_t>(F, OFF_WE2);
    const float* wg = F.in[I_WEG] + (size_t)l * NEXP * DM * FF; const float* wu = F.in[I_WEU] + (size_t)l * NEXP * DM * FF; const float* wd = F.in[I_WED] + (size_t)l * NEXP * FF * DM;
    const int tt = F.tid, lk = tt >> 3, l8 = (tt & 7) * 8;
    const int NT = NEXP * 384;
#define EXP_TILE(t_, srcp_, dstp_) do { const int e_ = (t_) / 384, r_ = (t_) % 384; \
        if (r_ < 256) { const int up_ = r_ >> 7, q_ = r_ & 127, kt_ = q_ & 15, nt_ = q_ >> 4, ff0_ = nt_ * 64, drow_ = 256 * (ff0_ >> 7) + 128 * up_ + (ff0_ & 127); \
            srcp_ = (up_ ? wu : wg) + (size_t)e_ * DM * FF + (size_t)(kt_ * 64 + lk) * FF + ff0_ + l8; dstp_ = w1 + (size_t)e_ * 1024 * 1024 + (size_t)(drow_ + lk) * DM + kt_ * 64 + l8; } \
        else { const int q_ = r_ - 256, kt_ = q_ & 7, nt_ = q_ >> 3; \
            srcp_ = wd + (size_t)e_ * FF * DM + (size_t)(kt_ * 64 + lk) * DM + nt_ * 64 + l8; dstp_ = w2 + (size_t)e_ * 1024 * 512 + (size_t)(nt_ * 64 + lk) * FF + kt_ * 64 + l8; } } while (0)
    for (int base = F.bid; base < NT; base += 4 * F.G) {
        f32x4 ra[4], rb[4]; bf16_t* dp[4];
#pragma unroll
        for (int s_ = 0; s_ < 4; ++s_) { const int t = base + s_ * F.G < NT ? base + s_ * F.G : base; const float* sp; EXP_TILE(t, sp, dp[s_]); ra[s_] = *(const f32x4*)sp; rb[s_] = *(const f32x4*)(sp + 4); }
#pragma unroll
        for (int s_ = 0; s_ < 4; ++s_) { LAS float* q = (LAS float*)F.lds + s_ * (64 * 65) + lk * 65 + l8; const f32x4 a = ra[s_], b = rb[s_]; q[0] = a[0]; q[1] = a[1]; q[2] = a[2]; q[3] = a[3]; q[4] = b[0]; q[5] = b[1]; q[6] = b[2]; q[7] = b[3]; }
        __syncthreads();
#pragma unroll
        for (int s_ = 0; s_ < 4; ++s_) { if (base + s_ * F.G >= NT) break; const LAS float* tile = (const LAS float*)F.lds + s_ * (64 * 65); float f[8];
#pragma unroll
            for (int j = 0; j < 8; ++j) f[j] = tile[(l8 + j) * 65 + lk];
            *(u32x4*)dp[s_] = pack8(f); }
        __syncthreads();
    }
#undef EXP_TILE
}
DI void conv_router_weights(const Frame& F, int l) {
    const int gt = F.bid * 512 + F.tid, gn = F.G * 512;
    bf16_t* wr = wsp<bf16_t>(F, OFF_WRT);
    const float* wrg = F.in[I_WRG] + (size_t)l * DM * 4; const float* wre = F.in[I_WRE] + (size_t)l * DM * 32;
    for (int i = gt; i < 256 * (DM / 8); i += gn) { const int n = i & 255, k0 = (i >> 8) * 8; float f[8];
#pragma unroll
        for (int j = 0; j < 8; ++j) f[j] = n < 4 ? wrg[(size_t)(k0 + j) * 4 + n] : (n < 36 ? wre[(size_t)(k0 + j) * 32 + (n - 4)] : 0.f);
        *(u32x4*)(wr + (size_t)n * DM + k0) = pack8(f); }
}
DI void p0_prologue(const Frame& F) {
    LAS float* sl = (LAS float*)F.lds;
    LAS float* red = sl + 3 * DM;
    for (int i = F.tid; i < 3 * DM; i += 512) { const int cond = i >> 10, k = i & 1023; const float v = cond < 2 ? F.in[I_C][cond * DM + k] : F.in[I_CCTX][k]; sl[i] = v * sigmoidf_(v); }
    __syncthreads();
    for (int cg = F.bid; cg < 192; cg += F.G) {
        const int l = cg / 96, col = (cg % 96) * 64 + F.lane;
        const float* W = F.in[I_WADA] + (size_t)l * DM * 6144 + col;
        float s0 = 0.f, s1 = 0.f, s2 = 0.f;
        const int kb = F.wid * 128;
#pragma unroll 8
        for (int k = kb; k < kb + 128; ++k) { const float w = W[(size_t)k * 6144]; s0 += sl[k] * w; s1 += sl[DM + k] * w; s2 += sl[2 * DM + k] * w; }
        red[(F.wid * 3 + 0) * 64 + F.lane] = s0; red[(F.wid * 3 + 1) * 64 + F.lane] = s1; red[(F.wid * 3 + 2) * 64 + F.lane] = s2;
        __syncthreads();
        if (F.tid < 192) { const int cond = F.tid >> 6, ln = F.tid & 63; float s = 0.f;
#pragma unroll
            for (int w = 0; w < 8; ++w) s += red[(w * 3 + cond) * 64 + ln];
            const int n = (cg % 96) * 64 + ln;
            wsp<float>(F, OFF_MOD)[(size_t)(l * 3 + cond) * 6144 + n] = s + F.in[I_BADA][(size_t)l * 6144 + n]; }
        __syncthreads();
    }
    { const int gt = F.bid * 512 + F.tid, gn = F.G * 512; float* cx = wsp<float>(F, OFF_CTX);
      for (int i = gt; i < NCTX * DM / 4; i += gn) ((f32x4*)cx)[i] = ((const f32x4*)F.in[I_CTX])[i]; }
    __syncthreads();
    conv_small_weights(F, 0);
}

DI void norm_rows(const Frame& F, const float* xlat, const float* g, int l, int j_shift, int j_scale, bf16_t* dst, int r_begin = 0) {
    const int gw = F.bid * 8 + F.wid, nw = F.G * 8;
    f32x4 gv[4];
#pragma unroll
    for (int j = 0; j < 4; ++j) gv[j] = *(const f32x4*)(g + 4 * F.lane + 256 * j);
    for (int r0 = r_begin + gw * 4; r0 < MROWS; r0 += nw * 4) {
        f32x4 v[4][4]; float ss[4];
#pragma unroll
        for (int q = 0; q < 4; ++q) { const float* xr = xrow_ptr(F, xlat, r0 + q);
#pragma unroll
            for (int j = 0; j < 4; ++j) v[q][j] = *(const f32x4*)(xr + 4 * F.lane + 256 * j); }
        const int cond = row_cond(r0); const float* sh = modp(F, l, cond, j_shift); const float* sc = modp(F, l, cond, j_scale);
        f32x4 s4v[4], c4v[4];
#pragma unroll
        for (int j = 0; j < 4; ++j) { s4v[j] = *(const f32x4*)(sh + 4 * F.lane + 256 * j); c4v[j] = *(const f32x4*)(sc + 4 * F.lane + 256 * j); }
#pragma unroll
        for (int q = 0; q < 4; ++q) { float a = 0.f;
#pragma unroll
            for (int j = 0; j < 4; ++j) a += v[q][j][0] * v[q][j][0] + v[q][j][1] * v[q][j][1] + v[q][j][2] * v[q][j][2] + v[q][j][3] * v[q][j][3];
            ss[q] = a; }
#pragma unroll
        for (int sft = 1; sft < 64; sft <<= 1) {
#pragma unroll
            for (int q = 0; q < 4; ++q) ss[q] += __shfl_xor(ss[q], sft); }
#pragma unroll
        for (int j = 0; j < 4; ++j) { const f32x4 s4 = s4v[j], c4 = c4v[j];
#pragma unroll
            for (int q = 0; q < 4; ++q) { const float inv = rsqrtf(ss[q] * (1.0f / DM) + 1e-6f); float o[4];
#pragma unroll
                for (int e = 0; e < 4; ++e) o[e] = (v[q][j][e] * inv * gv[j][e]) * (1.0f + c4[e]) + s4[e];
                u32x2 w; w.x = pk2(o[0], o[1]); w.y = pk2(o[2], o[3]);
                *(u32x2*)(dst + (size_t)(r0 + q) * DM + 4 * F.lane + 256 * j) = w; } }
    }
}

struct EpiInproj {
    static constexpr bool PERM = true, SEG = false;
    unsigned char* ws;
    DI void operator()(const f32x4 (&acc)[2][2][4][2], const pg8::Unit& u, int wr, int wc, int fr, int fq) const {
        bf16_t* dst; int ld, colt;
        if (u.pn < 8) { dst = (bf16_t*)(ws + R1) + (size_t)(u.pn >> 1) * U_EL; ld = 512; colt = (u.pn & 1) * 256; } else { dst = (bf16_t*)(ws + OFF_RWRAW); ld = 2048; colt = (u.pn - 8) * 256; }
        const int row0 = u.pm * 256 + wr * 64 + fr, col0 = colt + wc * 32 + 8 * fq;
#pragma unroll
        for (int ai = 0; ai < 2; ++ai)
#pragma unroll
            for (int m = 0; m < 4; ++m) { bf16_t* rowp = dst + (size_t)(row0 + ai * 128 + m * 16) * ld + col0;
#pragma unroll
                for (int bj = 0; bj < 2; ++bj) { const f32x4 v0 = acc[ai][bj][m][0], v1 = acc[ai][bj][m][1]; u32x4 w; w.x = pk2(v0[0], v0[1]); w.y = pk2(v0[2], v0[3]); w.z = pk2(v1[0], v1[1]); w.w = pk2(v1[2], v1[3]);
                    *(u32x4*)(rowp + bj * 128) = w; } }
    }
};
struct EpiLora {
    static constexpr bool PERM = true, SEG = false;
    unsigned char* ws; const float* w0; const float* a0;
    DI void operator()(const f32x4 (&acc)[2][2][4][2], const pg8::Unit& u, int wr, int wc, int fr, int fq) const {
        fr = launder(fr); fq = launder(fq);
        const int kind = u.pn >> 1; bf16_t* dst = (bf16_t*)(ws + R2) + (size_t)kind * U_EL; const int colt = (u.pn & 1) * 256;
        const int row0 = u.pm * 256 + wr * 64 + fr, col0 = colt + wc * 32 + 8 * fq;
        const float* bias = kind < 2 ? w0 + kind * 512 : a0 + ((kind - 2) & 1) * 512;
        const float mul = kind < 2 ? 0.60653065971f : 1.0f;
        if (kind < 4) {
#pragma unroll
            for (int bj = 0; bj < 2; ++bj) { const f32x4 b0 = *(const f32x4*)(bias + col0 + bj * 128), b1 = *(const f32x4*)(bias + col0 + bj * 128 + 4);
#pragma unroll
                for (int ai = 0; ai < 2; ++ai)
#pragma unroll
                    for (int m = 0; m < 4; ++m) { bf16_t* rowp = dst + (size_t)(row0 + ai * 128 + m * 16) * 512 + col0;
                        f32x4 v0 = acc[ai][bj][m][0], v1 = acc[ai][bj][m][1];
#pragma unroll
                        for (int e = 0; e < 4; ++e) { v0[e] = mul * sigmoidf_(v0[e] + b0[e]); v1[e] = mul * sigmoidf_(v1[e] + b1[e]); }
                        u32x4 w; w.x = pk2(v0[0], v0[1]); w.y = pk2(v0[2], v0[3]); w.z = pk2(v1[0], v1[1]); w.w = pk2(v1[2], v1[3]);
                        *(u32x4*)(rowp + bj * 128) = w; }
                asm volatile("" ::: "memory"); }
        } else {
#pragma unroll
            for (int bj = 0; bj < 2; ++bj)
#pragma unroll
                for (int ai = 0; ai < 2; ++ai)
#pragma unroll
                    for (int m = 0; m < 4; ++m) { bf16_t* rowp = dst + (size_t)(row0 + ai * 128 + m * 16) * 512 + col0;
                        const f32x4 v0 = acc[ai][bj][m][0], v1 = acc[ai][bj][m][1];
                        u32x4 w; w.x = pk2(v0[0], v0[1]); w.y = pk2(v0[2], v0[3]); w.z = pk2(v1[0], v1[1]); w.w = pk2(v1[2], v1[3]);
                        *(u32x4*)(rowp + bj * 128) = w; }
        }
    }
};
struct EpiGates {
    static constexpr bool PERM = true, SEG = false;
    bf16_t* G;
    DI void operator()(const f32x4 (&acc)[2][2][4][2], const pg8::Unit& u, int wr, int wc, int fr, int fq) const {
        const int row0 = u.pm * 256 + wr * 64 + fr, col0 = u.pn * 256 + wc * 32 + 8 * fq;
#pragma unroll
        for (int ai = 0; ai < 2; ++ai)
#pragma unroll
            for (int m = 0; m < 4; ++m) { bf16_t* rowp = G + (size_t)(row0 + ai * 128 + m * 16) * N_GATE + col0;
#pragma unroll
                for (int bj = 0; bj < 2; ++bj) { f32x4 v0 = acc[ai][bj][m][0], v1 = acc[ai][bj][m][1];
#pragma unroll
                    for (int e = 0; e < 4; ++e) { v0[e] = sigmoidf_(v0[e]); v1[e] = sigmoidf_(v1[e]); }
                    u32x4 w; w.x = pk2(v0[0], v0[1]); w.y = pk2(v0[2], v0[3]); w.z = pk2(v1[0], v1[1]); w.w = pk2(v1[2], v1[3]);
                    *(u32x4*)(rowp + bj * 128) = w; } }
    }
};
struct EpiMerge {
    static constexpr bool PERM = true, SEG = true;
    const bf16_t* G; bf16_t* mg;
    DI void mid(f32x4 (&acc)[2][2][4][2], const pg8::Unit& u, int seg, int wr, int wc, int fr, int fq) const {
        const int row0 = u.pm * 256 + wr * 64 + fr, col0 = u.pn * 256 + wc * 32 + 8 * fq;
#pragma unroll
        for (int ai = 0; ai < 2; ++ai)
#pragma unroll
            for (int m = 0; m < 4; ++m) { const bf16_t* gp = G + (size_t)(row0 + ai * 128 + m * 16) * N_GATE + (seg - 1) * DM + col0;
#pragma unroll
                for (int bj = 0; bj < 2; ++bj) { float ga[8], gb[8]; unpack8(*(const u32x4*)(gp + bj * 128), ga); unpack8(*(const u32x4*)(gp + DM + bj * 128), gb);
#pragma unroll
                    for (int e = 0; e < 4; ++e) { acc[ai][bj][m][0][e] *= fmaxf(ga[e], 1e-30f) * __builtin_amdgcn_rcpf(fmaxf(gb[e], 1e-30f)); acc[ai][bj][m][1][e] *= fmaxf(ga[4 + e], 1e-30f) * __builtin_amdgcn_rcpf(fmaxf(gb[4 + e], 1e-30f)); } }
                asm volatile("" ::: "memory"); }
    }
    DI void operator()(const f32x4 (&acc)[2][2][4][2], const pg8::Unit& u, int wr, int wc, int fr, int fq) const {
        const int row0 = u.pm * 256 + wr * 64 + fr, col0 = u.pn * 256 + wc * 32 + 8 * fq;
#pragma unroll
        for (int ai = 0; ai < 2; ++ai)
#pragma unroll
            for (int m = 0; m < 4; ++m) { const size_t row = (size_t)(row0 + ai * 128 + m * 16);
#pragma unroll
                for (int bj = 0; bj < 2; ++bj) { const f32x4 v0 = acc[ai][bj][m][0], v1 = acc[ai][bj][m][1];
                    float gv[8], o[8]; unpack8(*(const u32x4*)(G + row * N_GATE + 2 * DM + col0 + bj * 128), gv);
#pragma unroll
                    for (int e = 0; e < 4; ++e) { o[e] = fmaxf(gv[e], 1e-30f) * v0[e]; o[4 + e] = fmaxf(gv[4 + e], 1e-30f) * v1[e]; }
                    *(u32x4*)(mg + row * DM + col0 + bj * 128) = pack8(o); }
                asm volatile("" ::: "memory"); }
    }
};
struct EpiResid {
    static constexpr bool PERM = false, SEG = false;
    const float* xlat_in; float* xlat_out; float* ctxb; const float* modl;
    DI void operator()(const f32x4 (&acc)[2][2][4][2], const pg8::Unit& u, int wr, int wc, int fr, int fq) const {
        const int col0 = u.pn * 256 + wc * 32 + 4 * fq; const bool isctx = u.pm < 2; const int cond = isctx ? 2 : (u.pm - 2) / 64;
        const float* src = isctx ? ctxb + (size_t)u.pm * 256 * DM : xlat_in + (size_t)(u.pm - 2) * 256 * DM;
        float* dst = isctx ? ctxb + (size_t)u.pm * 256 * DM : xlat_out + (size_t)(u.pm - 2) * 256 * DM;
        const float* gate = modl + (size_t)(cond * 6 + 2) * DM + col0;
#pragma unroll
        for (int bj = 0; bj < 2; ++bj)
#pragma unroll
            for (int n = 0; n < 2; ++n) { const f32x4 gv = *(const f32x4*)(gate + bj * 128 + n * 16);
#pragma unroll
                for (int ai = 0; ai < 2; ++ai) { f32x4 xo[4];
#pragma unroll
                    for (int m = 0; m < 4; ++m) xo[m] = *(const f32x4*)(src + (size_t)(wr * 64 + fr + ai * 128 + m * 16) * DM + col0 + bj * 128 + n * 16);
#pragma unroll
                    for (int m = 0; m < 4; ++m) *(f32x4*)(dst + (size_t)(wr * 64 + fr + ai * 128 + m * 16) * DM + col0 + bj * 128 + n * 16) = xo[m] + gv * acc[ai][bj][m][n];
                    asm volatile("" ::: "memory"); } }
    }
};
struct EpiLogits {
    static constexpr bool PERM = false, SEG = false;
    float* lg;
    DI void operator()(const f32x4 (&acc)[2][2][4][2], const pg8::Unit& u, int wr, int wc, int fr, int fq) const {
        if (wc >= 2) return;
        const int row0 = u.pm * 256 + wr * 64 + fr, col0 = wc * 32 + 4 * fq;
#pragma unroll
        for (int ai = 0; ai < 2; ++ai)
#pragma unroll
            for (int m = 0; m < 4; ++m)
#pragma unroll
                for (int n = 0; n < 2; ++n) *(f32x4*)(lg + (size_t)(row0 + ai * 128 + m * 16) * 64 + col0 + n * 16) = acc[ai][0][m][n];
    }
};
struct EpiAct {
    static constexpr bool PERM = true, SEG = false;
    bf16_t* act;
    DI void operator()(const f32x4 (&acc)[2][2][4][2], const pg8::Unit& u, int wr, int wc, int fr, int fq) const {
        const int row0 = u.pm * 256 + wr * 64 + fr, col0 = u.pn * 128 + wc * 32 + 8 * fq;
#pragma unroll
        for (int ai = 0; ai < 2; ++ai)
#pragma unroll
            for (int m = 0; m < 4; ++m) { float o[8];
#pragma unroll
                for (int n = 0; n < 2; ++n)
#pragma unroll
                    for (int e = 0; e < 4; ++e) { const float gt = acc[ai][0][m][n][e], up = acc[ai][1][m][n][e]; o[4 * n + e] = gt * sigmoidf_(gt) * up; }
                *(u32x4*)(act + (size_t)(row0 + ai * 128 + m * 16) * FF + col0) = pack8(o); }
    }
};
struct EpiY {
    static constexpr bool PERM = true, SEG = false;
    bf16_t* y;
    DI void operator()(const f32x4 (&acc)[2][2][4][2], const pg8::Unit& u, int wr, int wc, int fr, int fq) const {
        const int row0 = u.pm * 256 + wr * 64 + fr, col0 = u.pn * 256 + wc * 32 + 8 * fq;
#pragma unroll
        for (int ai = 0; ai < 2; ++ai)
#pragma unroll
            for (int m = 0; m < 4; ++m) { bf16_t* rowp = y + (size_t)(row0 + ai * 128 + m * 16) * DM + col0;
#pragma unroll
                for (int bj = 0; bj < 2; ++bj) { const f32x4 v0 = acc[ai][bj][m][0], v1 = acc[ai][bj][m][1]; u32x4 w; w.x = pk2(v0[0], v0[1]); w.y = pk2(v0[2], v0[3]); w.z = pk2(v1[0], v1[1]); w.w = pk2(v1[2], v1[3]);
                    *(u32x4*)(rowp + bj * 128) = w; } }
    }
};

DI void seq_of_row(int r, int& t, int& len) { if (r < NCTX) { t = r & 255; len = CTXL; } else { t = (r - NCTX) & (SEQ - 1); len = SEQ; } }

DI void phaseC_rows(const Frame& F, int l) {
    const int gw = F.bid * 8 + F.wid, nw = F.G * 8, lane = F.lane;
    bf16_t* Q = wsp<bf16_t>(F, OFF_Q); bf16_t* Kp = wsp<bf16_t>(F, OFF_K);
    const bf16_t* POOL = wsp<bf16_t>(F, OFF_POOL); bf16_t* PD = wsp<bf16_t>(F, OFF_PDIFF);
    const bf16_t* RW = wsp<bf16_t>(F, OFF_RWRAW); bf16_t* AL = wsp<bf16_t>(F, OFF_ALORA);
    bf16_t* RR = wsp<bf16_t>(F, OFF_RR); bf16_t* RK = wsp<bf16_t>(F, OFF_RK); bf16_t* RV = wsp<bf16_t>(F, OFF_RV); bf16_t* RKK = wsp<bf16_t>(F, OFF_RKK);
    const int i8 = lane & 7, axis = i8 >> 2, sec = (i8 >> 1) & 1, fb = (i8 & 1) * 8;
    float qg[8], kg[8];
#pragma unroll
    for (int e = 0; e < 8; ++e) { qg[e] = F.in[I_QNG][l * 64 + i8 * 8 + e]; kg[e] = F.in[I_KNG][l * 64 + i8 * 8 + e]; }
    LAS float* mul_ = (LAS float*)(F.lds + 32768);
    { const float* mu = F.in[I_SHMU] + (size_t)l * 2 * RW_IN; const float* kkw = F.in[I_KK] + (size_t)l * 512;
      for (int i = F.tid; i < 2 * RW_IN + 512; i += 512) mul_[i] = i < 2 * RW_IN ? mu[i] : kkw[i - 2 * RW_IN]; }
    __syncthreads();
    const float QSCALE = 0.125f * 1.4426950408889634f;
    for (int r = gw; r < MROWS; r += nw) {
        int t, len; seq_of_row(r, t, len);
        const int half = 1 << (lane >> 4); const int lo = max(t - half, 0), hi = min(t + half - 1, len - 1);
        const bool hp = t > 0, hn = t < len - 1; const bf16_t* cur = RW + (size_t)r * 2048;
        u32x4 wq, wk, wself, xw[16], rc[4], rp[4], rn[4];
        __builtin_amdgcn_sched_barrier(0);
        wq = *(const u32x4*)(Q + (size_t)r * 512 + 8 * lane); wk = *(const u32x4*)(Kp + (size_t)r * 512 + 8 * lane);
        wself = *(const u32x4*)(POOL + (size_t)r * 512 + 8 * lane);
#pragma unroll
        for (int j = 0; j < 16; ++j) { const int tt = t - 8 + j; const bool ok = tt >= lo && tt <= hi; xw[j] = *(const u32x4*)(POOL + (size_t)(ok ? r + (tt - t) : r) * 512 + 8 * lane); }
#pragma unroll
        for (int ch = 0; ch < 4; ++ch) { const int c0 = ch * 512 + 8 * (ch == 3 ? min(lane, 47) : lane);
            rc[ch] = *(const u32x4*)(cur + c0); rp[ch] = *(const u32x4*)(cur - (hp ? 2048 : 0) + c0); rn[ch] = *(const u32x4*)(cur + (hn ? 2048 : 0) + c0); }
        __builtin_amdgcn_sched_barrier(0);
        float cs[8], sn[8];
        if (r >= NCTX) { const float pos = (float)(axis ? (t & 63) : (t >> 6));
#pragma unroll
            for (int e = 0; e < 8; ++e) { const float invf = __builtin_amdgcn_exp2f(-(float)(fb + e) * 0.83048202372184059f); const float rev = (pos * invf) * 0.15915494309189535f;
                cs[e] = __builtin_amdgcn_cosf(rev); sn[e] = __builtin_amdgcn_sinf(rev); }
        } else {
#pragma unroll
            for (int e = 0; e < 8; ++e) { cs[e] = 1.f; sn[e] = 0.f; } }
#pragma unroll
        for (int which = 0; which < 2; ++which) {
            bf16_t* p = (which ? Kp : Q) + (size_t)r * 512 + 8 * lane; float x[8]; unpack8(which ? wk : wq, x);
            float ss = 0.f;
#pragma unroll
            for (int e = 0; e < 8; ++e) ss += x[e] * x[e];
            ss = sum8(ss); const float rinv = rsqrtf(ss * (1.0f / 64.0f) + 1e-6f);
            float o[8];
#pragma unroll
            for (int e = 0; e < 8; ++e) { const float y = x[e] * rinv * (which ? kg[e] : qg[e]); const float yp = __shfl_xor(y, 2);
                o[e] = y * cs[e] + (sec ? yp : -yp) * sn[e]; if (!which) o[e] *= QSCALE; }
            *(u32x4*)p = pack8(o);
        }
        {
            float s[8], self[8];
#pragma unroll
            for (int e = 0; e < 8; ++e) s[e] = 0.f;
            unpack8(wself, self);
#pragma unroll
            for (int j = 0; j < 16; ++j) { const int tt = t - 8 + j; const float mk = (tt >= lo && tt <= hi) ? 1.0f : 0.0f; float x[8]; unpack8(xw[j], x);
#pragma unroll
                for (int e = 0; e < 8; ++e) s[e] += mk * x[e]; }
            const float ic = 1.0f / (float)(hi - lo + 1); float o[8];
#pragma unroll
            for (int e = 0; e < 8; ++e) o[e] = s[e] * ic - self[e];
            *(u32x4*)(PD + (size_t)r * 512 + 8 * lane) = pack8(o);
        }
        {
#pragma unroll
            for (int ch = 0; ch < 4; ++ch) {
                if (ch == 3 && lane >= 48) break;
                const int c0 = ch * 512 + 8 * lane; float x[8], xp[8], xn[8], u[8];
                unpack8(rc[ch], x); unpack8(rp[ch], xp); unpack8(rn[ch], xn);
                if (!hp) {
#pragma unroll
                    for (int e = 0; e < 8; ++e) xp[e] = 0.f; }
                if (!hn) {
#pragma unroll
                    for (int e = 0; e < 8; ++e) xn[e] = 0.f; }
                const f32x4 m0a = *(const LAS f32x4*)(mul_ + c0), m0b = *(const LAS f32x4*)(mul_ + c0 + 4), m1a = *(const LAS f32x4*)(mul_ + RW_IN + c0), m1b = *(const LAS f32x4*)(mul_ + RW_IN + c0 + 4);
#pragma unroll
                for (int e = 0; e < 8; ++e) { const float m0 = e < 4 ? m0a[e & 3] : m0b[e & 3], m1 = e < 4 ? m1a[e & 3] : m1b[e & 3]; u[e] = x[e] + (xp[e] - x[e]) * m0 + (xn[e] - x[e]) * m1; }
                if (ch == 0) *(u32x4*)(RR + (size_t)r * 512 + 8 * lane) = pack8(u);
                else if (ch == 2) *(u32x4*)(RV + (size_t)r * 512 + 8 * lane) = pack8(u);
                else if (ch == 1) {
                    *(u32x4*)(RK + (size_t)r * 512 + 8 * lane) = pack8(u);
                    const f32x4 kka = *(const LAS f32x4*)(mul_ + 2 * RW_IN + 8 * lane), kkb = *(const LAS f32x4*)(mul_ + 2 * RW_IN + 8 * lane + 4); float kk[8], ss = 0.f;
#pragma unroll
                    for (int e = 0; e < 8; ++e) { kk[e] = u[e] * (e < 4 ? kka[e & 3] : kkb[e & 3]); ss += kk[e] * kk[e]; }
                    ss = sum8(ss); const float inv = 1.0f / fmaxf(sqrtf(ss), 1e-12f);
#pragma unroll
                    for (int e = 0; e < 8; ++e) kk[e] *= inv;
                    *(u32x4*)(RKK + (size_t)r * 512 + 8 * lane) = pack8(kk);
                } else {
                    float o[8];
#pragma unroll
                    for (int e = 0; e < 8; ++e) { if (lane < 16) { const float ex = __expf(2.0f * u[e]); o[e] = 1.0f - 2.0f * __builtin_amdgcn_rcpf(ex + 1.0f); } else if (lane < 32) o[e] = u[e]; else o[e] = sigmoidf_(u[e]); }
                    *(u32x4*)(AL + (size_t)r * LORA_K + 8 * lane) = pack8(o);
                }
            }
        }
    }
}
DI void phaseC_vt(const Frame& F) {
    const bf16_t* V = wsp<bf16_t>(F, OFF_V); bf16_t* VT = wsp<bf16_t>(F, RVT);
    LAS bf16_t* T = (LAS bf16_t*)F.lds;
    for (int task = F.bid; task < NB * 4 * (KEYS / 64); task += F.G) {
        const int kb = task % (KEYS / 64), bh = task / (KEYS / 64), b = bh >> 2, h = bh & 3;
        const int row0 = kb < 4 ? b * CTXL + kb * 64 : NCTX + b * SEQ + (kb - 4) * 64;
#pragma unroll
        for (int i = 0; i < 2; ++i) { const int ci = F.tid + 512 * i, j = ci >> 4, c = ci & 15;
            const u32x4 w = *(const u32x4*)(V + (size_t)(row0 + j) * 512 + h * 128 + c * 8);
            LAS unsigned* q = (LAS unsigned*)(T + j * 136 + c * 8); q[0] = w.x; q[1] = w.y; q[2] = w.z; q[3] = w.w; }
        __syncthreads();
#pragma unroll
        for (int i = 0; i < 2; ++i) { const int ci = F.tid + 512 * i, vd = ci >> 3, p8 = ci & 7; unsigned w[4];
#pragma unroll
            for (int e2 = 0; e2 < 4; ++e2) { unsigned pr = 0;
#pragma unroll
                for (int q = 0; q < 2; ++q) { const int p = p8 * 8 + e2 * 2 + q, gq = p >> 4, pp = p & 15, hh = pp >> 3, ee = pp & 7, ko = 8 * (ee >> 2) + 4 * hh + (ee & 3);
                    pr |= ((unsigned)T[(gq * 16 + ko) * 136 + vd]) << (16 * q); }
                w[e2] = pr; }
            *(u32x4*)(VT + ((size_t)bh * 128 + vd) * KEYS + kb * 64 + p8 * 8) = (u32x4){w[0], w[1], w[2], w[3]}; }
        __syncthreads();
    }
}

#define MFMA32(a, b, c) __builtin_amdgcn_mfma_f32_32x32x16_bf16((a), (b), (c), 0, 0, 0)
constexpr int ATT_KB = 16384, ATT_STG = 32768;
DI void attn_phase(const Frame& F, int l, int nunits) {
    const int tid = F.tid, wid = F.wid, lane = F.lane, l32 = lane & 31, hh = lane >> 5, g = wid >> 1, m = wid & 1;
    const bf16_t* Q = wsp<bf16_t>(F, OFF_Q); const bf16_t* Kg = wsp<bf16_t>(F, OFF_K); const bf16_t* VT = wsp<bf16_t>(F, RVT); bf16_t* ATT = wsp<bf16_t>(F, OFF_POOL);
    const float* lq = F.in[I_LAMQK] + (size_t)l * 256;
    float d0 = lq[lane] * lq[64 + lane], d1 = lq[128 + lane] * lq[192 + lane]; d0 = wave_sum(d0); d1 = wave_sum(d1);
    const float lam_init = 0.8f - 0.6f * expf(-0.3f * (float)l);
    const float lam = expf(d0) - expf(d1) + lam_init, lamfac = 1.0f - lam_init;
    const float* sg = F.in[I_SUBLN] + (size_t)l * 128;
    LAS float* xch = (LAS float*)F.lds;
    LAS float* sgl = (LAS float*)(F.lds + MISC_OFF + 2048);
    if (wid < 2) sgl[wid * 64 + lane] = sg[wid * 64 + lane];
    (void)tid;
    for (int u = F.bid; u < nunits; u += F.G) {
        int b, h, qrow0, nkt;
        if (u < 512) { const int bh = u & 7, qt = ((u >> 3) & 31) + 32 * (u >> 8); b = bh >> 2; h = bh & 3; qrow0 = NCTX + b * SEQ + qt * 256; nkt = KEYS / 64; } else { const int uu = u - 512; b = uu >> 2; h = uu & 3; qrow0 = b * CTXL; nkt = 4; }
        bf16x8 qf[2][4];
#pragma unroll
        for (int qs = 0; qs < 2; ++qs) { const bf16_t* qp = Q + (size_t)(qrow0 + g * 64 + qs * 32 + l32) * 512 + h * 128 + m * 64 + hh * 8;
#pragma unroll
            for (int ks = 0; ks < 4; ++ks) qf[qs][ks] = *(const bf16x8*)(qp + ks * 16); }
        f32x16 o[2][4];
#pragma unroll
        for (int qs = 0; qs < 2; ++qs)
#pragma unroll
            for (int vt = 0; vt < 4; ++vt)
#pragma unroll
                for (int i = 0; i < 16; ++i) o[qs][vt][i] = 0.f;
        float lsum[2] = {0.f, 0.f};
        const bf16_t* vtb = VT + (size_t)(b * 4 + h) * 128 * KEYS;
#define KROW0(kt) ((kt) < 4 ? b * CTXL + (kt) * 64 : NCTX + b * SEQ + ((kt) - 4) * 64)
#define ISSUE_TILE(kt, buf) do { const int ln_ = launder(lane); const int kr0_ = KROW0(kt); _Pragma("unroll") for (int q_ = 0; q_ < 2; ++q_) { const int j_ = 2 * wid + q_; \
            { const int row_ = 4 * j_ + (ln_ >> 4), c_ = (ln_ & 15) ^ (row_ & 15); \
              __builtin_amdgcn_global_load_lds((const unsigned*)(Kg + (size_t)(kr0_ + row_) * 512 + h * 128 + c_ * 8), (LAS unsigned*)(F.lds + (buf) * ATT_STG + j_ * 1024), 16, 0, 0); } \
            { const int row_ = 8 * j_ + (ln_ >> 3), c_ = (ln_ & 7) ^ ((row_ >> 1) & 7); \
              __builtin_amdgcn_global_load_lds((const unsigned*)(vtb + (size_t)row_ * KEYS + (kt) * 64 + c_ * 8), (LAS unsigned*)(F.lds + (buf) * ATT_STG + ATT_KB + j_ * 1024), 16, 0, 0); } } } while (0)
        __syncthreads();
        ISSUE_TILE(0, 0);
        for (int kt = 0; kt < nkt; ++kt) {
            const int buf = kt & 1;
            asm volatile("s_waitcnt vmcnt(0)" ::: "memory");
            __syncthreads();
            const int ln = launder(lane); const int l32b = ln & 31, hb = ln >> 5;
            const LAS unsigned char* Kb = F.lds + buf * ATT_STG + l32b * 256; const int kx = l32b & 15;
            const LAS unsigned char* Vb = F.lds + buf * ATT_STG + ATT_KB + l32b * 128; const int vx = (l32b >> 1) & 7;
#define KFRAG(kk_, ks_) (*(const LAS bf16x8*)(Kb + (kk_) * 8192 + (((m * 8 + (ks_) * 2 + hb) ^ kx) << 4)))
#define VFRAG(kk_, i_) (*(const LAS bf16x8*)(Vb + ((i_) >> 1) * 4096 + ((((kk_) * 4 + ((i_) & 1) * 2 + hb) ^ vx) << 4)))
#define SBA_ __builtin_amdgcn_sched_barrier(0)
            bf16x8 kf[4];
#pragma unroll
            for (int ks = 0; ks < 4; ++ks) kf[ks] = KFRAG(0, ks);
            SBA_;
            if (kt + 1 < nkt) ISSUE_TILE(kt + 1, buf ^ 1);
            SBA_;
#pragma unroll
            for (int kk = 0; kk < 2; ++kk) {
                f32x16 sv[2];
#pragma unroll
                for (int qs = 0; qs < 2; ++qs)
#pragma unroll
                    for (int i = 0; i < 16; ++i) sv[qs][i] = 0.f;
#pragma unroll
                for (int ks = 0; ks < 4; ++ks) { sv[0] = MFMA32(kf[ks], qf[0][ks], sv[0]); sv[1] = MFMA32(kf[ks], qf[1][ks], sv[1]); }
                SBA_;
                bf16x8 vfr[3]; vfr[0] = VFRAG(kk, 0); vfr[1] = VFRAG(kk, 1);
                if (kk == 0) {
#pragma unroll
                    for (int ks = 0; ks < 4; ++ks) kf[ks] = KFRAG(1, ks); }
                SBA_;
                bf16x8 pb[2][2];
#pragma unroll
                for (int qs = 0; qs < 2; ++qs)
#pragma unroll
                    for (int jp = 0; jp < 2; ++jp) { u32x4 w; float p[8];
#pragma unroll
                        for (int e = 0; e < 8; ++e) { p[e] = __builtin_amdgcn_exp2f(sv[qs][8 * jp + e]); lsum[qs] += p[e]; }
                        w.x = pk2(p[0], p[1]); w.y = pk2(p[2], p[3]); w.z = pk2(p[4], p[5]); w.w = pk2(p[6], p[7]); pb[qs][jp] = __builtin_bit_cast(bf16x8, w); }
                SBA_;
#pragma unroll
                for (int i = 0; i < 8; ++i) { const int vt = i >> 1, jp = i & 1;
                    if (i + 2 < 8) vfr[(i + 2) % 3] = VFRAG(kk, i + 2);
                    SBA_;
                    o[0][vt] = MFMA32(vfr[i % 3], pb[0][jp], o[0][vt]); o[1][vt] = MFMA32(vfr[i % 3], pb[1][jp], o[1][vt]);
                    SBA_; }
            }
#undef KFRAG
#undef VFRAG
#undef SBA_
        }
#undef ISSUE_TILE
#undef KROW0
        __syncthreads();
        float cm[2];
#pragma unroll
        for (int qs = 0; qs < 2; ++qs) { const float lt = lsum[qs] + __shfl_xor(lsum[qs], 32); cm[qs] = m ? lam / lt : 1.0f / lt; }
        if (m) {
#pragma unroll
            for (int qs = 0; qs < 2; ++qs)
#pragma unroll
                for (int vt = 0; vt < 4; ++vt)
#pragma unroll
                    for (int i = 0; i < 16; ++i) xch[((g * 2 + qs) * 64 + vt * 16 + i) * 64 + lane] = o[qs][vt][i] * cm[qs];
        }
        __syncthreads();
        if (!m) {
#pragma unroll
            for (int qs = 0; qs < 2; ++qs) {
                float ss = 0.f;
#pragma unroll
                for (int vt = 0; vt < 4; ++vt)
#pragma unroll
                    for (int i = 0; i < 16; ++i) { const float v = o[qs][vt][i] * cm[qs] - xch[((g * 2 + qs) * 64 + vt * 16 + i) * 64 + lane]; o[qs][vt][i] = v; ss += v * v; }
                ss += __shfl_xor(ss, 32);
                const float rn = rsqrtf(ss * (1.0f / 128.0f) + 1e-6f) * lamfac;
                bf16_t* op = ATT + (size_t)(qrow0 + g * 64 + qs * 32 + l32) * 512 + h * 128;
#pragma unroll
                for (int vt = 0; vt < 4; ++vt)
#pragma unroll
                    for (int q4 = 0; q4 < 4; ++q4) { const int vd = vt * 32 + q4 * 8 + hh * 4; const f32x4 g4 = *(const LAS f32x4*)(sgl + vd);
                        u32x2 w; w.x = pk2(o[qs][vt][4 * q4] * rn * g4[0], o[qs][vt][4 * q4 + 1] * rn * g4[1]); w.y = pk2(o[qs][vt][4 * q4 + 2] * rn * g4[2], o[qs][vt][4 * q4 + 3] * rn * g4[3]);
                        *(u32x2*)(op + vd) = w; }
            }
        }
    }
}

DI int crow_(int reg, int h) { return (reg & 3) + 8 * (reg >> 2) + 4 * h; }
DI int swz(int row, int chunk) { return row * 128 + ((chunk ^ ((row >> 1) & 7)) << 4); }
constexpr int SL_A = 0, SL_B = 8192, SL_K = 16384, SL_V = 24576, SL_T = 32768, SL_R = 40960, WAVE_LDS = 49152;
typedef LAS unsigned char* lds_t;
DI bf16x8 fragN(lds_t base, int row, int k0, int h) { return *(const LAS bf16x8*)(base + swz(row, (k0 >> 3) + h)); }
DI bf16x8 fragK(lds_t base, int row, int kt, int s, int h) { const int c0 = 4 * kt + 2 * s; const u32x2 a = *(const LAS u32x2*)(base + swz(row, c0) + 8 * h), b = *(const LAS u32x2*)(base + swz(row, c0 + 1) + 8 * h);
    return __builtin_bit_cast(bf16x8, (u32x4){a.x, a.y, b.x, b.y}); }
DI void zero_acc(f32x16 (&acc)[2][2]) {
#pragma unroll
    for (int a = 0; a < 2; ++a)
#pragma unroll
        for (int b = 0; b < 2; ++b)
#pragma unroll
            for (int i = 0; i < 16; ++i) acc[a][b][i] = 0.f; }
DI void mm_nn(f32x16 (&acc)[2][2], lds_t A, lds_t B, int l32, int h) {
    l32 = launder(l32); h = launder(h);
    bf16x8 af[4][2], bf[4][2];
#pragma unroll
    for (int ks = 0; ks < 4; ++ks)
#pragma unroll
        for (int q = 0; q < 2; ++q) { af[ks][q] = fragN(A, 32 * q + l32, 16 * ks, h); bf[ks][q] = fragN(B, 32 * q + l32, 16 * ks, h); }
#pragma unroll
    for (int ks = 0; ks < 4; ++ks)
#pragma unroll
        for (int ra = 0; ra < 2; ++ra)
#pragma unroll
            for (int cb = 0; cb < 2; ++cb) acc[ra][cb] = MFMA32(af[ks][ra], bf[ks][cb], acc[ra][cb]);
}
DI void mm_nn_lp(f32x16 (&acc)[2][2], lds_t A, lds_t B, int l32, int h) {
    l32 = launder(l32); h = launder(h);
#pragma unroll
    for (int kp = 0; kp < 2; ++kp) { bf16x8 af[2][2], bf[2][2];
#pragma unroll
        for (int ks = 0; ks < 2; ++ks)
#pragma unroll
            for (int q = 0; q < 2; ++q) { af[ks][q] = fragN(A, 32 * q + l32, 16 * (2 * kp + ks), h); bf[ks][q] = fragN(B, 32 * q + l32, 16 * (2 * kp + ks), h); }
#pragma unroll
        for (int ks = 0; ks < 2; ++ks)
#pragma unroll
            for (int ra = 0; ra < 2; ++ra)
#pragma unroll
                for (int cb = 0; cb < 2; ++cb) acc[ra][cb] = MFMA32(af[ks][ra], bf[ks][cb], acc[ra][cb]); }
}
DI void mm_xt(f32x16 (&acc)[2][2], const bf16x8 (&xf)[2][2][2], lds_t Y, int l32, int h) {
    l32 = launder(l32); h = launder(h);
#pragma unroll
    for (int it = 0; it < 2; ++it)
#pragma unroll
        for (int s = 0; s < 2; ++s) { bf16x8 yf[2];
#pragma unroll
            for (int vt = 0; vt < 2; ++vt) yf[vt] = fragK(Y, 32 * vt + l32, it, s, h);
#pragma unroll
            for (int tt = 0; tt < 2; ++tt)
#pragma unroll
                for (int vt = 0; vt < 2; ++vt) acc[vt][tt] = MFMA32(yf[vt], xf[it][tt][s], acc[vt][tt]); }
}
DI void mm_st(f32x16 (&acc)[2][2], lds_t A, const bf16x8 (&sf)[2][2][2], int l32, int h) {
    l32 = launder(l32); h = launder(h);
#pragma unroll
    for (int ct = 0; ct < 2; ++ct)
#pragma unroll
        for (int s = 0; s < 2; ++s) { bf16x8 af[2];
#pragma unroll
            for (int tt = 0; tt < 2; ++tt) af[tt] = fragK(A, 32 * tt + l32, ct, s, h);
#pragma unroll
            for (int tt = 0; tt < 2; ++tt)
#pragma unroll
                for (int vt = 0; vt < 2; ++vt) acc[vt][tt] = MFMA32(sf[ct][vt][s], af[tt], acc[vt][tt]); }
}
DI bf16x8 pack_regs(const f32x16& x, int s) { u32x4 w; w.x = pk2(x[8 * s], x[8 * s + 1]); w.y = pk2(x[8 * s + 2], x[8 * s + 3]); w.z = pk2(x[8 * s + 4], x[8 * s + 5]); w.w = pk2(x[8 * s + 6], x[8 * s + 7]); return __builtin_bit_cast(bf16x8, w); }
template <int INCL> DI void pack_masked(const f32x16 (&acc)[2][2], bf16x8 (&xf)[2][2][2], int l32, int h) {
#pragma unroll
    for (int it = 0; it < 2; ++it)
#pragma unroll
        for (int tt = 0; tt < 2; ++tt) { f32x16 m;
#pragma unroll
            for (int r = 0; r < 16; ++r) { const int i = 32 * it + crow_(r, h), t = 32 * tt + l32; m[r] = (INCL ? i <= t : i < t) ? acc[it][tt][r] : 0.f; }
            xf[it][tt][0] = pack_regs(m, 0); xf[it][tt][1] = pack_regs(m, 1); }
}
DI void store_tm(const f32x16 (&acc)[2][2], lds_t img, int l32, int h) {
    l32 = launder(l32); h = launder(h);
#pragma unroll
    for (int a = 0; a < 2; ++a)
#pragma unroll
        for (int b = 0; b < 2; ++b)
#pragma unroll
            for (int q = 0; q < 4; ++q) { u32x2 w; w.x = pk2(acc[a][b][4 * q], acc[a][b][4 * q + 1]); w.y = pk2(acc[a][b][4 * q + 2], acc[a][b][4 * q + 3]);
                *(LAS u32x2*)(img + swz(32 * b + l32, 4 * a + q) + 8 * h) = w; }
}
DI void solve_rows(lds_t rhs, lds_t tab, lds_t out, int lane) {
    lane = launder(lane);
    lds_t orow = out + lane * 128; const int sw = (lane >> 1) & 7; const int rb = ((lane >> 3) << 4), rl = (lane & 7) * 2;
    const int l32 = lane & 31, h = lane >> 5;
#define DOT4(a, cw, xw, j0) asm volatile("v_dot2c_f32_bf16 %0, %4, %20\n\tv_dot2c_f32_bf16 %1, %8, %20\n\tv_dot2c_f32_bf16 %2, %12, %20\n\tv_dot2c_f32_bf16 %3, %16, %20\n\t" \
                              "v_dot2c_f32_bf16 %0, %5, %21\n\tv_dot2c_f32_bf16 %1, %9, %21\n\tv_dot2c_f32_bf16 %2, %13, %21\n\tv_dot2c_f32_bf16 %3, %17, %21\n\t" \
                              "v_dot2c_f32_bf16 %0, %6, %22\n\tv_dot2c_f32_bf16 %1, %10, %22\n\tv_dot2c_f32_bf16 %2, %14, %22\n\tv_dot2c_f32_bf16 %3, %18, %22\n\t" \
                              "v_dot2c_f32_bf16 %0, %7, %23\n\tv_dot2c_f32_bf16 %1, %11, %23\n\tv_dot2c_f32_bf16 %2, %15, %23\n\tv_dot2c_f32_bf16 %3, %19, %23\n\ts_nop 3" \
                : "+v"(a[j0]), "+v"(a[j0 + 1]), "+v"(a[j0 + 2]), "+v"(a[j0 + 3]) \
                : "v"(cw[j0].x), "v"(cw[j0].y), "v"(cw[j0].z), "v"(cw[j0].w), "v"(cw[j0 + 1].x), "v"(cw[j0 + 1].y), "v"(cw[j0 + 1].z), "v"(cw[j0 + 1].w), \
                  "v"(cw[j0 + 2].x), "v"(cw[j0 + 2].y), "v"(cw[j0 + 2].z), "v"(cw[j0 + 2].w), "v"(cw[j0 + 3].x), "v"(cw[j0 + 3].y), "v"(cw[j0 + 3].z), "v"(cw[j0 + 3].w), \
                  "v"(xw.x), "v"(xw.y), "v"(xw.z), "v"(xw.w))
    f32x16 u0[2], u1[2], zero;
#pragma unroll
    for (int i = 0; i < 16; ++i) { zero[i] = 0.f; u1[0][i] = 0.f; u1[1][i] = 0.f; u0[0][i] = 0.f; u0[1][i] = 0.f; }
#pragma unroll
    for (int b = 0; b < 4; ++b) {
        const int tA = 16 * b, tB = tA + 8, cA = 2 * b, cB = cA + 1;
        float a[8], a2[8]; u32x4 dg0[8], cw[8], dg1[8];
#pragma unroll
        for (int j = 0; j < 8; ++j) { const int t = tA + j, u = tB + j;
            a[j] = bf2f(*(const LAS bf16_t*)(rhs + t * 128 + (rb ^ (((t >> 1) & 7) << 4)) + rl)); a2[j] = bf2f(*(const LAS bf16_t*)(rhs + u * 128 + (rb ^ (((u >> 1) & 7) << 4)) + rl)); }
#pragma unroll
        for (int j = 0; j < 8; ++j) { const int t = tA + j, u = tB + j;
            dg0[j] = *(const LAS u32x4*)(tab + t * 128 + ((cA ^ ((t >> 1) & 7)) << 4)); cw[j] = *(const LAS u32x4*)(tab + u * 128 + ((cA ^ ((u >> 1) & 7)) << 4)); dg1[j] = *(const LAS u32x4*)(tab + u * 128 + ((cB ^ ((u >> 1) & 7)) << 4)); }
        if (b > 0) { const int k0 = 16 * (b - 1); const bf16x8 xb0 = fragN(out, l32, k0, h), xb1 = fragN(out, 32 + l32, k0, h);
            if (b == 1) { const bf16x8 af0 = fragN(tab, l32, k0, h); u0[0] = MFMA32(af0, xb0, zero); u0[1] = MFMA32(af0, xb1, zero); }
            const bf16x8 af1 = fragN(tab, 32 + l32, k0, h); u1[0] = MFMA32(af1, xb0, u1[0]); u1[1] = MFMA32(af1, xb1, u1[1]);
            const int R0 = (b == 2) ? 0 : 8;
#pragma unroll
            for (int i = 0; i < 8; ++i) { const float X = (b == 1) ? u0[0][R0 + i] : u1[0][R0 + i], Y = (b == 1) ? u0[1][R0 + i] : u1[1][R0 + i];
                const auto r = __builtin_amdgcn_permlane32_swap(__float_as_uint(X), __float_as_uint(Y), false, false);
                const float lo = __uint_as_float(r[0]), hi = __uint_as_float(r[1]);
                if (i < 4) { a[i] += lo; a[4 + i] += hi; } else { a2[i - 4] += lo; a2[i] += hi; } }
        }
#pragma unroll
        for (int j = 1; j < 8; ++j) { float cf[8]; unpack8(dg0[j], cf);
#pragma unroll
            for (int q = 0; q < 8; ++q) if (q < j) a[j] += cf[q] * a[q]; }
        const u32x4 x0 = pack8(a);
        *(LAS u32x4*)(orow + ((cA ^ sw) << 4)) = x0;
        DOT4(a2, cw, x0, 0); DOT4(a2, cw, x0, 4);
#pragma unroll
        for (int j = 1; j < 8; ++j) { float cf[8]; unpack8(dg1[j], cf);
#pragma unroll
            for (int q = 0; q < 8; ++q) if (q < j) a2[j] += cf[q] * a2[q]; }
        *(LAS u32x4*)(orow + ((cB ^ sw) << 4)) = pack8(a2);
    }
#undef DOT4
}
struct ScanTask { int chain, h, r0, sgn; };
DI int scan_order(int q) { const int rbk = q >> 5, j = q & 31, dir = j & 1, bh = j >> 1, chain = dir * 16 + bh;
    const int ck = dir ? (rbk < 4 ? 3 - rbk : 4 + 255 - (rbk - 4)) : rbk; return chain * NCHUNK + ck; }
DI int scan_deal(int bid, int slot3, int trip, int G) {
    if (G != 256) { const int q = bid * 3 + slot3 + trip * G * 3; return q < 32 * NCHUNK ? scan_order(q) : -1; }
    const int xcd = bid & 7, sl = (bid >> 3) * 3 + slot3, grp = (trip * 8 + xcd) * 6 + sl / 16, mem = sl % 16;
    if (grp >= 2 * NCHUNK) return -1;
    const int rbk = grp >> 1, b = grp & 1, dir = mem & 1, hd = mem >> 1, chain = dir * 16 + b * 8 + hd;
    const int ck = dir ? (rbk < 4 ? 3 - rbk : 4 + 255 - (rbk - 4)) : rbk; return chain * NCHUNK + ck; }

DI ScanTask scan_task(int task) { ScanTask T; T.chain = task / NCHUNK; const int ck = task % NCHUNK, dir = T.chain >> 4, b = (T.chain >> 3) & 1; T.h = T.chain & 7;
    int base, len, c2; if (ck < 4) { base = b * CTXL; len = CTXL; c2 = ck; } else { base = NCTX + b * SEQ; len = SEQ; c2 = ck - 4; }
    T.r0 = dir ? base + len - 1 - 64 * c2 : base + 64 * c2; T.sgn = dir ? -1 : 1; return T; }
DI void write_cm_row(lds_t img, const unsigned (&pk)[32], int lane) {
    lane = launder(lane);
#pragma unroll
    for (int ch = 0; ch < 8; ++ch) *(LAS u32x4*)(img + swz(lane, ch)) = (u32x4){pk[4 * ch], pk[4 * ch + 1], pk[4 * ch + 2], pk[4 * ch + 3]};
}
DI void stage_raw(const bf16_t* src, const ScanTask& T, lds_t dst, int lane) {
    lane = launder(lane);
#pragma unroll
    for (int i = 0; i < 8; ++i) { const int q = lane + 64 * i, t = q >> 3, c8 = q & 7;
        *(LAS u32x4*)(dst + swz(t, c8)) = *(const u32x4*)(src + (size_t)(T.r0 + T.sgn * t) * 512 + T.h * 64 + c8 * 8); }
}
template <int N> DI void stage_raw_n(const bf16_t* const (&src)[N], const int (&slot)[N], const ScanTask& T, lds_t wl, int lane) {
    lane = launder(lane);
    u32x4 v[N][8];
    __builtin_amdgcn_sched_barrier(0);
#pragma unroll
    for (int p = 0; p < N; ++p)
#pragma unroll
        for (int i = 0; i < 8; ++i) { const int q = lane + 64 * i, t = q >> 3, c8 = q & 7; v[p][i] = *(const u32x4*)(src[p] + (size_t)(T.r0 + T.sgn * t) * 512 + T.h * 64 + c8 * 8); }
    __builtin_amdgcn_sched_barrier(0);
#pragma unroll
    for (int p = 0; p < N; ++p)
#pragma unroll
        for (int i = 0; i < 8; ++i) { const int q = lane + 64 * i, t = q >> 3, c8 = q & 7; *(LAS u32x4*)(wl + slot[p] + swz(t, c8)) = v[p][i]; }
    __builtin_amdgcn_sched_barrier(0);
}
DI void read_col(lds_t img, unsigned (&pk)[32], int lane) {
    lane = launder(lane);
    const int tw = ((lane >> 3) << 4), tb = (lane & 7) * 2;
    unsigned lo[32], hi[32];
#pragma unroll
    for (int t2 = 0; t2 < 32; ++t2) { const int ta = 2 * t2, tc = 2 * t2 + 1;
        lo[t2] = *(const LAS bf16_t*)(img + ta * 128 + (tw ^ (((ta >> 1) & 7) << 4)) + tb); hi[t2] = *(const LAS bf16_t*)(img + tc * 128 + (tw ^ (((tc >> 1) & 7) << 4)) + tb); }
#pragma unroll
    for (int t2 = 0; t2 < 32; ++t2) pk[t2] = lo[t2] | (hi[t2] << 16);
}
template <bool P3>
DI float scan_prep(const Frame& F, int l, const ScanTask& T, lds_t wl, int lane) {
    const int dir = T.chain >> 4;
    if (P3) { const bf16_t* const src[6] = {wsp<bf16_t>(F, OFF_RKK), wsp<bf16_t>(F, OFF_RK), wsp<bf16_t>(F, dir ? OFF_AB : OFF_AF), wsp<bf16_t>(F, dir ? OFF_EB : OFF_EF), wsp<bf16_t>(F, OFF_RV), wsp<bf16_t>(F, OFF_RR)};
        const int slot[6] = {SL_A, SL_K, SL_B, SL_T, SL_V, SL_R}; stage_raw_n<6>(src, slot, T, wl, lane); }
    else { const bf16_t* const src[5] = {wsp<bf16_t>(F, OFF_RKK), wsp<bf16_t>(F, OFF_RK), wsp<bf16_t>(F, dir ? OFF_AB : OFF_AF), wsp<bf16_t>(F, dir ? OFF_EB : OFF_EF), wsp<bf16_t>(F, OFF_RV)};
        const int slot[5] = {SL_A, SL_K, SL_B, SL_T, SL_V}; stage_raw_n<5>(src, slot, T, wl, lane); }
    const float ka = F.in[I_KA][(size_t)l * 512 + T.h * 64 + lane];
    float E2 = 0.f, gprev = 1.f;
    lane = launder(lane);
    const int tw = ((lane >> 3) << 4), tb = (lane & 7) * 2;
#pragma unroll 1
    for (int t8 = 0; t8 < 8; ++t8) {
        float kk_[8], k_[8], al_[8], e_[8], r_[8]; int off_[8];
#pragma unroll
        for (int j = 0; j < 8; ++j) { const int t = t8 * 8 + j; off_[j] = t * 128 + (tw ^ (((t >> 1) & 7) << 4)) + tb;
            kk_[j] = bf2f(*(const LAS bf16_t*)(wl + SL_A + off_[j])); k_[j] = bf2f(*(const LAS bf16_t*)(wl + SL_K + off_[j])); al_[j] = bf2f(*(const LAS bf16_t*)(wl + SL_B + off_[j]));
            e_[j] = bf2f(*(const LAS bf16_t*)(wl + SL_T + off_[j])); r_[j] = P3 ? bf2f(*(const LAS bf16_t*)(wl + SL_R + off_[j])) : 0.f; }
#pragma unroll
        for (int j = 0; j < 8; ++j) {
            E2 += e_[j] * 1.4426950408889634f;
            const float g = __builtin_amdgcn_exp2f(-E2), ex = __builtin_amdgcn_rcpf(g);
            const float at = -kk_[j] * gprev, bh = kk_[j] * al_[j] * ex, kh = k_[j] * (1.0f + (al_[j] - 1.0f) * ka) * ex;
            gprev = g;
            if (P3) *(LAS bf16_t*)(wl + SL_R + off_[j]) = f2bf(r_[j] * g);
            *(LAS bf16_t*)(wl + SL_A + off_[j]) = f2bf(at); *(LAS bf16_t*)(wl + SL_B + off_[j]) = f2bf(bh); *(LAS bf16_t*)(wl + SL_K + off_[j]) = f2bf(kh);
        }
    }
    { unsigned vcm[32]; read_col(wl + SL_V, vcm, lane); write_cm_row(wl + SL_V, vcm, lane); }
    return gprev;
}
DI void make_table(lds_t wl, int l32, int h, int slot_b = SL_B) {
    l32 = launder(l32); h = launder(h);
    f32x16 acc[2][2]; zero_acc(acc); mm_nn(acc, wl + slot_b, wl + SL_A, l32, h);
#pragma unroll
    for (int it = 0; it < 2; ++it)
#pragma unroll
        for (int tt = 0; tt < 2; ++tt)
#pragma unroll
            for (int q = 0; q < 4; ++q) { const int t = 32 * tt + l32, i0 = 32 * it + 8 * q + 4 * h; float v[4];
#pragma unroll
                for (int e = 0; e < 4; ++e) v[e] = (i0 + e < t) ? acc[it][tt][4 * q + e] : 0.f;
                u32x2 w; w.x = pk2(v[0], v[1]); w.y = pk2(v[2], v[3]);
                *(LAS u32x2*)(wl + SL_T + swz(t, 4 * it + q) + 8 * h) = w; }
}
DI void scan_pass1(const Frame& F, int l) {
    const int lane = F.lane, l32 = lane & 31, h = lane >> 5, pr = F.wid >> 1, role = F.wid & 1;
    lds_t wl = F.lds + (pr < 3 ? pr : 0) * WAVE_LDS; LAS float* gtab = (LAS float*)(F.lds + MISC_OFF + 512 + (pr < 3 ? pr : 0) * 256);
    u32x4* MP = wsp<u32x4>(F, OFF_MP); u32x4* NS = wsp<u32x4>(F, OFF_NS);
    const int ntrip = (32 * NCHUNK + F.G * 3 - 1) / (F.G * 3);
    u32x4 pf[3][8];
#define P1_REQUEST(task_) do { const ScanTask Tq_ = scan_task(task_); const int dq_ = Tq_.chain >> 4; const int ln_ = launder(lane); \
        const bf16_t* s0_ = role ? wsp<bf16_t>(F, OFF_RK) : wsp<bf16_t>(F, OFF_RKK); const bf16_t* s1_ = role ? wsp<bf16_t>(F, OFF_RV) : wsp<bf16_t>(F, dq_ ? OFF_AB : OFF_AF); const bf16_t* s2_ = wsp<bf16_t>(F, dq_ ? OFF_EB : OFF_EF); \
        __builtin_amdgcn_sched_barrier(0); \
        _Pragma("unroll") for (int i_ = 0; i_ < 8; ++i_) { const int q_ = ln_ + 64 * i_, t_ = q_ >> 3, c8_ = q_ & 7; const size_t ro_ = (size_t)(Tq_.r0 + Tq_.sgn * t_) * 512 + Tq_.h * 64 + c8_ * 8; \
            pf[0][i_] = *(const u32x4*)(s0_ + ro_); pf[1][i_] = *(const u32x4*)(s1_ + ro_); if (role == 0) pf[2][i_] = *(const u32x4*)(s2_ + ro_); else asm volatile("" : "=v"(pf[2][i_].x), "=v"(pf[2][i_].y), "=v"(pf[2][i_].z), "=v"(pf[2][i_].w)); } \
        __builtin_amdgcn_sched_barrier(0); } while (0)
#define P1_UNDEF() do { _Pragma("unroll") for (int p_ = 0; p_ < 3; ++p_) _Pragma("unroll") for (int i_ = 0; i_ < 8; ++i_) asm volatile("" : "=v"(pf[p_][i_].x), "=v"(pf[p_][i_].y), "=v"(pf[p_][i_].z), "=v"(pf[p_][i_].w)); } while (0)
    { const int t0_ = pr < 3 ? scan_deal(F.bid, pr, 0, F.G) : -1; if (t0_ >= 0) P1_REQUEST(t0_); else P1_UNDEF(); }
    for (int trip = 0; trip < ntrip; ++trip) {
        const int task_ = pr < 3 ? scan_deal(F.bid, pr, trip, F.G) : -1; const bool on = task_ >= 0; const int task = on ? task_ : 0;
        ScanTask T = scan_task(on ? task : 0); const int dir = T.chain >> 4; (void)dir;
        const int tw = ((launder(lane) >> 3) << 4), tb = (launder(lane) & 7) * 2;
        if (on) { const int ln_ = launder(lane);
#pragma unroll
            for (int i_ = 0; i_ < 8; ++i_) { const int q_ = ln_ + 64 * i_, t_ = q_ >> 3, c8_ = q_ & 7;
                *(LAS u32x4*)(wl + (role ? SL_K : SL_A) + swz(t_, c8_)) = pf[0][i_]; *(LAS u32x4*)(wl + (role ? SL_V : SL_B) + swz(t_, c8_)) = pf[1][i_]; if (role == 0) *(LAS u32x4*)(wl + SL_T + swz(t_, c8_)) = pf[2][i_]; } }
        __syncthreads();
        if (on) {
            const float ka = F.in[I_KA][(size_t)l * 512 + T.h * 64 + lane];
            float E2 = 0.f, gprev = 1.f;
#pragma unroll 1
            for (int t8 = 0; t8 < 8; ++t8) {
                float x_[8], al_[8], e_[8]; int off_[8];
#pragma unroll
                for (int j = 0; j < 8; ++j) { const int t = t8 * 8 + j; off_[j] = t * 128 + (tw ^ (((t >> 1) & 7) << 4)) + tb;
                    x_[j] = bf2f(*(const LAS bf16_t*)(wl + (role ? SL_K : SL_A) + off_[j])); al_[j] = bf2f(*(const LAS bf16_t*)(wl + SL_B + off_[j])); e_[j] = bf2f(*(const LAS bf16_t*)(wl + SL_T + off_[j])); }
#pragma unroll
                for (int j = 0; j < 8; ++j) {
                    E2 += e_[j] * 1.4426950408889634f;
                    const float g = __builtin_amdgcn_exp2f(-E2), ex = __builtin_amdgcn_rcpf(g);
                    if (role == 0) { *(LAS bf16_t*)(wl + SL_A + off_[j]) = f2bf(-x_[j] * gprev); *(LAS bf16_t*)(wl + SL_R + off_[j]) = f2bf(x_[j] * al_[j] * ex); }
                    else *(LAS bf16_t*)(wl + SL_K + off_[j]) = f2bf(x_[j] * (1.0f + (al_[j] - 1.0f) * ka) * ex);
                    gprev = g;
                }
            }
            if (role == 0) gtab[lane] = gprev;
            else { unsigned vcm[32]; read_col(wl + SL_V, vcm, lane); write_cm_row(wl + SL_V, vcm, lane); }
        }
        __syncthreads();
        if (on) {
            if (role == 0) make_table(wl, l32, h, SL_R);
            else { bf16x8 xf[2][2][2];
                { f32x16 acc[2][2]; zero_acc(acc); mm_nn(acc, wl + SL_K, wl + SL_A, l32, h); pack_masked<0>(acc, xf, l32, h); }
                __builtin_amdgcn_sched_barrier(0);
                { f32x16 acc[2][2]; zero_acc(acc); mm_xt(acc, xf, wl + SL_V, l32, h); store_tm(acc, wl + SL_B, l32, h); } }
        }
        __syncthreads();
        if (on) {
            if (role == 0) { unsigned bcm[32]; read_col(wl + SL_R, bcm, lane); __builtin_amdgcn_sched_barrier(0);
                solve_rows(wl + SL_A, wl + SL_T, wl + SL_R, lane); __builtin_amdgcn_sched_barrier(0);
                write_cm_row(wl + SL_A, bcm, lane); }
            else { unsigned kcm[32]; read_col(wl + SL_K, kcm, lane); __builtin_amdgcn_sched_barrier(0);
                solve_rows(wl + SL_B, wl + SL_T, wl + SL_K, lane); __builtin_amdgcn_sched_barrier(0);
                write_cm_row(wl + SL_B, kcm, lane); }
        }
        __syncthreads();
        { const int tn_ = (pr < 3 && trip + 1 < ntrip) ? scan_deal(F.bid, pr, trip + 1, F.G) : -1; if (tn_ >= 0) P1_REQUEST(tn_); else P1_UNDEF(); }
        if (on) {
            if (role == 0) { u32x4* mp = MP + (size_t)task * 512 + launder(lane);
                f32x16 acc[2][2]; zero_acc(acc); mm_nn_lp(acc, wl + SL_R, wl + SL_A, l32, h);
#pragma unroll
                for (int ct = 0; ct < 2; ++ct)
#pragma unroll
                    for (int cp = 0; cp < 2; ++cp) { const float gc = gtab[32 * cp + launder(l32)]; f32x16 m;
#pragma unroll
                        for (int r = 0; r < 16; ++r) m[r] = (acc[ct][cp][r] + ((ct == cp && crow_(r, h) == l32) ? 1.0f : 0.0f)) * gc;
                        mp[((ct * 2 + cp) * 2 + 0) * 64] = __builtin_bit_cast(u32x4, pack_regs(m, 0)); mp[((ct * 2 + cp) * 2 + 1) * 64] = __builtin_bit_cast(u32x4, pack_regs(m, 1)); }
            } else { u32x4* ns = NS + (size_t)task * 512 + launder(lane);
                f32x16 acc[2][2]; zero_acc(acc); mm_nn_lp(acc, wl + SL_A, wl + SL_K, l32, h); mm_nn_lp(acc, wl + SL_B, wl + SL_V, l32, h);
#pragma unroll
                for (int cp = 0; cp < 2; ++cp)
#pragma unroll
                    for (int vt = 0; vt < 2; ++vt) { f32x16 m;
#pragma unroll
                        for (int q = 0; q < 4; ++q) { const f32x4 g4 = *(const LAS f32x4*)(gtab + 32 * cp + 8 * q + 4 * h);
#pragma unroll
                            for (int e = 0; e < 4; ++e) m[4 * q + e] = acc[cp][vt][4 * q + e] * g4[e]; }
                        ns[((cp * 2 + vt) * 2 + 0) * 64] = __builtin_bit_cast(u32x4, pack_regs(m, 0)); ns[((cp * 2 + vt) * 2 + 1) * 64] = __builtin_bit_cast(u32x4, pack_regs(m, 1)); }
            }
        }
        __syncthreads();
    }
#undef P1_REQUEST
#undef P1_UNDEF
}
DI void scan_pass2(const Frame& F) {
    if (F.wid != 0) return;
    const int lane = F.lane;
    for (int task = F.bid; task < 64; task += F.G) {
        const int chain = task >> 1, vt = task & 1;
        const u32x4* MP = wsp<u32x4>(F, OFF_MP) + (size_t)chain * NCHUNK * 512 + lane; u32x4* NS = wsp<u32x4>(F, OFF_NS) + (size_t)chain * NCHUNK * 512 + lane;
        u32x4 sf[2][2], mA[8], nA[2][2], mB[8], nB[2][2], mC[8], nC[2][2];
#define P2_LOAD(m_, n_, ck_) do { _Pragma("unroll") for (int i_ = 0; i_ < 8; ++i_) m_[i_] = MP[(size_t)(ck_) * 512 + i_ * 64]; \
        _Pragma("unroll") for (int a_ = 0; a_ < 2; ++a_) _Pragma("unroll") for (int st_ = 0; st_ < 2; ++st_) n_[a_][st_] = NS[(size_t)(ck_) * 512 + ((a_ * 2 + vt) * 2 + st_) * 64]; } while (0)
#define P2_STEP(m_, n_, ck_) do { \
        _Pragma("unroll") for (int a_ = 0; a_ < 2; ++a_) _Pragma("unroll") for (int st_ = 0; st_ < 2; ++st_) NS[(size_t)(ck_) * 512 + ((a_ * 2 + vt) * 2 + st_) * 64] = sf[a_][st_];        \
        f32x16 acc_[2]; \
        _Pragma("unroll") for (int cp_ = 0; cp_ < 2; ++cp_) _Pragma("unroll") for (int st_ = 0; st_ < 2; ++st_) { float f_[8]; unpack8(n_[cp_][st_], f_); \
            _Pragma("unroll") for (int j_ = 0; j_ < 8; ++j_) acc_[cp_][8 * st_ + j_] = f_[j_]; } \
        _Pragma("unroll") for (int ct_ = 0; ct_ < 2; ++ct_) _Pragma("unroll") for (int st_ = 0; st_ < 2; ++st_) _Pragma("unroll") for (int cp_ = 0; cp_ < 2; ++cp_) \
            acc_[cp_] = MFMA32(__builtin_bit_cast(bf16x8, m_[(ct_ * 2 + cp_) * 2 + st_]), __builtin_bit_cast(bf16x8, sf[ct_][st_]), acc_[cp_]); \
        _Pragma("unroll") for (int ct_ = 0; ct_ < 2; ++ct_) { sf[ct_][0] = __builtin_bit_cast(u32x4, pack_regs(acc_[ct_], 0)); sf[ct_][1] = __builtin_bit_cast(u32x4, pack_regs(acc_[ct_], 1)); } } while (0)
#pragma unroll
        for (int a = 0; a < 2; ++a)
#pragma unroll
            for (int st = 0; st < 2; ++st) sf[a][st] = (u32x4){0u, 0u, 0u, 0u};
        P2_LOAD(mA, nA, 0); P2_LOAD(mB, nB, 1);
        for (int ck = 0; ck < NCHUNK; ck += 3) {
            { const int nx = ck + 2 < NCHUNK ? ck + 2 : NCHUNK - 1; P2_LOAD(mC, nC, nx); }
            P2_STEP(mA, nA, ck);
            if (ck + 1 < NCHUNK) { { const int nx = ck + 3 < NCHUNK ? ck + 3 : NCHUNK - 1; P2_LOAD(mA, nA, nx); } P2_STEP(mB, nB, ck + 1); }
            if (ck + 2 < NCHUNK) { { const int nx = ck + 4 < NCHUNK ? ck + 4 : NCHUNK - 1; P2_LOAD(mB, nB, nx); } P2_STEP(mC, nC, ck + 2); }
        }
#undef P2_LOAD
#undef P2_STEP
    }
}
DI void scan_pass3(const Frame& F, int l) {
    if (F.wid >= 3) return;
    const int lane = F.lane, l32 = lane & 31, h = lane >> 5;
    lds_t wl = F.lds + F.wid * WAVE_LDS;
    const u32x4* NS = wsp<u32x4>(F, OFF_NS);
    const int ntrip3 = (32 * NCHUNK + F.G * 3 - 1) / (F.G * 3);
    for (int trip = 0; trip < ntrip3; ++trip) {
        const int task = scan_deal(F.bid, F.wid, trip, F.G); if (task < 0) continue;
        const ScanTask T = scan_task(task);
        (void)scan_prep<true>(F, l, T, wl, lane);
        make_table(wl, l32, h);
#define SB_ __builtin_amdgcn_sched_barrier(0)
#define LOAD_SF() do { const u32x4* ns = NS + (size_t)task * 512 + lane; _Pragma("unroll") for (int i = 0; i < 8; ++i) sf[i >> 2][(i >> 1) & 1][i & 1] = __builtin_bit_cast(bf16x8, ns[i * 64]); } while (0)
        bf16x8 xf[2][2][2], xg[2][2][2];
        { f32x16 acc[2][2]; zero_acc(acc); mm_nn(acc, wl + SL_K, wl + SL_A, l32, h); pack_masked<0>(acc, xf, l32, h); }
        SB_;
        { bf16x8 sf[2][2][2]; LOAD_SF(); f32x16 acc[2][2]; zero_acc(acc); mm_st(acc, wl + SL_A, sf, l32, h); SB_; mm_xt(acc, xf, wl + SL_V, l32, h); SB_; store_tm(acc, wl + SL_A, l32, h); }
        SB_;
        { f32x16 acc[2][2]; zero_acc(acc); mm_nn(acc, wl + SL_B, wl + SL_R, l32, h); pack_masked<1>(acc, xf, l32, h); }
        SB_;
        solve_rows(wl + SL_A, wl + SL_T, wl + SL_B, lane);
        SB_;
        unsigned tch[7]; const int tn_ = trip + 1 < ntrip3 ? scan_deal(F.bid, F.wid, trip + 1, F.G) : -1;
        if (tn_ >= 0) { const ScanTask Tn = scan_task(tn_); const int dn = Tn.chain >> 4; const size_t ro = (size_t)(Tn.r0 + Tn.sgn * launder(lane)) * 512 + Tn.h * 64;
            tch[0] = *(const unsigned*)(wsp<bf16_t>(F, OFF_RKK) + ro); tch[1] = *(const unsigned*)(wsp<bf16_t>(F, OFF_RK) + ro); tch[2] = *(const unsigned*)(wsp<bf16_t>(F, dn ? OFF_AB : OFF_AF) + ro);
            tch[3] = *(const unsigned*)(wsp<bf16_t>(F, dn ? OFF_EB : OFF_EF) + ro); tch[4] = *(const unsigned*)(wsp<bf16_t>(F, OFF_RV) + ro); tch[5] = *(const unsigned*)(wsp<bf16_t>(F, OFF_RR) + ro);
            tch[6] = *((const unsigned*)(NS + (size_t)tn_ * 512) + launder(lane) * 32); }
        else {
#pragma unroll
            for (int i = 0; i < 7; ++i) tch[i] = 0u; }
        SB_;
        f32x16 y[2][2]; zero_acc(y);
        mm_xt(y, xf, wl + SL_B, l32, h);
        SB_;
        { bf16x8 sf[2][2][2]; LOAD_SF(); mm_st(y, wl + SL_R, sf, l32, h); }
        SB_;
        { f32x16 acc[2][2]; zero_acc(acc); mm_nn(acc, wl + SL_K, wl + SL_R, l32, h); pack_masked<1>(acc, xg, l32, h); }
        SB_;
        mm_xt(y, xg, wl + SL_V, l32, h);
        SB_;
#undef LOAD_SF
        bf16_t* Y = wsp<bf16_t>(F, (T.chain >> 4) ? OFF_YB : OFF_YF);
        store_tm(y, wl + SL_A, l32, h);
        { const int ln = launder(lane);
#pragma unroll
          for (int i = 0; i < 8; ++i) { const int q = ln + 64 * i, t = q >> 3, c8 = q & 7;
              *(u32x4*)(Y + (size_t)(T.r0 + T.sgn * t) * 512 + T.h * 64 + c8 * 8) = *(const LAS u32x4*)(wl + SL_A + swz(t, c8)); } }
#pragma unroll
        for (int i = 0; i < 7; ++i) asm volatile("" :: "v"(tch[i]));
    }
}
DI void rwkv_out_rows(const Frame& F, int l, int r_begin) {
    const int gw = F.bid * 8 + F.wid, nw = F.G * 8, lane = F.lane, c0 = 8 * lane;
    const bf16_t* RR = wsp<bf16_t>(F, OFF_RR); const bf16_t* RK = wsp<bf16_t>(F, OFF_RK); const bf16_t* RV = wsp<bf16_t>(F, OFF_RV);
    const bf16_t* AF = wsp<bf16_t>(F, OFF_AF); const bf16_t* AB = wsp<bf16_t>(F, OFF_AB); const bf16_t* GG = wsp<bf16_t>(F, OFF_GG);
    bf16_t* YF = wsp<bf16_t>(F, OFF_YF); const bf16_t* YB = wsp<bf16_t>(F, OFF_YB);
    float ka[8], rk[8], gw_[8], gb_[8];
#pragma unroll
    for (int e = 0; e < 8; ++e) { ka[e] = F.in[I_KA][(size_t)l * 512 + c0 + e]; rk[e] = F.in[I_RK][(size_t)l * 512 + c0 + e]; gw_[e] = F.in[I_GNW][(size_t)l * 512 + c0 + e]; gb_[e] = F.in[I_GNB][(size_t)l * 512 + c0 + e]; }
    for (int ra = r_begin + gw; ra < MROWS; ra += 2 * nw) {
        const bool two = ra + nw < MROWS; u32x4 w[2][8];
#pragma unroll
        for (int q = 0; q < 2; ++q) { const size_t ro = (size_t)(q && two ? ra + nw : ra) * 512 + c0;
            w[q][0] = *(const u32x4*)(YF + ro); w[q][1] = *(const u32x4*)(YB + ro); w[q][2] = *(const u32x4*)(RR + ro); w[q][3] = *(const u32x4*)(RK + ro); w[q][4] = *(const u32x4*)(RV + ro);
            w[q][5] = *(const u32x4*)(AF + ro); w[q][6] = *(const u32x4*)(AB + ro); w[q][7] = *(const u32x4*)(GG + ro); }
#pragma unroll
        for (int q = 0; q < 2; ++q) { if (q && !two) break;
            const size_t ro = (size_t)(q ? ra + nw : ra) * 512 + c0; float yf[8], yb[8], y[8], rr[8], k[8], v[8], af[8], ab[8], g[8];
            unpack8(w[q][0], yf); unpack8(w[q][1], yb); unpack8(w[q][2], rr); unpack8(w[q][3], k); unpack8(w[q][4], v); unpack8(w[q][5], af); unpack8(w[q][6], ab); unpack8(w[q][7], g);
            float s = 0.f;
#pragma unroll
            for (int e = 0; e < 8; ++e) { y[e] = yf[e] + yb[e]; s += y[e]; }
            const float mean = sum8(s) * (1.0f / 64.0f); float qq = 0.f, cf = 0.f;
#pragma unroll
            for (int e = 0; e < 8; ++e) { const float d = y[e] - mean; qq += d * d; const float kmf = k[e] * (1.0f + (af[e] - 1.0f) * ka[e]), kmb = k[e] * (1.0f + (ab[e] - 1.0f) * ka[e]); cf += rr[e] * (kmf + kmb) * rk[e]; }
            const float rstd = rsqrtf(sum8(qq) * (1.0f / 64.0f) + 64e-5f); cf = sum8(cf);
            float o[8];
#pragma unroll
            for (int e = 0; e < 8; ++e) o[e] = ((y[e] - mean) * rstd * gw_[e] + gb_[e] + cf * v[e]) * g[e];
            *(u32x4*)(YF + ro) = pack8(o); }
    }
}

struct RouteRec { int e0, e1; float g0, g1; int s0, s1; int pad0, pad1; };
DI void route_phase(const Frame& F, int l, int r_begin) {
    LAS int* hist = (LAS int*)(F.lds);
    if (F.tid < 32) hist[F.tid] = 0;
    __syncthreads();
    const float* lg = wsp<const float>(F, OFF_LOGITS); RouteRec* rec = wsp<RouteRec>(F, OFF_ROUTE);
    { int* st = wsp<int>(F, OFF_SLOTTOK); for (int i = F.bid * 512 + F.tid; i < PMAX; i += F.G * 512) st[i] = 0; }
    for (int tok = r_begin + F.bid * 512 + F.tid; tok < MROWS; tok += F.G * 512) {
        const float* p = lg + (size_t)tok * 64; const f32x4 g4 = *(const f32x4*)p;
        int grp = 0; float mx = g4[0];
#pragma unroll
        for (int i = 1; i < 4; ++i) if (g4[i] > mx) { mx = g4[i]; grp = i; }
        float den = 0.f;
#pragma unroll
        for (int i = 0; i < 4; ++i) den += __expf(g4[i] - mx);
        const float pg = 1.0f / den;
        const f32x4 ea = *(const f32x4*)(p + 4 + grp * 8), eb = *(const f32x4*)(p + 8 + grp * 8); float le[8] = {ea[0], ea[1], ea[2], ea[3], eb[0], eb[1], eb[2], eb[3]};
        int i1 = 0; float v1 = le[0];
#pragma unroll
        for (int i = 1; i < 8; ++i) if (le[i] > v1) { v1 = le[i]; i1 = i; }
        int i2 = -1; float v2 = -3.0e38f;
#pragma unroll
        for (int i = 0; i < 8; ++i) if (i != i1 && le[i] > v2) { v2 = le[i]; i2 = i; }
        const float ex = __expf(v2 - v1), w1 = 1.0f / (1.0f + ex), w2 = ex * w1;
        RouteRec rc; rc.e0 = grp * 8 + i1; rc.e1 = grp * 8 + i2; rc.g0 = pg * w1; rc.g1 = pg * w2; rc.s0 = 0; rc.s1 = 0; rc.pad0 = 0; rc.pad1 = 0;
        rec[tok] = rc;
        __hip_atomic_fetch_add(&hist[rc.e0], 1, __ATOMIC_RELAXED, __HIP_MEMORY_SCOPE_WORKGROUP); __hip_atomic_fetch_add(&hist[rc.e1], 1, __ATOMIC_RELAXED, __HIP_MEMORY_SCOPE_WORKGROUP);
    }
    __syncthreads();
    if (F.tid < 32 && hist[F.tid]) atomicAdd(wsp<int>(F, OFF_CTL) + CW_CNT + l * 32 + F.tid, hist[F.tid]);
}
DI void build_tab(const Frame& F, int l, LAS int* tab) {
    if (F.tid < 64) { const int* cnt = wsp<int>(F, OFF_CTL) + CW_CNT + l * 32; const int lane = F.tid;
        int v = lane < 32 ? ((__hip_atomic_load(cnt + lane, __ATOMIC_RELAXED, __HIP_MEMORY_SCOPE_AGENT) + 255) >> 8) : 0;
        int inc = v;
#pragma unroll
        for (int sft = 1; sft < 32; sft <<= 1) { const int o = __shfl_up(inc, sft); if (lane >= sft) inc += o; }
        if (lane < 32) tab[lane] = inc - v;
        if (lane == 31) tab[32] = inc; }
    __syncthreads();
}
DI void assign_gather_phase(const Frame& F, int l, int r_begin) {
    LAS int* tab = (LAS int*)(F.lds + MISC_OFF + 64); LAS int* lcnt = tab + 40; LAS int* gbase = lcnt + 32;
    build_tab(F, l, tab);
    if (F.tid < 32) lcnt[F.tid] = 0;
    __syncthreads();
    const int per = (MROWS - r_begin + F.G - 1) / F.G, t0 = r_begin + F.bid * per, t1 = min(MROWS, t0 + per);
    RouteRec* rec = wsp<RouteRec>(F, OFF_ROUTE);
    int e0 = 0, e1 = 0, r0 = 0, r1 = 0; const int tok = t0 + F.tid; const bool act = tok < t1;
    if (act) { e0 = rec[tok].e0; e1 = rec[tok].e1; r0 = __hip_atomic_fetch_add(&lcnt[e0], 1, __ATOMIC_RELAXED, __HIP_MEMORY_SCOPE_WORKGROUP); r1 = __hip_atomic_fetch_add(&lcnt[e1], 1, __ATOMIC_RELAXED, __HIP_MEMORY_SCOPE_WORKGROUP); }
    __syncthreads();
    if (F.tid < 32) { const int n = lcnt[F.tid]; gbase[F.tid] = tab[F.tid] * 256 + (n ? atomicAdd(wsp<int>(F, OFF_CTL) + CW_CUR + l * 32 + F.tid, n) : 0); }
    __syncthreads();
    if (act) { const int s0 = gbase[e0] + r0, s1 = gbase[e1] + r1; rec[tok].s0 = s0; rec[tok].s1 = s1; int* st = wsp<int>(F, OFF_SLOTTOK); st[s0] = tok; st[s1] = tok; }
}
template <bool NEXT>
DI void combine_rows(const Frame& F, int l, int r_begin, const float* gn, bf16_t* xn) {
    const int gw = F.bid * 8 + F.wid, nw = F.G * 8;
    const RouteRec* rec = wsp<RouteRec>(F, OFF_ROUTE); const bf16_t* YB = wsp<bf16_t>(F, OFF_YBUF); float* ctxb = wsp<float>(F, OFF_CTX);
    for (int r = r_begin + gw; r < MROWS; r += nw) {
        const RouteRec rc = rec[r]; const int cond = row_cond(r); const float* gate = modp(F, l, cond, 5);
        float* xr = r < NCTX ? ctxb + (size_t)r * DM : F.out + (size_t)(r - NCTX) * DM;
        f32x4 xv[2][2]; float ss = 0.f;
        u32x4 wy0[2], wy1[2]; f32x4 xa_[2], xb_[2], ga_[2], gb_[2], g4_[2][2], s4_[2][2], c4_[2][2];
        const float* sh = modp(F, l + 1, cond, 0); const float* sc = modp(F, l + 1, cond, 1);
#pragma unroll
        for (int j = 0; j < 2; ++j) { const int c0 = 8 * F.lane + 512 * j;
            wy0[j] = *(const u32x4*)(YB + (size_t)rc.s0 * DM + c0); wy1[j] = *(const u32x4*)(YB + (size_t)rc.s1 * DM + c0);
            xa_[j] = *(const f32x4*)(xr + c0); xb_[j] = *(const f32x4*)(xr + c0 + 4); ga_[j] = *(const f32x4*)(gate + c0); gb_[j] = *(const f32x4*)(gate + c0 + 4);
            if (NEXT) {
#pragma unroll
                for (int q = 0; q < 2; ++q) { g4_[j][q] = *(const f32x4*)(gn + c0 + 4 * q); s4_[j][q] = *(const f32x4*)(sh + c0 + 4 * q); c4_[j][q] = *(const f32x4*)(sc + c0 + 4 * q); } } }
#pragma unroll
        for (int j = 0; j < 2; ++j) { const int c0 = 8 * F.lane + 512 * j; float y0[8], y1[8];
            unpack8(wy0[j], y0); unpack8(wy1[j], y1);
            f32x4 xa = xa_[j], xb = xb_[j]; const f32x4 ga = ga_[j], gb = gb_[j];
#pragma unroll
            for (int e = 0; e < 4; ++e) { xa[e] += ga[e] * (rc.g0 * y0[e] + rc.g1 * y1[e]); xb[e] += gb[e] * (rc.g0 * y0[4 + e] + rc.g1 * y1[4 + e]); }
            *(f32x4*)(xr + c0) = xa; *(f32x4*)(xr + c0 + 4) = xb;
            if (NEXT) { xv[j][0] = xa; xv[j][1] = xb;
#pragma unroll
                for (int e = 0; e < 4; ++e) ss += xa[e] * xa[e] + xb[e] * xb[e]; } }
        if (NEXT) {
            ss = wave_sum(ss); const float inv = rsqrtf(ss * (1.0f / DM) + 1e-6f);
#pragma unroll
            for (int j = 0; j < 2; ++j) { const int c0 = 8 * F.lane + 512 * j; float o[8];
#pragma unroll
                for (int q = 0; q < 2; ++q) { const f32x4 g4 = g4_[j][q], s4 = s4_[j][q], c4 = c4_[j][q];
#pragma unroll
                    for (int e = 0; e < 4; ++e) o[4 * q + e] = (xv[j][q][e] * inv * g4[e]) * (1.0f + c4[e]) + s4[e]; }
                *(u32x4*)(xn + (size_t)r * DM + c0) = pack8(o); }
        }
    }
}

constexpr int PH_PER_LAYER = 19, N_PHASES = 1 + 2 * PH_PER_LAYER;
#if MK_ONE_LAUNCH
#define GRID_BAR() xcd_barrier(bar)
#else
#define GRID_BAR() do { } while (0)
#endif
#ifndef PH_MASK
#define PH_MASK 0xFFFFFFFFu
#endif
#define PON(j) (((PH_MASK) >> (j)) & 1u)
#ifndef REP_MASK
#define REP_MASK 0u
#endif
#define REPEAT(j) for (int rep_ = 0; rep_ < 1 + (int)(((REP_MASK) >> (j)) & 1u); ++rep_)
#define IN(k) (lo <= (k) && (k) < hi)
#define SEAM(k) do { if (IN((k) + 1)) GRID_BAR(); } while (0)
template <int l, class BarT>
DI void layer_phases(const Frame& F0, const int lo, const int hi, const BarT& bar) {
        const Frame& F = F0;
        constexpr bool LAST = (l == EN_LAYERS - 1);
        constexpr int RB = LAST ? NCTX : 0, PM0 = LAST ? 2 : 0;
        const int pb = 1 + l * PH_PER_LAYER;
        const float* xlat = l == 0 ? F.in[I_X] : F.out;
        const float* modl = wsp<const float>(F, OFF_MOD) + (size_t)l * 3 * 6144;
        if (PON(0) && IN(pb + 0)) { const Frame F = phase_frame(F0); REPEAT(0) {  if (l == 0) norm_rows(F, xlat, F.in[I_N1G] + (size_t)l * DM, l, 0, 1, wsp<bf16_t>(F, OFF_XN));  } if (l == 0) SEAM(pb + 0); }
        if (PON(1) && IN(pb + 1)) { const Frame F = phase_frame(F0); REPEAT(1) {  pg8::Gemm g{wsp<bf16_t>(F, OFF_XN), wsp<bf16_t>(F, OFF_WIN), DM, nullptr, nullptr}; pg8::StaticOrder S; S.init(MROWS, N_INP, F.G, F.bid); EpiInproj E{F.ws};
            pg8::gemm_phase(F.lds, g, S, E, F.tid);  } SEAM(pb + 1); }
        if (PON(2) && IN(pb + 2)) { const Frame F = phase_frame(F0); REPEAT(2) {  phaseC_rows(F, l); __syncthreads(); phaseC_vt(F);  } SEAM(pb + 2); }
        if (PON(3) && IN(pb + 3)) { const Frame F = phase_frame(F0); REPEAT(3) {  pg8::Gemm g{wsp<bf16_t>(F, OFF_ALORA), wsp<bf16_t>(F, OFF_WLORA), LORA_K, nullptr, nullptr}; pg8::StaticOrder S; S.init(MROWS, LORA_N, F.G, F.bid);
            EpiLora E{F.ws, F.in[I_DW0] + (size_t)l * 1024, F.in[I_AA0] + (size_t)l * 1024};
            pg8::gemm_phase(F.lds, g, S, E, F.tid);  } SEAM(pb + 3); }
        if (PON(4) && IN(pb + 4)) { const Frame F = phase_frame(F0); REPEAT(4) {  attn_phase(F, l, LAST ? 512 : 520);  } SEAM(pb + 4); }
        if (PON(5) && IN(pb + 5)) { const Frame F = phase_frame(F0); REPEAT(5) {  scan_pass1(F, l);  } SEAM(pb + 5); }
        if (PON(6) && IN(pb + 6)) { const Frame F = phase_frame(F0); REPEAT(6) {  scan_pass2(F);  } SEAM(pb + 6); }
        if (PON(7) && IN(pb + 7)) { const Frame F = phase_frame(F0); REPEAT(7) {  scan_pass3(F, l);  } SEAM(pb + 7); }
        if (PON(8) && IN(pb + 8)) { const Frame F = phase_frame(F0); REPEAT(8) {  rwkv_out_rows(F, l, RB); norm_rows(F, xlat, F.in[I_N1G] + (size_t)l * DM, l, 0, 1, wsp<bf16_t>(F, OFF_XN2), RB);  } SEAM(pb + 8); }
        if (PON(9) && IN(pb + 9)) { const Frame F = phase_frame(F0); REPEAT(9) {  pg8::Gemm g{wsp<bf16_t>(F, OFF_XN2), wsp<bf16_t>(F, OFF_WIN) + (size_t)N_INP * DM, DM, nullptr, nullptr}; pg8::StaticOrder S; S.init(MROWS, N_GATE, F.G, F.bid, PM0); EpiGates E{wsp<bf16_t>(F, OFF_G)};
            pg8::gemm_phase(F.lds, g, S, E, F.tid);  } SEAM(pb + 9); }
        if (PON(10) && IN(pb + 10)) { const Frame F = phase_frame(F0); REPEAT(10) {
            pg8::Gemm g{wsp<bf16_t>(F, OFF_PDIFF), wsp<bf16_t>(F, OFF_WMG), 1536, wsp<bf16_t>(F, OFF_POOL), wsp<bf16_t>(F, OFF_YF)}; pg8::StaticOrder S; S.init(MROWS, DM, F.G, F.bid, PM0);
            EpiMerge E{wsp<bf16_t>(F, OFF_G), wsp<bf16_t>(F, OFF_MERGED)};
            pg8::gemm_phase(F.lds, g, S, E, F.tid); } SEAM(pb + 10); }
        if (PON(11) && IN(pb + 11)) { const Frame F = phase_frame(F0); REPEAT(11) {  pg8::Gemm g{wsp<bf16_t>(F, OFF_MERGED), wsp<bf16_t>(F, OFF_WOUT), DM, nullptr, nullptr}; pg8::StaticOrder S; S.init(MROWS, DM, F.G, F.bid, PM0); EpiResid E{xlat, F.out, wsp<float>(F, OFF_CTX), modl};
            pg8::gemm_phase(F.lds, g, S, E, F.tid);  } SEAM(pb + 11); }
#if EN_MOE
        if (PON(12) && IN(pb + 12)) { const Frame F = phase_frame(F0); REPEAT(12) {  conv_router_weights(F, l); norm_rows(F, F.out, F.in[I_N2G] + (size_t)l * DM, l, 3, 4, wsp<bf16_t>(F, OFF_XN), RB);  } SEAM(pb + 12); }
        if (PON(13) && IN(pb + 13)) { const Frame F = phase_frame(F0); REPEAT(13) {  pg8::Gemm g{wsp<bf16_t>(F, OFF_XN), wsp<bf16_t>(F, OFF_WRT), DM, nullptr, nullptr}; pg8::StaticOrder S; S.init(MROWS, 256, F.G, F.bid, PM0); EpiLogits E{wsp<float>(F, OFF_LOGITS)};
            pg8::gemm_phase(F.lds, g, S, E, F.tid);  } SEAM(pb + 13); }
        if (PON(14) && IN(pb + 14)) { const Frame F = phase_frame(F0); REPEAT(14) {  route_phase(F, l, RB);  } SEAM(pb + 14); }
        if (PON(15) && IN(pb + 15)) { const Frame F = phase_frame(F0); REPEAT(15) {  assign_gather_phase(F, l, RB); __syncthreads(); conv_expert_weights(F, l);  } SEAM(pb + 15); }
        if (PON(16) && IN(pb + 16)) { const Frame F = phase_frame(F0); REPEAT(16) {  LAS int* tab = (LAS int*)(F.lds + MISC_OFF + 64); build_tab(F, l, tab);
            pg8::Gemm g{wsp<bf16_t>(F, OFF_XN), wsp<bf16_t>(F, OFF_WE1), DM, nullptr, nullptr}; pg8::MoeOrder<true> S{tab, 4, F.G, F.bid, wsp<int>(F, OFF_SLOTTOK)}; EpiAct E{wsp<bf16_t>(F, OFF_ACT)};
            pg8::gemm_phase(F.lds, g, S, E, F.tid);  } SEAM(pb + 16); }
        if (PON(17) && IN(pb + 17)) { const Frame F = phase_frame(F0); REPEAT(17) {  LAS int* tab = (LAS int*)(F.lds + MISC_OFF + 64); build_tab(F, l, tab);
            pg8::Gemm g{wsp<bf16_t>(F, OFF_ACT), wsp<bf16_t>(F, OFF_WE2), FF, nullptr, nullptr}; pg8::MoeOrder<false> S{tab, 4, F.G, F.bid, nullptr}; EpiY E{wsp<bf16_t>(F, OFF_YBUF)};
            pg8::gemm_phase(F.lds, g, S, E, F.tid);  } SEAM(pb + 17); }
        if (PON(18) && IN(pb + 18)) { const Frame F = phase_frame(F0); REPEAT(18) {  if constexpr (!LAST) { conv_small_weights(F, l + 1); combine_rows<true>(F, l, RB, F.in[I_N1G] + (size_t)(l + 1) * DM, wsp<bf16_t>(F, OFF_XN)); } else combine_rows<false>(F, l, RB, nullptr, nullptr);  } SEAM(pb + 18); }
#endif
}
__global__ void __launch_bounds__(512, 2) fwd(Args args) {
    extern __shared__ __attribute__((aligned(16))) unsigned char lds_raw[];
    Frame F0; F0.in = (kain_t)__builtin_amdgcn_kernarg_segment_ptr(); F0.out = args.out; F0.ws = args.ws; F0.lds = (LAS unsigned char*)lds_raw;
    F0.tid = threadIdx.x; F0.lane = F0.tid & 63; F0.wid = __builtin_amdgcn_readfirstlane(F0.tid >> 6); F0.G = gridDim.x; F0.bid = blockIdx.x;
    volatile LAS unsigned* MISC = (volatile LAS unsigned*)(F0.lds + MISC_OFF);
    if (F0.tid < 4) MISC[F0.tid] = 0u;
    __syncthreads();
#if MK_ONE_LAUNCH
    const XcdBarrier bar = xcd_barrier_post((unsigned*)(F0.ws + OFF_CTL) + CW_BAR, MISC);
#else
    const int bar = 0;
#endif
    const int lo = args.ph_lo, hi = args.ph_hi;
    if (PON(31) && IN(0)) { const Frame F = phase_frame(F0); p0_prologue(F); SEAM(0); }
    layer_phases<0>(F0, lo, hi, bar);
#if EN_LAYERS > 1
    layer_phases<1>(F0, lo, hi, bar);
#endif
}

extern "C" void kernel_launch(void* const* d_in, const int* in_sizes, int n_in, void* d_out, int out_size, void* d_ws, size_t ws_size, hipStream_t stream) {
    static int grid = 0;
    if (grid == 0) {
        if (n_in != 33 || out_size != NB * SEQ * DM || ws_size < WS_END) { fprintf(stderr, "kernel_launch: unexpected shapes (n_in %d out %d ws %zu need %zu)\n", n_in, out_size, ws_size, (size_t)WS_END); grid = -1; return; }
        int dev = 0, cus = 0, per_cu = 0;
        if (hipGetDevice(&dev) != hipSuccess || hipDeviceGetAttribute(&cus, hipDeviceAttributeMultiprocessorCount, dev) != hipSuccess) { grid = -1; return; }
        if (hipFuncSetAttribute((const void*)fwd, hipFuncAttributeMaxDynamicSharedMemorySize, LDS_BYTES) != hipSuccess) { fprintf(stderr, "kernel_launch: hipFuncSetAttribute failed\n"); grid = -1; return; }
        if (hipOccupancyMaxActiveBlocksPerMultiprocessor(&per_cu, (const void*)fwd, 512, LDS_BYTES) != hipSuccess || per_cu < 1) { fprintf(stderr, "kernel_launch: occupancy query says %d\n", per_cu); }
        (void)hipGetLastError();
        grid = cus;
    }
    if (grid < 0) return;
    (void)hipMemsetAsync((char*)d_ws + OFF_CTL, 0, 65536, stream);
    Args a{};
    for (int i = 0; i < 33; ++i) a.in[i] = (const float*)d_in[i];
    a.out = (float*)d_out; a.ws = (unsigned char*)d_ws;
#if MK_ONE_LAUNCH
    a.ph_lo = 0; a.ph_hi = N_PHASES;
    hipLaunchKernelGGL(fwd, dim3(grid), dim3(512), LDS_BYTES, stream, a);
#else
    for (int p = 0; p < N_PHASES; ++p) {
        if (p >= 1 + EN_LAYERS * PH_PER_LAYER) break;
#if !EN_MOE
        if (p >= 1 && ((p - 1) % PH_PER_LAYER) >= 12) continue;
#endif
        a.ph_lo = p; a.ph_hi = p + 1;
        hipLaunchKernelGGL(fwd, dim3(grid), dim3(512), LDS_BYTES, stream, a);
    }
#endif
}
```

```cpp
#include <hip/hip_runtime.h>
#include <stdint.h>
#include <stdio.h>
#include <stddef.h>
#include <utility>

#ifndef MK_ONE_LAUNCH
#define MK_ONE_LAUNCH 1
#endif
#ifndef EN_MOE
#define EN_MOE 1
#endif
#ifndef EN_LAYERS
#define EN_LAYERS 2
#endif

#define LAS __attribute__((address_space(3)))
#define DI __device__ __forceinline__
typedef unsigned short bf16_t;
typedef short bf16x8 __attribute__((ext_vector_type(8)));
typedef float f32x4 __attribute__((ext_vector_type(4)));
typedef float f32x2 __attribute__((ext_vector_type(2)));
typedef float f32x16 __attribute__((ext_vector_type(16)));
typedef unsigned u32x4 __attribute__((ext_vector_type(4)));
typedef unsigned u32x2 __attribute__((ext_vector_type(2)));
typedef __bf16 bfv2 __attribute__((ext_vector_type(2)));

constexpr int DM = 1024, NB = 2, SEQ = 16384, CTXL = 256, NCTX = NB * CTXL  , MROWS = NCTX + NB * SEQ  ;
constexpr int NPAN = MROWS / 256;
constexpr int IN_W = 7040, N_INP = 4096  , N_GATE = 3072, N_INT = N_INP + N_GATE  ;
constexpr int RW_IN = 1920, LORA_K = 384, LORA_N = 2560;
constexpr int NEXP = 32, FF = 512;
constexpr int PMAX = 74752;
constexpr int KEYS = CTXL + SEQ;
constexpr size_t U_EL = (size_t)MROWS * 512;
constexpr size_t U_B = U_EL * 2;
constexpr size_t OFF_CTL = 0, OFF_MOD = 65536, OFF_CTX = 327680, OFF_WIN = 2424832, OFF_WMG = 17104896, OFF_WOUT = 20250624, OFF_WLORA = 22347776, OFF_WRT = 24313856;
constexpr size_t R1 = 25165824, R2 = R1 + 4 * U_B, R3 = R2 + 5 * U_B, R4 = R3 + 4 * U_B, R6 = R4 + 2 * U_B, RVT = R6 + 2 * U_B, WS_END = RVT + U_B;
constexpr size_t OFF_POOL = R1, OFF_Q = R1 + U_B, OFF_K = R1 + 2 * U_B, OFF_V = R1 + 3 * U_B;
constexpr size_t OFF_RWRAW = R2, OFF_EF = R2, OFF_EB = R2 + U_B, OFF_AF = R2 + 2 * U_B, OFF_AB = R2 + 3 * U_B, OFF_GG = R2 + 4 * U_B;
constexpr size_t OFF_RR = R3, OFF_RK = R3 + U_B, OFF_RV = R3 + 2 * U_B, OFF_RKK = R3 + 3 * U_B;
constexpr size_t OFF_YF = R4, OFF_YB = R4 + U_B;
constexpr size_t OFF_MP = R1 + U_B;
constexpr size_t OFF_NS = R6 + U_B;
constexpr int NCHUNK = KEYS / 64;
constexpr size_t OFF_PDIFF = R6, OFF_ALORA = R6 + U_B, OFF_XN = R6;
constexpr size_t OFF_XN2 = R1 + 2 * U_B;
constexpr size_t OFF_G = R2;
constexpr size_t OFF_MERGED = R3 + U_B;
constexpr size_t OFF_WE1 = R3, OFF_WE2 = R3 + (size_t)NEXP * 1024 * 1024 * 2;
constexpr size_t OFF_XB = R1, OFF_ACT = R1 + (size_t)PMAX * 2048, OFF_YBUF = R1;
constexpr size_t OFF_LOGITS = R4, OFF_ROUTE = R4 + (size_t)MROWS * 64 * 4, OFF_SLOTTOK = OFF_ROUTE + (size_t)MROWS * 32;
constexpr int CW_BAR = 0, CW_CNT = 4096, CW_CUR = 4096 + 64, CW_END = 4096 + 128;
constexpr int LDS_BYTES = 151552, MISC_OFF = 147456;

DI int launder(int x) { asm volatile("" : "+v"(x)); return x; }
DI int lane_id() { return (int)__builtin_amdgcn_mbcnt_hi(~0u, __builtin_amdgcn_mbcnt_lo(~0u, 0u)); }
DI float bf2f(bf16_t v) { return __uint_as_float(((unsigned)v) << 16); }
DI unsigned pk2(float lo, float hi) { f32x2 v = {lo, hi}; bfv2 r = __builtin_convertvector(v, bfv2); return __builtin_bit_cast(unsigned, r); }
DI bf16_t f2bf(float f) { return (bf16_t)(pk2(f, 0.f) & 0xffffu); }
DI float lo_f(unsigned w) { return __uint_as_float(w << 16); }
DI float hi_f(unsigned w) { return __uint_as_float(w & 0xffff0000u); }
DI void unpack8(const u32x4 w, float (&f)[8]) { f[0] = lo_f(w.x); f[1] = hi_f(w.x); f[2] = lo_f(w.y); f[3] = hi_f(w.y); f[4] = lo_f(w.z); f[5] = hi_f(w.z); f[6] = lo_f(w.w); f[7] = hi_f(w.w); }
DI u32x4 pack8(const float (&f)[8]) { u32x4 w; w.x = pk2(f[0], f[1]); w.y = pk2(f[2], f[3]); w.z = pk2(f[4], f[5]); w.w = pk2(f[6], f[7]); return w; }
DI float sigmoidf_(float x) { return __builtin_amdgcn_rcpf(1.0f + __expf(-x)); }
DI float wave_sum(float v) { v += __shfl_xor(v, 1); v += __shfl_xor(v, 2); v += __shfl_xor(v, 4); v += __shfl_xor(v, 8); v += __shfl_xor(v, 16); v += __shfl_xor(v, 32); return v; }
DI float sum8(float v) { v += __shfl_xor(v, 1); v += __shfl_xor(v, 2); v += __shfl_xor(v, 4); return v; }
template <int CTRL> DI float dppf(float v) { return __builtin_bit_cast(float, __builtin_amdgcn_update_dpp(0, __builtin_bit_cast(int, v), CTRL, 0xf, 0xf, true)); }
DI float allsum16(float v) { v += dppf<0xB1>(v); v += dppf<0x4E>(v); v += dppf<0x141>(v); v += dppf<0x140>(v); return v; }

#define XB_TMO      128
#define XB_XCNT(j)  (256  + 64 * (j))
#define XB_XSUB(j)  (1280 + 64 * (j))
#define XB_XGEN(j)  (2304 + 64 * (j))
#define XB_TOP      3328
#define XB_TOPGEN   3392
#define XCD_BAR_WORDS 3456
#define XB_SPIN_CAP (1u << 22)
DI unsigned xb_ld(unsigned* p)              { return __hip_atomic_load(p, __ATOMIC_RELAXED, __HIP_MEMORY_SCOPE_AGENT); }
DI unsigned xb_add(unsigned* p, unsigned v) { return __hip_atomic_fetch_add(p, v, __ATOMIC_RELAXED, __HIP_MEMORY_SCOPE_AGENT); }
DI unsigned xb_xcc_id() { return (unsigned)__builtin_amdgcn_s_getreg((3 << 11) | 20) & 0xFu; }
#define XB_SPIN(cond, bar) do { unsigned _sp = 0; while (cond) { __builtin_amdgcn_s_sleep(1); \
    if ((++_sp & 255u) == 0u) { if (xb_ld(&(bar)[XB_TMO])) break; if (_sp > XB_SPIN_CAP) { atomicAdd(&(bar)[XB_TMO], 1u); break; } } } } while (0)
struct XcdBarrier { unsigned* bar; unsigned x; volatile LAS unsigned* st; bool t0; };
DI XcdBarrier xcd_barrier_post(unsigned* bar, volatile LAS unsigned* st) {
    XcdBarrier b; b.bar = bar; b.x = xb_xcc_id(); b.st = st; b.t0 = threadIdx.x == 0;
    if (b.t0) (void)xb_add(&bar[XB_XCNT(b.x)], 1u);
    return b;
}
DI void xcd_barrier_complete(unsigned* bar, unsigned x, unsigned& nloc, unsigned& nx) {
    const unsigned G = gridDim.x * gridDim.y * gridDim.z;
    unsigned sum, cnt, mine, sp = 0u;
    for (;;) {
        sum = 0u; cnt = 0u; mine = 0u;
#pragma unroll
        for (unsigned j = 0; j < 16; ++j) { const unsigned c = xb_ld(&bar[XB_XCNT(j)]); sum += c; cnt += (c > 0u) ? 1u : 0u; mine = (j == x) ? c : mine; }
        if (sum == G) break;
        __builtin_amdgcn_s_sleep(1);
        if ((++sp & 255u) == 0u) { if (xb_ld(&bar[XB_TMO])) break; if (sp > XB_SPIN_CAP) { atomicAdd(&bar[XB_TMO], 1u); break; } }
    }
    nloc = mine > 0u ? mine : 1u; nx = cnt > 0u ? cnt : 1u;
}
DI void xcd_barrier(const XcdBarrier& b) {
    asm volatile("s_waitcnt vmcnt(0)" ::: "memory");
    __syncthreads();
    if (b.t0) {
        unsigned* bar = b.bar;
        __builtin_amdgcn_s_waitcnt(0);
        unsigned nloc = b.st[0], nx = b.st[1];
        if (nloc == 0u) { xcd_barrier_complete(bar, b.x, nloc, nx); b.st[0] = nloc; b.st[1] = nx; }
        const unsigned old = xb_add(&bar[XB_XSUB(b.x)], 1u);
        const unsigned gen = old / nloc;
        if (old + 1u == (gen + 1u) * nloc) {
            __builtin_amdgcn_fence(__ATOMIC_RELEASE, "agent");
            asm volatile("s_waitcnt vmcnt(0)" ::: "memory");
            const unsigned og = xb_add(&bar[XB_TOP], 1u);
            const unsigned tg = og / nx;
            if (og + 1u == (tg + 1u) * nx) xb_add(&bar[XB_TOPGEN], 1u);
            else XB_SPIN(xb_ld(&bar[XB_TOPGEN]) == tg, bar);
            __builtin_amdgcn_fence(__ATOMIC_ACQUIRE, "agent");
            xb_add(&bar[XB_XGEN(b.x)], 1u);
            asm volatile("s_waitcnt vmcnt(0)" ::: "memory");
        } else {
            XB_SPIN(xb_ld(&bar[XB_XGEN(b.x)]) == gen, bar);
            __builtin_amdgcn_fence(__ATOMIC_ACQUIRE, "agent");
            asm volatile("s_waitcnt vmcnt(0)" ::: "memory");
        }
    }
    __syncthreads();
}

namespace pg8 {
constexpr int BM = 256, BK = 64, HALF = 128, HTB = HALF * BK * 2, STAGE_BYTES = 8 * HTB, NXCD = 8, WGM = 8;
DI int lds_byte(int r, int c) { const int st = (r >> 4) * 2 + (c >> 5), rr = r & 15, cc = c & 31, ob = rr * 64 + cc * 2; return st * 1024 + (ob ^ (((ob >> 9) & 1) << 5)); }
DI void stage_rc(int b, int& R, int& C) { const int st = b / 1024, sb = b % 1024, swz = sb ^ (((sb >> 9) & 1) << 5); R = (st >> 1) * 16 + swz / 64; C = (st & 1) * 32 + (swz % 64) / 2; }
DI int perm32(int rho) { const int n = rho >> 4, i = rho & 15; return 8 * (i >> 2) + 4 * n + (i & 3); }
struct Unit { int pm, pn, pb; };
struct Gemm { const bf16_t* A; const bf16_t* Bt; int K; const bf16_t* A1; const bf16_t* A2; };
struct StaticOrder {
    static constexpr bool GATHER = false;
    int nM, nN, nwg, G, c, pm0;
    DI void init(int M, int N, int G_, int c_, int pm0_ = 0) { pm0 = pm0_; nM = M / BM - pm0_; nN = N / BM; nwg = nM * nN; G = G_; c = c_; }
    DI bool next(int i, Unit& u) const {
        const long L = (long)i * G + c; if (L >= nwg) return false;
        int wgid = (int)L; { const int q = nwg / NXCD, r = nwg % NXCD, xcd = wgid % NXCD, off = wgid / NXCD; wgid = (xcd < r ? xcd * (q + 1) : r * (q + 1) + (xcd - r) * q) + off; }
        const int nig = WGM * nN, gid = wgid / nig, fm = gid * WGM, gsz = (nM - fm) < WGM ? (nM - fm) : WGM;
        u.pm = pm0 + fm + ((wgid % nig) % gsz); u.pn = (wgid % nig) / gsz; u.pb = u.pn; return true;
    }
};
template <bool GATHER_> struct MoeOrder {
    static constexpr bool GATHER = GATHER_;
    const LAS int* tab; int NT, G, c; const int* slot_tok;
    DI bool next(int i, Unit& u) const {
        int L = i * G + c; const int np = tab[32], nwg = np * NT; if (L >= nwg) return false;
        { const int q = nwg / NXCD, r = nwg % NXCD, xcd = L % NXCD, off = L / NXCD; L = (xcd < r ? xcd * (q + 1) : r * (q + 1) + (xcd - r) * q) + off; }
        const int p = L / NT, pn = L % NT; int e = 0;
#pragma unroll 1
        for (int j = 1; j < 32; ++j) e = (tab[j] <= p) ? j : e;
        u.pm = p; u.pn = pn; u.pb = e * NT + pn; return true;
    }
};

template <class Epi, class Sched>
DI void gemm_phase(LAS unsigned char* lds, const Gemm g, const Sched& S, const Epi& E, int tid_) {
    const int tid = launder(tid_), wid = __builtin_amdgcn_readfirstlane(tid >> 6), lane = tid & 63, wr = wid >> 2, wc = wid & 3, fr = lane & 15, fq = lane >> 4;
    const int K = g.K, nt = K / BK, lda = Epi::SEG ? 512 : K;
    unsigned voffA[2], voffB[2];
#pragma unroll
    for (int i = 0; i < 2; ++i) { int R, C; stage_rc(tid * 16 + i * 8192, R, C); const int Rb = Epi::PERM ? ((R & ~31) + perm32(R & 31)) : R;
        voffA[i] = (unsigned)(R * lda + C) * 2u; voffB[i] = (unsigned)(Rb * K + C) * 2u; }
    const size_t kstep = (size_t)(BK * 2);
    const size_t hstep = (size_t)HALF * K * 2;
    const size_t tstep = 2 * hstep;
    const size_t hstepA = (size_t)HALF * lda * 2, tstepA = 2 * hstepA;
    constexpr bool GA = Sched::GATHER;
    unsigned cv[2][2], nv[2][2]; int gR[2], gC[2];
#pragma unroll
    for (int i = 0; i < 2; ++i) { stage_rc(tid * 16 + i * 8192, gR[i], gC[i]); cv[0][i] = cv[1][i] = nv[0][i] = nv[1][i] = 0u; }
#define PG8_GVOFF(v, pm_) do { _Pragma("unroll") for (int h_ = 0; h_ < 2; ++h_) _Pragma("unroll") for (int i_ = 0; i_ < 2; ++i_) \
        (v)[h_][i_] = ((unsigned)S.slot_tok[(pm_) * 256 + h_ * 128 + gR[i_]] * (unsigned)lda + (unsigned)gC[i_]) * 2u; } while (0)
#define PG8_ATILE(ub, t) (Epi::SEG ? (const char*)((t) < 8 ? g.A : ((t) < 16 ? g.A1 : g.A2)) + (ub) + (size_t)((t) & 7) * kstep : (const char*)g.A + (ub) + (size_t)(t) * kstep)
    const unsigned ldsw = (unsigned)wid * 1024u;
    const int aoff = lds_byte(wr * 64 + fr, fq * 8), boff = lds_byte(wc * 32 + fr, fq * 8);
#define PG8_SA(b, h) (((b) * 2 + (h)) * HTB)
#define PG8_SB(b, h) ((4 + (b) * 2 + (h)) * HTB)
#define PG8_STAGE(bufoff, gbase, voff) do { _Pragma("unroll") for (int _i = 0; _i < 2; ++_i) \
        __builtin_amdgcn_global_load_lds((const unsigned*)((const char*)(gbase) + (voff)[_i]), (LAS unsigned*)(lds + (bufoff) + ldsw + _i * 8192), 16, 0, 0); } while (0)
#define PG8_LDA(dst, b, h) do { _Pragma("unroll") for (int m = 0; m < 4; ++m) _Pragma("unroll") for (int k = 0; k < 2; ++k) dst[m][k] = *(const LAS bf16x8*)(lds + PG8_SA(b, h) + aoff + m * 2048 + k * 1024); } while (0)
#define PG8_LDB(dst, b, h) do { _Pragma("unroll") for (int n = 0; n < 2; ++n) _Pragma("unroll") for (int k = 0; k < 2; ++k) dst[n][k] = *(const LAS bf16x8*)(lds + PG8_SB(b, h) + boff + n * 2048 + k * 1024); } while (0)
#define PG8_MMA(ai, bj, At, Bt) do { __builtin_amdgcn_s_setprio(1); _Pragma("unroll") for (int m = 0; m < 4; ++m) _Pragma("unroll") for (int n = 0; n < 2; ++n) _Pragma("unroll") for (int k = 0; k < 2; ++k) \
        acc[ai][bj][m][n] = __builtin_amdgcn_mfma_f32_16x16x32_bf16(Bt[n][k], At[m][k], acc[ai][bj][m][n], 0, 0, 0); __builtin_amdgcn_s_setprio(0); } while (0)
#define PG8_WAIT_V(n) asm volatile("s_waitcnt vmcnt(" #n ")" ::: "memory")
#define PG8_WAIT_L(n) asm volatile("s_waitcnt lgkmcnt(" #n ")" ::: "memory")
#define PG8_BAR __builtin_amdgcn_s_barrier()
#define PG8_SCHED __builtin_amdgcn_sched_barrier(0)
    Unit cur, nxt; int ui = 0;
    if (!S.next(0, cur)) return;
    f32x4 acc[2][2][4][2];
#pragma unroll
    for (int a = 0; a < 2; ++a)
#pragma unroll
        for (int b = 0; b < 2; ++b)
#pragma unroll
            for (int m = 0; m < 4; ++m)
#pragma unroll
                for (int n = 0; n < 2; ++n) acc[a][b][m][n] = (f32x4){0.f, 0.f, 0.f, 0.f};
    bf16x8 At[4][2], B0[2][2], B1[2][2];
    size_t ubA = (size_t)cur.pm * tstepA; const char* cA = PG8_ATILE(ubA, 0); const char* cB = (const char*)g.Bt + (size_t)cur.pb * tstep;
    const char* const gA = (const char*)g.A;
    if constexpr (GA) { PG8_GVOFF(cv, cur.pm); }
    PG8_STAGE(PG8_SB(0, 0), cB, voffB);
    if constexpr (GA) PG8_STAGE(PG8_SA(0, 0), gA, cv[0]); else PG8_STAGE(PG8_SA(0, 0), cA, voffA);
    PG8_STAGE(PG8_SB(0, 1), cB + hstep, voffB);
    if constexpr (GA) PG8_STAGE(PG8_SA(0, 1), gA, cv[1]); else PG8_STAGE(PG8_SA(0, 1), cA + hstepA, voffA);
    if (wr == 1) PG8_BAR;
    PG8_WAIT_V(4); PG8_BAR;
    PG8_STAGE(PG8_SB(1, 0), cB + kstep, voffB);
    if constexpr (GA) PG8_STAGE(PG8_SA(1, 0), gA + kstep, cv[0]); else PG8_STAGE(PG8_SA(1, 0), cA + kstep, voffA);
    PG8_STAGE(PG8_SB(1, 1), cB + hstep + kstep, voffB);
    PG8_WAIT_V(6); PG8_BAR;
    for (;;) {
        const bool has_next = S.next(ui + 1, nxt);
        const size_t nubA = has_next ? (size_t)nxt.pm * tstepA : ubA;
        const char* nA = PG8_ATILE(nubA, 0); const char* nB = has_next ? (const char*)g.Bt + (size_t)nxt.pb * tstep : cB;
        if constexpr (GA) { if (has_next) { PG8_GVOFF(nv, nxt.pm); } else {
#pragma unroll
            for (int h_ = 0; h_ < 2; ++h_) { nv[h_][0] = cv[h_][0]; nv[h_][1] = cv[h_][1]; } } }
        for (int t = 0; t < nt; t += 2) {
            const bool last = (t == nt - 2);
            const char* a1 = PG8_ATILE(ubA, t + 1);
            const char* a2 = last ? nA : PG8_ATILE(ubA, t + 2); const char* b2 = last ? nB : cB + (size_t)(t + 2) * kstep;
            const char* a3 = a2 + kstep; const char* b3 = b2 + kstep;
            const char* gk2 = gA + (last ? (size_t)0 : (size_t)(t + 2) * kstep);
            unsigned s0[2] = {last ? nv[0][0] : cv[0][0], last ? nv[0][1] : cv[0][1]}, s1[2] = {last ? nv[1][0] : cv[1][0], last ? nv[1][1] : cv[1][1]};
            PG8_LDB(B0, 0, 0); PG8_SCHED; PG8_LDA(At, 0, 0);
            if constexpr (GA) PG8_STAGE(PG8_SA(1, 1), gA + (size_t)(t + 1) * kstep, cv[1]); else PG8_STAGE(PG8_SA(1, 1), a1 + hstepA, voffA);
            PG8_WAIT_L(8); PG8_BAR; PG8_WAIT_L(0); PG8_MMA(0, 0, At, B0); PG8_BAR; PG8_SCHED;
            PG8_LDB(B1, 0, 1); PG8_STAGE(PG8_SB(0, 0), b2, voffB);
            PG8_BAR; PG8_WAIT_L(0); PG8_MMA(0, 1, At, B1); PG8_BAR;
            PG8_LDA(At, 0, 1); if constexpr (GA) PG8_STAGE(PG8_SA(0, 0), gk2, s0); else PG8_STAGE(PG8_SA(0, 0), a2, voffA);
            PG8_BAR; PG8_WAIT_L(0); PG8_MMA(1, 0, At, B0); PG8_BAR; PG8_SCHED;
            PG8_STAGE(PG8_SB(0, 1), b2 + hstep, voffB);
            PG8_WAIT_V(6); PG8_BAR; PG8_MMA(1, 1, At, B1); PG8_BAR;
            PG8_LDB(B0, 1, 0); PG8_SCHED; PG8_LDA(At, 1, 0); if constexpr (GA) PG8_STAGE(PG8_SA(0, 1), gk2, s1); else PG8_STAGE(PG8_SA(0, 1), a2 + hstepA, voffA);
            PG8_WAIT_L(8); PG8_BAR; PG8_WAIT_L(0); PG8_MMA(0, 0, At, B0); PG8_BAR; PG8_SCHED;
            PG8_LDB(B1, 1, 1); PG8_STAGE(PG8_SB(1, 0), b3, voffB);
            PG8_BAR; PG8_WAIT_L(0); PG8_MMA(0, 1, At, B1); PG8_BAR;
            PG8_LDA(At, 1, 1); if constexpr (GA) PG8_STAGE(PG8_SA(1, 0), gk2 + kstep, s0); else PG8_STAGE(PG8_SA(1, 0), a3, voffA);
            PG8_BAR; PG8_WAIT_L(0); PG8_MMA(1, 0, At, B0); PG8_BAR; PG8_SCHED;
            PG8_STAGE(PG8_SB(1, 1), b3 + hstep, voffB);
            PG8_WAIT_V(6); PG8_BAR; PG8_MMA(1, 1, At, B1); PG8_BAR;
            if constexpr (Epi::SEG) { if (((t + 2) & 7) == 0 && !last) E.mid(acc, cur, (t + 2) >> 3, wr, wc, fr, fq); }
        }
        E(acc, cur, wr, wc, fr, fq);
        if (!has_next) break;
#pragma unroll
        for (int a = 0; a < 2; ++a)
#pragma unroll
            for (int b = 0; b < 2; ++b)
#pragma unroll
                for (int m = 0; m < 4; ++m)
#pragma unroll
                    for (int n = 0; n < 2; ++n) acc[a][b][m][n] = (f32x4){0.f, 0.f, 0.f, 0.f};
        cur = nxt; cA = nA; cB = nB; ubA = nubA; ++ui;
        if constexpr (GA) {
#pragma unroll
            for (int h_ = 0; h_ < 2; ++h_) { cv[h_][0] = nv[h_][0]; cv[h_][1] = nv[h_][1]; } }
    }
    PG8_WAIT_V(0);
    if (wr == 0) PG8_BAR;
    PG8_BAR;
#undef PG8_ATILE
#undef PG8_GVOFF
#undef PG8_SA
#undef PG8_SB
#undef PG8_STAGE
#undef PG8_LDA
#undef PG8_LDB
#undef PG8_MMA
#undef PG8_WAIT_V
#undef PG8_WAIT_L
#undef PG8_BAR
#undef PG8_SCHED
}
}

struct Args { const float* in[33]; float* out; unsigned char* ws; int ph_lo, ph_hi; };
static_assert(offsetof(Args, out) == 264 && offsetof(Args, ws) == 272, "kernarg layout");
typedef const float* cfptr_t;
typedef __attribute__((address_space(4))) const cfptr_t* kain_t;
typedef __attribute__((address_space(4))) const unsigned char* kab_t;
struct Frame {
    kain_t in; float* out; unsigned char* ws; LAS unsigned char* lds;
    int tid, lane, wid, G, bid;
};
enum { I_X = 0, I_C, I_CTX, I_CCTX, I_WADA, I_BADA, I_N1G, I_N2G, I_WIN, I_POOLW, I_POOLS, I_QNG, I_KNG, I_LAMQK, I_SUBLN, I_SHMU, I_DW0, I_DW2, I_AA0, I_AA2, I_GW2, I_KK, I_KA, I_RK, I_GNW, I_GNB,
       I_WBR, I_WOUT, I_WRG, I_WRE, I_WEG, I_WEU, I_WED };
template <class T> DI T* wsp(const Frame& F, size_t off) { return (T*)(F.ws + off); }
DI const float* xrow_ptr(const Frame& F, const float* xlat, int r) { return r < NCTX ? wsp<const float>(F, OFF_CTX) + (size_t)r * DM : xlat + (size_t)(r - NCTX) * DM; }
DI Frame phase_frame(const Frame& F0) { Frame F = F0; F.lane = launder(lane_id()); F.wid = F0.wid; F.tid = (F.wid << 6) | F.lane;
    kab_t ka = (kab_t)__builtin_amdgcn_kernarg_segment_ptr(); asm volatile("" : "+s"(ka));
    F.in = (kain_t)ka; F.out = *(float* const __attribute__((address_space(4)))*)(ka + 264); F.ws = *(unsigned char* const __attribute__((address_space(4)))*)(ka + 272); return F; }
DI int row_cond(int r) { return r < NCTX ? 2 : (r - NCTX) / SEQ; }
DI const float* modp(const Frame& F, int l, int cond, int j) { return wsp<const float>(F, OFF_MOD) + ((size_t)(l * 3 + cond) * 6 + j) * DM; }

DI void convT_tile(const Frame& F, const float* src, int src_ld, int k0, int n0, bf16_t* dst, int dst_ld, int drow0) {
    LAS float* tile = (LAS float*)F.lds;
    const int t = F.tid;
    { const int k = t >> 3, n8 = (t & 7) * 8; const float* p = src + (size_t)(k0 + k) * src_ld + n0 + n8;
      const f32x4 a = *(const f32x4*)p, b = *(const f32x4*)(p + 4);
      LAS float* q = tile + k * 65 + n8; q[0] = a[0]; q[1] = a[1]; q[2] = a[2]; q[3] = a[3]; q[4] = b[0]; q[5] = b[1]; q[6] = b[2]; q[7] = b[3]; }
    __syncthreads();
    { const int n = t >> 3, k8 = (t & 7) * 8; float f[8];
#pragma unroll
      for (int j = 0; j < 8; ++j) f[j] = tile[(k8 + j) * 65 + n];
      *(u32x4*)(dst + (size_t)(drow0 + n) * dst_ld + k0 + k8) = pack8(f); }
    __syncthreads();
}
DI void convT(const Frame& F, const float* src, int src_ld, int K, int n_lo, int n_hi, bf16_t* dst, int dst_ld, int drow_base, int rot) {
    const int tk = K / 64, tn = (n_hi - n_lo) / 64, ntile = tk * tn;
    for (int t = (F.bid + rot) % F.G; t < ntile; t += F.G) { const int kt = t % tk, nt_ = t / tk; convT_tile(F, src, src_ld, kt * 64, n_lo + nt_ * 64, dst, dst_ld, drow_base + nt_ * 64); }
}

DI void conv_small_weights(const Frame& F, int l) {
    const int gt = F.bid * 512 + F.tid, gn = F.G * 512;
    bf16_t* win = wsp<bf16_t>(F, OFF_WIN);
    const float* w_in = F.in[I_WIN] + (size_t)l * DM * IN_W;
    convT(F, w_in, IN_W, DM, 0, 3968, win, DM, 0, 0);
    convT(F, w_in, IN_W, DM, 3968, IN_W, win, DM, 4096, 64);
    for (int i = gt; i < 128 * DM / 8; i += gn) *(u32x4*)(win + (size_t)3968 * DM + (size_t)i * 8) = (u32x4){0u, 0u, 0u, 0u};
    bf16_t* wmg = wsp<bf16_t>(F, OFF_WMG);
    const float* w_br = F.in[I_WBR] + (size_t)l * 3 * 512 * DM;
    convT(F, w_br + (size_t)1 * 512 * DM, DM, 512, 0, DM, wmg + 512, 1536, 0, 128);
    convT(F, w_br + (size_t)2 * 512 * DM, DM, 512, 0, DM, wmg + 1024, 1536, 0, 192);
    {
        const float* pw = F.in[I_POOLW] + (size_t)l * 4 * 128 * 128; const float* ps = F.in[I_POOLS] + (size_t)l * 512;
        for (int i = gt; i < DM * 64; i += gn) {
            const int n = i & 1023, c8 = i >> 10, k0 = c8 * 8, g = k0 >> 7, c0 = k0 & 127; float acc[8];
#pragma unroll
            for (int j = 0; j < 8; ++j) acc[j] = 0.f;
            for (int d = 0; d < 128; ++d) { const float wb = ps[g * 128 + d] * w_br[(size_t)(g * 128 + d) * DM + n];
#pragma unroll
                for (int j = 0; j < 8; ++j) acc[j] += pw[(size_t)(g * 128 + c0 + j) * 128 + d] * wb; }
            *(u32x4*)(wmg + (size_t)n * 1536 + k0) = pack8(acc);
        }
    }
    convT(F, F.in[I_WOUT] + (size_t)l * DM * DM, DM, DM, 0, DM, wsp<bf16_t>(F, OFF_WOUT), DM, 0, 32);
    {
        bf16_t* wl = wsp<bf16_t>(F, OFF_WLORA);
        const float* dw2 = F.in[I_DW2] + (size_t)l * 2 * 64 * 512; const float* aa2 = F.in[I_AA2] + (size_t)l * 2 * 64 * 512; const float* gw2 = F.in[I_GW2] + (size_t)l * 128 * 512;
        for (int i = gt; i < LORA_N * (LORA_K / 8); i += gn) {
            const int n = i % LORA_N, k0 = (i / LORA_N) * 8, kind = n >> 9, c = n & 511; float f[8];
#pragma unroll
            for (int j = 0; j < 8; ++j) { const int k = k0 + j; float v = 0.f;
                if (kind < 2) { if (k >= kind * 64 && k < kind * 64 + 64) v = dw2[((size_t)kind * 64 + (k - kind * 64)) * 512 + c]; }
                else if (kind < 4) { const int d = kind - 2; if (k >= 128 + d * 64 && k < 192 + d * 64) v = aa2[((size_t)d * 64 + (k - 128 - d * 64)) * 512 + c]; }
                else { if (k >= 256) v = gw2[(size_t)(k - 256) * 512 + c]; }
                f[j] = v; }
            *(u32x4*)(wl + (size_t)n * LORA_K + k0) = pack8(f);
        }
    }
}
DI void conv_expert_weights(const Frame& F, int l) {
    const int gt = F.bid * 512 + F.tid, gn = F.G * 512;
    bf16_t* w1 = wsp<bf16_t>(F, OFF_WE1); bf16_t* w2 = wsp<bf16_t>(F, OFF_WE2);
    const float* wg = F.in[I_WEG] + (size_t)l * NEXP * DM * FF; const float* wu = F.in[I_WEU] + (size_t)l * NEXP * DM * FF; const float* wd = F.in[I_WED] + (size_t)l * NEXP * FF * DM;
    const int tt = F.tid, lk = tt >> 3, l8 = (tt & 7) * 8;
    const int NT = NEXP * 384;
#define EXP_TILE(t_, srcp_, dstp_) do { const int e_ = (t_) / 384, r_ = (t_) % 384; \
        if (r_ < 256) { const int up_ = r_ >> 7, q_ = r_ & 127, kt_ = q_ & 15, nt_ = q_ >> 4, ff0_ = nt_ * 64, drow_ = 256 * (ff0_ >> 7) + 128 * up_ + (ff0_ & 127); \
            srcp_ = (up_ ? wu : wg) + (size_t)e_ * DM * FF + (size_t)(kt_ * 64 + lk) * FF + ff0_ + l8; dstp_ = w1 + (size_t)e_ * 1024 * 1024 + (size_t)(drow_ + lk) * DM + kt_ * 64 + l8; } \
        else { const int q_ = r_ - 256, kt_ = q_ & 7, nt_ = q_ >> 3; \
            srcp_ = wd + (size_t)e_ * FF * DM + (size_t)(kt_ * 64 + lk) * DM + nt_ * 64 + l8; dstp_ = w2 + (size_t)e_ * 1024 * 512 + (size_t)(nt_ * 64 + lk) * FF + kt_ * 64 + l8; } } while (0)
    for (int base = F.bid; base < NT; base += 4 * F.G) {
        f32x4 ra[4], rb[4]; bf16_t* dp[4];
#pragma unroll
        for (int s_ = 0; s_ < 4; ++s_) { const int t = base + s_ * F.G < NT ? base + s_ * F.G : base; const float* sp; EXP_TILE(t, sp, dp[s_]); ra[s_] = *(const f32x4*)sp; rb[s_] = *(const f32x4*)(sp + 4); }
#pragma unroll
        for (int s_ = 0; s_ < 4; ++s_) { LAS float* q = (LAS float*)F.lds + s_ * (64 * 65) + lk * 65 + l8; const f32x4 a = ra[s_], b = rb[s_]; q[0] = a[0]; q[1] = a[1]; q[2] = a[2]; q[3] = a[3]; q[4] = b[0]; q[5] = b[1]; q[6] = b[2]; q[7] = b[3]; }
        __syncthreads();
#pragma unroll
        for (int s_ = 0; s_ < 4; ++s_) { if (base + s_ * F.G >= NT) break; const LAS float* tile = (const LAS float*)F.lds + s_ * (64 * 65); float f[8];
#pragma unroll
            for (int j = 0; j < 8; ++j) f[j] = tile[(l8 + j) * 65 + lk];
            *(u32x4*)dp[s_] = pack8(f); }
        __syncthreads();
    }
#undef EXP_TILE
}
DI void conv_router_weights(const Frame& F, int l) {
    const int gt = F.bid * 512 + F.tid, gn = F.G * 512;
    bf16_t* wr = wsp<bf16_t>(F, OFF_WRT);
    const float* wrg = F.in[I_WRG] + (size_t)l * DM * 4; const float* wre = F.in[I_WRE] + (size_t)l * DM * 32;
    for (int i = gt; i < 256 * (DM / 8); i += gn) { const int n = i & 255, k0 = (i >> 8) * 8; float f[8];
#pragma unroll
        for (int j = 0; j < 8; ++j) f[j] = n < 4 ? wrg[(size_t)(k0 + j) * 4 + n] : (n < 36 ? wre[(size_t)(k0 + j) * 32 + (n - 4)] : 0.f);
        *(u32x4*)(wr + (size_t)n * DM + k0) = pack8(f); }
}
DI void p0_prologue(const Frame& F) {
    LAS float* sl = (LAS float*)F.lds;
    LAS float* red = sl + 3 * DM;
    for (int i = F.tid; i < 3 * DM; i += 512) { const int cond = i >> 10, k = i & 1023; const float v = cond < 2 ? F.in[I_C][cond * DM + k] : F.in[I_CCTX][k]; sl[i] = v * sigmoidf_(v); }
    __syncthreads();
    for (int cg = F.bid; cg < 192; cg += F.G) {
        const int l = cg / 96, col = (cg % 96) * 64 + F.lane;
        const float* W = F.in[I_WADA] + (size_t)l * DM * 6144 + col;
        float s0 = 0.f, s1 = 0.f, s2 = 0.f;
        const int kb = F.wid * 128;
#pragma unroll 8
        for (int k = kb; k < kb + 128; ++k) { const float w = W[(size_t)k * 6144]; s0 += sl[k] * w; s1 += sl[DM + k] * w; s2 += sl[2 * DM + k] * w; }
        red[(F.wid * 3 + 0) * 64 + F.lane] = s0; red[(F.wid * 3 + 1) * 64 + F.lane] = s1; red[(F.wid * 3 + 2) * 64 + F.lane] = s2;
        __syncthreads();
        if (F.tid < 192) { const int cond = F.tid >> 6, ln = F.tid & 63; float s = 0.f;
#pragma unroll
            for (int w = 0; w < 8; ++w) s += red[(w * 3 + cond) * 64 + ln];
            const int n = (cg % 96) * 64 + ln;
            wsp<float>(F, OFF_MOD)[(size_t)(l * 3 + cond) * 6144 + n] = s + F.in[I_BADA][(size_t)l * 6144 + n]; }
        __syncthreads();
    }
    { const int gt = F.bid * 512 + F.tid, gn = F.G * 512; float* cx = wsp<float>(F, OFF_CTX);
      for (int i = gt; i < NCTX * DM / 4; i += gn) ((f32x4*)cx)[i] = ((const f32x4*)F.in[I_CTX])[i]; }
    __syncthreads();
    conv_small_weights(F, 0);
}

DI void norm_rows(const Frame& F, const float* xlat, const float* g, int l, int j_shift, int j_scale, bf16_t* dst, int r_begin = 0) {
    const int gw = F.bid * 8 + F.wid, nw = F.G * 8;
    f32x4 gv[4];
#pragma unroll
    for (int j = 0; j < 4; ++j) gv[j] = *(const f32x4*)(g + 4 * F.lane + 256 * j);
    for (int r0 = r_begin + gw * 4; r0 < MROWS; r0 += nw * 4) {
        f32x4 v[4][4]; float ss[4];
#pragma unroll
        for (int q = 0; q < 4; ++q) { const float* xr = xrow_ptr(F, xlat, r0 + q);
#pragma unroll
            for (int j = 0; j < 4; ++j) v[q][j] = *(const f32x4*)(xr + 4 * F.lane + 256 * j); }
        const int cond = row_cond(r0); const float* sh = modp(F, l, cond, j_shift); const float* sc = modp(F, l, cond, j_scale);
        f32x4 s4v[4], c4v[4];
#pragma unroll
        for (int j = 0; j < 4; ++j) { s4v[j] = *(const f32x4*)(sh + 4 * F.lane + 256 * j); c4v[j] = *(const f32x4*)(sc + 4 * F.lane + 256 * j); }
#pragma unroll
        for (int q = 0; q < 4; ++q) { float a = 0.f;
#pragma unroll
            for (int j = 0; j < 4; ++j) a += v[q][j][0] * v[q][j][0] + v[q][j][1] * v[q][j][1] + v[q][j][2] * v[q][j][2] + v[q][j][3] * v[q][j][3];
            ss[q] = a; }
#pragma unroll
        for (int sft = 1; sft < 64; sft <<= 1) {
#pragma unroll
            for (int q = 0; q < 4; ++q) ss[q] += __shfl_xor(ss[q], sft); }
#pragma unroll
        for (int j = 0; j < 4; ++j) { const f32x4 s4 = s4v[j], c4 = c4v[j];
#pragma unroll
            for (int q = 0; q < 4; ++q) { const float inv = rsqrtf(ss[q] * (1.0f / DM) + 1e-6f); float o[4];
#pragma unroll
                for (int e = 0; e < 4; ++e) o[e] = (v[q][j][e] * inv * gv[j][e]) * (1.0f + c4[e]) + s4[e];
                u32x2 w; w.x = pk2(o[0], o[1]); w.y = pk2(o[2], o[3]);
                *(u32x2*)(dst + (size_t)(r0 + q) * DM + 4 * F.lane + 256 * j) = w; } }
    }
}

struct EpiInproj {
    static constexpr bool PERM = true, SEG = false;
    unsigned char* ws;
    DI void operator()(const f32x4 (&acc)[2][2][4][2], const pg8::Unit& u, int wr, int wc, int fr, int fq) const {
        bf16_t* dst; int ld, colt;
        if (u.pn < 8) { dst = (bf16_t*)(ws + R1) + (size_t)(u.pn >> 1) * U_EL; ld = 512; colt = (u.pn & 1) * 256; } else { dst = (bf16_t*)(ws + OFF_RWRAW); ld = 2048; colt = (u.pn - 8) * 256; }
        const int row0 = u.pm * 256 + wr * 64 + fr, col0 = colt + wc * 32 + 8 * fq;
#pragma unroll
        for (int ai = 0; ai < 2; ++ai)
#pragma unroll
            for (int m = 0; m < 4; ++m) { bf16_t* rowp = dst + (size_t)(row0 + ai * 128 + m * 16) * ld + col0;
#pragma unroll
                for (int bj = 0; bj < 2; ++bj) { const f32x4 v0 = acc[ai][bj][m][0], v1 = acc[ai][bj][m][1]; u32x4 w; w.x = pk2(v0[0], v0[1]); w.y = pk2(v0[2], v0[3]); w.z = pk2(v1[0], v1[1]); w.w = pk2(v1[2], v1[3]);
                    *(u32x4*)(rowp + bj * 128) = w; } }
    }
};
struct EpiLora {
    static constexpr bool PERM = true, SEG = false;
    unsigned char* ws; const float* w0; const float* a0;
    DI void operator()(const f32x4 (&acc)[2][2][4][2], const pg8::Unit& u, int wr, int wc, int fr, int fq) const {
        fr = launder(fr); fq = launder(fq);
        const int kind = u.pn >> 1; bf16_t* dst = (bf16_t*)(ws + R2) + (size_t)kind * U_EL; const int colt = (u.pn & 1) * 256;
        const int row0 = u.pm * 256 + wr * 64 + fr, col0 = colt + wc * 32 + 8 * fq;
        const float* bias = kind < 2 ? w0 + kind * 512 : a0 + ((kind - 2) & 1) * 512;
        const float mul = kind < 2 ? 0.60653065971f : 1.0f;
        if (kind < 4) {
#pragma unroll
            for (int bj = 0; bj < 2; ++bj) { const f32x4 b0 = *(const f32x4*)(bias + col0 + bj * 128), b1 = *(const f32x4*)(bias + col0 + bj * 128 + 4);
#pragma unroll
                for (int ai = 0; ai < 2; ++ai)
#pragma unroll
                    for (int m = 0; m < 4; ++m) { bf16_t* rowp = dst + (size_t)(row0 + ai * 128 + m * 16) * 512 + col0;
                        f32x4 v0 = acc[ai][bj][m][0], v1 = acc[ai][bj][m][1];
#pragma unroll
                        for (int e = 0; e < 4; ++e) { v0[e] = mul * sigmoidf_(v0[e] + b0[e]); v1[e] = mul * sigmoidf_(v1[e] + b1[e]); }
                        u32x4 w; w.x = pk2(v0[0], v0[1]); w.y = pk2(v0[2], v0[3]); w.z = pk2(v1[0], v1[1]); w.w = pk2(v1[2], v1[3]);
                        *(u32x4*)(rowp + bj * 128) = w; }
                asm volatile("" ::: "memory"); }
        } else {
#pragma unroll
            for (int bj = 0; bj < 2; ++bj)
#pragma unroll
                for (int ai = 0; ai < 2; ++ai)
#pragma unroll
                    for (int m = 0; m < 4; ++m) { bf16_t* rowp = dst + (size_t)(row0 + ai * 128 + m * 16) * 512 + col0;
                        const f32x4 v0 = acc[ai][bj][m][0], v1 = acc[ai][bj][m][1];
                        u32x4 w; w.x = pk2(v0[0], v0[1]); w.y = pk2(v0[2], v0[3]); w.z = pk2(v1[0], v1[1]); w.w = pk2(v1[2], v1[3]);
                        *(u32x4*)(rowp + bj * 128) = w; }
        }
    }
};
struct EpiGates {
    static constexpr bool PERM = true, SEG = false;
    bf16_t* G;
    DI void operator()(const f32x4 (&acc)[2][2][4][2], const pg8::Unit& u, int wr, int wc, int fr, int fq) const {
        const int row0 = u.pm * 256 + wr * 64 + fr, col0 = u.pn * 256 + wc * 32 + 8 * fq;
#pragma unroll
        for (int ai = 0; ai < 2; ++ai)
#pragma unroll
            for (int m = 0; m < 4; ++m) { bf16_t* rowp = G + (size_t)(row0 + ai * 128 + m * 16) * N_GATE + col0;
#pragma unroll
                for (int bj = 0; bj < 2; ++bj) { f32x4 v0 = acc[ai][bj][m][0], v1 = acc[ai][bj][m][1];
#pragma unroll
                    for (int e = 0; e < 4; ++e) { v0[e] = sigmoidf_(v0[e]); v1[e] = sigmoidf_(v1[e]); }
                    u32x4 w; w.x = pk2(v0[0], v0[1]); w.y = pk2(v0[2], v0[3]); w.z = pk2(v1[0], v1[1]); w.w = pk2(v1[2], v1[3]);
                    *(u32x4*)(rowp + bj * 128) = w; } }
    }
};
struct EpiMerge {
    static constexpr bool PERM = true, SEG = true;
    const bf16_t* G; bf16_t* mg;
    DI void mid(f32x4 (&acc)[2][2][4][2], const pg8::Unit& u, int seg, int wr, int wc, int fr, int fq) const {
        const int row0 = u.pm * 256 + wr * 64 + fr, col0 = u.pn * 256 + wc * 32 + 8 * fq;
#pragma unroll
        for (int ai = 0; ai < 2; ++ai)
#pragma unroll
            for (int m = 0; m < 4; ++m) { const bf16_t* gp = G + (size_t)(row0 + ai * 128 + m * 16) * N_GATE + (seg - 1) * DM + col0;
#pragma unroll
                for (int bj = 0; bj < 2; ++bj) { float ga[8], gb[8]; unpack8(*(const u32x4*)(gp + bj * 128), ga); unpack8(*(const u32x4*)(gp + DM + bj * 128), gb);
#pragma unroll
                    for (int e = 0; e < 4; ++e) { acc[ai][bj][m][0][e] *= fmaxf(ga[e], 1e-30f) * __builtin_amdgcn_rcpf(fmaxf(gb[e], 1e-30f)); acc[ai][bj][m][1][e] *= fmaxf(ga[4 + e], 1e-30f) * __builtin_amdgcn_rcpf(fmaxf(gb[4 + e], 1e-30f)); } }
                asm volatile("" ::: "memory"); }
    }
    DI void operator()(const f32x4 (&acc)[2][2][4][2], const pg8::Unit& u, int wr, int wc, int fr, int fq) const {
        const int row0 = u.pm * 256 + wr * 64 + fr, col0 = u.pn * 256 + wc * 32 + 8 * fq;
#pragma unroll
        for (int ai = 0; ai < 2; ++ai)
#pragma unroll
            for (int m = 0; m < 4; ++m) { const size_t row = (size_t)(row0 + ai * 128 + m * 16);
#pragma unroll
                for (int bj = 0; bj < 2; ++bj) { const f32x4 v0 = acc[ai][bj][m][0], v1 = acc[ai][bj][m][1];
                    float gv[8], o[8]; unpack8(*(const u32x4*)(G + row * N_GATE + 2 * DM + col0 + bj * 128), gv);
#pragma unroll
                    for (int e = 0; e < 4; ++e) { o[e] = fmaxf(gv[e], 1e-30f) * v0[e]; o[4 + e] = fmaxf(gv[4 + e], 1e-30f) * v1[e]; }
                    *(u32x4*)(mg + row * DM + col0 + bj * 128) = pack8(o); }
                asm volatile("" ::: "memory"); }
    }
};
struct EpiResid {
    static constexpr bool PERM = false, SEG = false;
    const float* xlat_in; float* xlat_out; float* ctxb; const float* modl;
    DI void operator()(const f32x4 (&acc)[2][2][4][2], const pg8::Unit& u, int wr, int wc, int fr, int fq) const {
        const int col0 = u.pn * 256 + wc * 32 + 4 * fq; const bool isctx = u.pm < 2; const int cond = isctx ? 2 : (u.pm - 2) / 64;
        const float* src = isctx ? ctxb + (size_t)u.pm * 256 * DM : xlat_in + (size_t)(u.pm - 2) * 256 * DM;
        float* dst = isctx ? ctxb + (size_t)u.pm * 256 * DM : xlat_out + (size_t)(u.pm - 2) * 256 * DM;
        const float* gate = modl + (size_t)(cond * 6 + 2) * DM + col0;
#pragma unroll
        for (int bj = 0; bj < 2; ++bj)
#pragma unroll
            for (int n = 0; n < 2; ++n) { const f32x4 gv = *(const f32x4*)(gate + bj * 128 + n * 16);
#pragma unroll
                for (int ai = 0; ai < 2; ++ai) { f32x4 xo[4];
#pragma unroll
                    for (int m = 0; m < 4; ++m) xo[m] = *(const f32x4*)(src + (size_t)(wr * 64 + fr + ai * 128 + m * 16) * DM + col0 + bj * 128 + n * 16);
#pragma unroll
                    for (int m = 0; m < 4; ++m) *(f32x4*)(dst + (size_t)(wr * 64 + fr + ai * 128 + m * 16) * DM + col0 + bj * 128 + n * 16) = xo[m] + gv * acc[ai][bj][m][n];
                    asm volatile("" ::: "memory"); } }
    }
};
struct EpiLogits {
    static constexpr bool PERM = false, SEG = false;
    float* lg;
    DI void operator()(const f32x4 (&acc)[2][2][4][2], const pg8::Unit& u, int wr, int wc, int fr, int fq) const {
        if (wc >= 2) return;
        const int row0 = u.pm * 256 + wr * 64 + fr, col0 = wc * 32 + 4 * fq;
#pragma unroll
        for (int ai = 0; ai < 2; ++ai)
#pragma unroll
            for (int m = 0; m < 4; ++m)
#pragma unroll
                for (int n = 0; n < 2; ++n) *(f32x4*)(lg + (size_t)(row0 + ai * 128 + m * 16) * 64 + col0 + n * 16) = acc[ai][0][m][n];
    }
};
struct EpiAct {
    static constexpr bool PERM = true, SEG = false;
    bf16_t* act;
    DI void operator()(const f32x4 (&acc)[2][2][4][2], const pg8::Unit& u, int wr, int wc, int fr, int fq) const {
        const int row0 = u.pm * 256 + wr * 64 + fr, col0 = u.pn * 128 + wc * 32 + 8 * fq;
#pragma unroll
        for (int ai = 0; ai < 2; ++ai)
#pragma unroll
            for (int m = 0; m < 4; ++m) { float o[8];
#pragma unroll
                for (int n = 0; n < 2; ++n)
#pragma unroll
                    for (int e = 0; e < 4; ++e) { const float gt = acc[ai][0][m][n][e], up = acc[ai][1][m][n][e]; o[4 * n + e] = gt * sigmoidf_(gt) * up; }
                *(u32x4*)(act + (size_t)(row0 + ai * 128 + m * 16) * FF + col0) = pack8(o); }
    }
};
struct EpiY {
    static constexpr bool PERM = true, SEG = false;
    bf16_t* y;
    DI void operator()(const f32x4 (&acc)[2][2][4][2], const pg8::Unit& u, int wr, int wc, int fr, int fq) const {
        const int row0 = u.pm * 256 + wr * 64 + fr, col0 = u.pn * 256 + wc * 32 + 8 * fq;
#pragma unroll
        for (int ai = 0; ai < 2; ++ai)
#pragma unroll
            for (int m = 0; m < 4; ++m) { bf16_t* rowp = y + (size_t)(row0 + ai * 128 + m * 16) * DM + col0;
#pragma unroll
                for (int bj = 0; bj < 2; ++bj) { const f32x4 v0 = acc[ai][bj][m][0], v1 = acc[ai][bj][m][1]; u32x4 w; w.x = pk2(v0[0], v0[1]); w.y = pk2(v0[2], v0[3]); w.z = pk2(v1[0], v1[1]); w.w = pk2(v1[2], v1[3]);
                    *(u32x4*)(rowp + bj * 128) = w; } }
    }
};

DI void seq_of_row(int r, int& t, int& len) { if (r < NCTX) { t = r & 255; len = CTXL; } else { t = (r - NCTX) & (SEQ - 1); len = SEQ; } }

DI void phaseC_rows(const Frame& F, int l) {
    const int gw = F.bid * 8 + F.wid, nw = F.G * 8, lane = F.lane;
    bf16_t* Q = wsp<bf16_t>(F, OFF_Q); bf16_t* Kp = wsp<bf16_t>(F, OFF_K);
    const bf16_t* POOL = wsp<bf16_t>(F, OFF_POOL); bf16_t* PD = wsp<bf16_t>(F, OFF_PDIFF);
    const bf16_t* RW = wsp<bf16_t>(F, OFF_RWRAW); bf16_t* AL = wsp<bf16_t>(F, OFF_ALORA);
    bf16_t* RR = wsp<bf16_t>(F, OFF_RR); bf16_t* RK = wsp<bf16_t>(F, OFF_RK); bf16_t* RV = wsp<bf16_t>(F, OFF_RV); bf16_t* RKK = wsp<bf16_t>(F, OFF_RKK);
    const int i8 = lane & 7, axis = i8 >> 2, sec = (i8 >> 1) & 1, fb = (i8 & 1) * 8;
    float qg[8], kg[8];
#pragma unroll
    for (int e = 0; e < 8; ++e) { qg[e] = F.in[I_QNG][l * 64 + i8 * 8 + e]; kg[e] = F.in[I_KNG][l * 64 + i8 * 8 + e]; }
    LAS float* mul_ = (LAS float*)(F.lds + 32768);
    { const float* mu = F.in[I_SHMU] + (size_t)l * 2 * RW_IN; const float* kkw = F.in[I_KK] + (size_t)l * 512;
      for (int i = F.tid; i < 2 * RW_IN + 512; i += 512) mul_[i] = i < 2 * RW_IN ? mu[i] : kkw[i - 2 * RW_IN]; }
    __syncthreads();
    const float QSCALE = 0.125f * 1.4426950408889634f;
    for (int r = gw; r < MROWS; r += nw) {
        int t, len; seq_of_row(r, t, len);
        const int half = 1 << (lane >> 4); const int lo = max(t - half, 0), hi = min(t + half - 1, len - 1);
        const bool hp = t > 0, hn = t < len - 1; const bf16_t* cur = RW + (size_t)r * 2048;
        u32x4 wq, wk, wself, xw[16], rc[4], rp[4], rn[4];
        __builtin_amdgcn_sched_barrier(0);
        wq = *(const u32x4*)(Q + (size_t)r * 512 + 8 * lane); wk = *(const u32x4*)(Kp + (size_t)r * 512 + 8 * lane);
        wself = *(const u32x4*)(POOL + (size_t)r * 512 + 8 * lane);
#pragma unroll
        for (int j = 0; j < 16; ++j) { const int tt = t - 8 + j; const bool ok = tt >= lo && tt <= hi; xw[j] = *(const u32x4*)(POOL + (size_t)(ok ? r + (tt - t) : r) * 512 + 8 * lane); }
#pragma unroll
        for (int ch = 0; ch < 4; ++ch) { const int c0 = ch * 512 + 8 * (ch == 3 ? min(lane, 47) : lane);
            rc[ch] = *(const u32x4*)(cur + c0); rp[ch] = *(const u32x4*)(cur - (hp ? 2048 : 0) + c0); rn[ch] = *(const u32x4*)(cur + (hn ? 2048 : 0) + c0); }
        __builtin_amdgcn_sched_barrier(0);
        float cs[8], sn[8];
        if (r >= NCTX) { const float pos = (float)(axis ? (t & 63) : (t >> 6));
#pragma unroll
            for (int e = 0; e < 8; ++e) { const float invf = __builtin_amdgcn_exp2f(-(float)(fb + e) * 0.83048202372184059f); const float rev = (pos * invf) * 0.15915494309189535f;
                cs[e] = __builtin_amdgcn_cosf(rev); sn[e] = __builtin_amdgcn_sinf(rev); }
        } else {
#pragma unroll
            for (int e = 0; e < 8; ++e) { cs[e] = 1.f; sn[e] = 0.f; } }
#pragma unroll
        for (int which = 0; which < 2; ++which) {
            bf16_t* p = (which ? Kp : Q) + (size_t)r * 512 + 8 * lane; float x[8]; unpack8(which ? wk : wq, x);
            float ss = 0.f;
#pragma unroll
            for (int e = 0; e < 8; ++e) ss += x[e] * x[e];
            ss = sum8(ss); const float rinv = rsqrtf(ss * (1.0f / 64.0f) + 1e-6f);
            float o[8];
#pragma unroll
            for (int e = 0; e < 8; ++e) { const float y = x[e] * rinv * (which ? kg[e] : qg[e]); const float yp = __shfl_xor(y, 2);
                o[e] = y * cs[e] + (sec ? yp : -yp) * sn[e]; if (!which) o[e] *= QSCALE; }
            *(u32x4*)p = pack8(o);
        }
        {
            float s[8], self[8];
#pragma unroll
            for (int e = 0; e < 8; ++e) s[e] = 0.f;
            unpack8(wself, self);
#pragma unroll
            for (int j = 0; j < 16; ++j) { const int tt = t - 8 + j; const float mk = (tt >= lo && tt <= hi) ? 1.0f : 0.0f; float x[8]; unpack8(xw[j], x);
#pragma unroll
                for (int e = 0; e < 8; ++e) s[e] += mk * x[e]; }
            const float ic = 1.0f / (float)(hi - lo + 1); float o[8];
#pragma unroll
            for (int e = 0; e < 8; ++e) o[e] = s[e] * ic - self[e];
            *(u32x4*)(PD + (size_t)r * 512 + 8 * lane) = pack8(o);
        }
        {
#pragma unroll
            for (int ch = 0; ch < 4; ++ch) {
                if (ch == 3 && lane >= 48) break;
                const int c0 = ch * 512 + 8 * lane; float x[8], xp[8], xn[8], u[8];
                unpack8(rc[ch], x); unpack8(rp[ch], xp); unpack8(rn[ch], xn);
                if (!hp) {
#pragma unroll
                    for (int e = 0; e < 8; ++e) xp[e] = 0.f; }
                if (!hn) {
#pragma unroll
                    for (int e = 0; e < 8; ++e) xn[e] = 0.f; }
                const f32x4 m0a = *(const LAS f32x4*)(mul_ + c0), m0b = *(const LAS f32x4*)(mul_ + c0 + 4), m1a = *(const LAS f32x4*)(mul_ + RW_IN + c0), m1b = *(const LAS f32x4*)(mul_ + RW_IN + c0 + 4);
#pragma unroll
                for (int e = 0; e < 8; ++e) { const float m0 = e < 4 ? m0a[e & 3] : m0b[e & 3], m1 = e < 4 ? m1a[e & 3] : m1b[e & 3]; u[e] = x[e] + (xp[e] - x[e]) * m0 + (xn[e] - x[e]) * m1; }
                if (ch == 0) *(u32x4*)(RR + (size_t)r * 512 + 8 * lane) = pack8(u);
                else if (ch == 2) *(u32x4*)(RV + (size_t)r * 512 + 8 * lane) = pack8(u);
                else if (ch == 1) {
                    *(u32x4*)(RK + (size_t)r * 512 + 8 * lane) = pack8(u);
                    const f32x4 kka = *(const LAS f32x4*)(mul_ + 2 * RW_IN + 8 * lane), kkb = *(const LAS f32x4*)(mul_ + 2 * RW_IN + 8 * lane + 4); float kk[8], ss = 0.f;
#pragma unroll
                    for (int e = 0; e < 8; ++e) { kk[e] = u[e] * (e < 4 ? kka[e & 3] : kkb[e & 3]); ss += kk[e] * kk[e]; }
                    ss = sum8(ss); const float inv = 1.0f / fmaxf(sqrtf(ss), 1e-12f);
#pragma unroll
                    for (int e = 0; e < 8; ++e) kk[e] *= inv;
                    *(u32x4*)(RKK + (size_t)r * 512 + 8 * lane) = pack8(kk);
                } else {
                    float o[8];
#pragma unroll
                    for (int e = 0; e < 8; ++e) { if (lane < 16) { const float ex = __expf(2.0f * u[e]); o[e] = 1.0f - 2.0f * __builtin_amdgcn_rcpf(ex + 1.0f); } else if (lane < 32) o[e] = u[e]; else o[e] = sigmoidf_(u[e]); }
                    *(u32x4*)(AL + (size_t)r * LORA_K + 8 * lane) = pack8(o);
                }
            }
        }
    }
}
DI void phaseC_vt(const Frame& F) {
    const bf16_t* V = wsp<bf16_t>(F, OFF_V); bf16_t* VT = wsp<bf16_t>(F, RVT);
    LAS bf16_t* T = (LAS bf16_t*)F.lds;
    for (int task = F.bid; task < NB * 4 * (KEYS / 64); task += F.G) {
        const int kb = task % (KEYS / 64), bh = task / (KEYS / 64), b = bh >> 2, h = bh & 3;
        const int row0 = kb < 4 ? b * CTXL + kb * 64 : NCTX + b * SEQ + (kb - 4) * 64;
#pragma unroll
        for (int i = 0; i < 2; ++i) { const int ci = F.tid + 512 * i, j = ci >> 4, c = ci & 15;
            const u32x4 w = *(const u32x4*)(V + (size_t)(row0 + j) * 512 + h * 128 + c * 8);
            LAS unsigned* q = (LAS unsigned*)(T + j * 136 + c * 8); q[0] = w.x; q[1] = w.y; q[2] = w.z; q[3] = w.w; }
        __syncthreads();
#pragma unroll
        for (int i = 0; i < 2; ++i) { const int ci = F.tid + 512 * i, vd = ci >> 3, p8 = ci & 7; unsigned w[4];
#pragma unroll
            for (int e2 = 0; e2 < 4; ++e2) { unsigned pr = 0;
#pragma unroll
                for (int q = 0; q < 2; ++q) { const int p = p8 * 8 + e2 * 2 + q, gq = p >> 4, pp = p & 15, hh = pp >> 3, ee = pp & 7, ko = 8 * (ee >> 2) + 4 * hh + (ee & 3);
                    pr |= ((unsigned)T[(gq * 16 + ko) * 136 + vd]) << (16 * q); }
                w[e2] = pr; }
            *(u32x4*)(VT + ((size_t)bh * 128 + vd) * KEYS + kb * 64 + p8 * 8) = (u32x4){w[0], w[1], w[2], w[3]}; }
        __syncthreads();
    }
}

#define MFMA32(a, b, c) __builtin_amdgcn_mfma_f32_32x32x16_bf16((a), (b), (c), 0, 0, 0)
constexpr int ATT_KB = 16384, ATT_STG = 32768;
DI void attn_phase(const Frame& F, int l, int nunits) {
    const int tid = F.tid, wid = F.wid, lane = F.lane, l32 = lane & 31, hh = lane >> 5, g = wid >> 1, m = wid & 1;
    const bf16_t* Q = wsp<bf16_t>(F, OFF_Q); const bf16_t* Kg = wsp<bf16_t>(F, OFF_K); const bf16_t* VT = wsp<bf16_t>(F, RVT); bf16_t* ATT = wsp<bf16_t>(F, OFF_POOL);
    const float* lq = F.in[I_LAMQK] + (size_t)l * 256;
    float d0 = lq[lane] * lq[64 + lane], d1 = lq[128 + lane] * lq[192 + lane]; d0 = wave_sum(d0); d1 = wave_sum(d1);
    const float lam_init = 0.8f - 0.6f * expf(-0.3f * (float)l);
    const float lam = expf(d0) - expf(d1) + lam_init, lamfac = 1.0f - lam_init;
    const float* sg = F.in[I_SUBLN] + (size_t)l * 128;
    LAS float* xch = (LAS float*)F.lds;
    LAS float* sgl = (LAS float*)(F.lds + MISC_OFF + 2048);
    if (wid < 2) sgl[wid * 64 + lane] = sg[wid * 64 + lane];
    (void)tid;
    for (int u = F.bid; u < nunits; u += F.G) {
        int b, h, qrow0, nkt;
        if (u < 512) { const int bh = u & 7, qt = ((u >> 3) & 31) + 32 * (u >> 8); b = bh >> 2; h = bh & 3; qrow0 = NCTX + b * SEQ + qt * 256; nkt = KEYS / 64; } else { const int uu = u - 512; b = uu >> 2; h = uu & 3; qrow0 = b * CTXL; nkt = 4; }
        bf16x8 qf[2][4];
#pragma unroll
        for (int qs = 0; qs < 2; ++qs) { const bf16_t* qp = Q + (size_t)(qrow0 + g * 64 + qs * 32 + l32) * 512 + h * 128 + m * 64 + hh * 8;
#pragma unroll
            for (int ks = 0; ks < 4; ++ks) qf[qs][ks] = *(const bf16x8*)(qp + ks * 16); }
        f32x16 o[2][4];
#pragma unroll
        for (int qs = 0; qs < 2; ++qs)
#pragma unroll
            for (int vt = 0; vt < 4; ++vt)
#pragma unroll
                for (int i = 0; i < 16; ++i) o[qs][vt][i] = 0.f;
        float lsum[2] = {0.f, 0.f};
        const bf16_t* vtb = VT + (size_t)(b * 4 + h) * 128 * KEYS;
#define KROW0(kt) ((kt) < 4 ? b * CTXL + (kt) * 64 : NCTX + b * SEQ + ((kt) - 4) * 64)
#define ISSUE_TILE(kt, buf) do { const int ln_ = launder(lane); const int kr0_ = KROW0(kt); _Pragma("unroll") for (int q_ = 0; q_ < 2; ++q_) { const int j_ = 2 * wid + q_; \
            { const int row_ = 4 * j_ + (ln_ >> 4), c_ = (ln_ & 15) ^ (row_ & 15); \
              __builtin_amdgcn_global_load_lds((const unsigned*)(Kg + (size_t)(kr0_ + row_) * 512 + h * 128 + c_ * 8), (LAS unsigned*)(F.lds + (buf) * ATT_STG + j_ * 1024), 16, 0, 0); } \
            { const int row_ = 8 * j_ + (ln_ >> 3), c_ = (ln_ & 7) ^ ((row_ >> 1) & 7); \
              __builtin_amdgcn_global_load_lds((const unsigned*)(vtb + (size_t)row_ * KEYS + (kt) * 64 + c_ * 8), (LAS unsigned*)(F.lds + (buf) * ATT_STG + ATT_KB + j_ * 1024), 16, 0, 0); } } } while (0)
        __syncthreads();
        ISSUE_TILE(0, 0);
        for (int kt = 0; kt < nkt; ++kt) {
            const int buf = kt & 1;
            asm volatile("s_waitcnt vmcnt(0)" ::: "memory");
            __syncthreads();
            const int ln = launder(lane); const int l32b = ln & 31, hb = ln >> 5;
            const LAS unsigned char* Kb = F.lds + buf * ATT_STG + l32b * 256; const int kx = l32b & 15;
            const LAS unsigned char* Vb = F.lds + buf * ATT_STG + ATT_KB + l32b * 128; const int vx = (l32b >> 1) & 7;
#define KFRAG(kk_, ks_) (*(const LAS bf16x8*)(Kb + (kk_) * 8192 + (((m * 8 + (ks_) * 2 + hb) ^ kx) << 4)))
#define VFRAG(kk_, i_) (*(const LAS bf16x8*)(Vb + ((i_) >> 1) * 4096 + ((((kk_) * 4 + ((i_) & 1) * 2 + hb) ^ vx) << 4)))
#define SBA_ __builtin_amdgcn_sched_barrier(0)
            bf16x8 kf[4];
#pragma unroll
            for (int ks = 0; ks < 4; ++ks) kf[ks] = KFRAG(0, ks);
            SBA_;
            if (kt + 1 < nkt) ISSUE_TILE(kt + 1, buf ^ 1);
            SBA_;
#pragma unroll
            for (int kk = 0; kk < 2; ++kk) {
                f32x16 sv[2];
#pragma unroll
                for (int qs = 0; qs < 2; ++qs)
#pragma unroll
                    for (int i = 0; i < 16; ++i) sv[qs][i] = 0.f;
#pragma unroll
                for (int ks = 0; ks < 4; ++ks) { sv[0] = MFMA32(kf[ks], qf[0][ks], sv[0]); sv[1] = MFMA32(kf[ks], qf[1][ks], sv[1]); }
                SBA_;
                bf16x8 vfr[3]; vfr[0] = VFRAG(kk, 0); vfr[1] = VFRAG(kk, 1);
                if (kk == 0) {
#pragma unroll
                    for (int ks = 0; ks < 4; ++ks) kf[ks] = KFRAG(1, ks); }
                SBA_;
                bf16x8 pb[2][2];
#pragma unroll
                for (int qs = 0; qs < 2; ++qs)
#pragma unroll
                    for (int jp = 0; jp < 2; ++jp) { u32x4 w; float p[8];
#pragma unroll
                        for (int e = 0; e < 8; ++e) { p[e] = __builtin_amdgcn_exp2f(sv[qs][8 * jp + e]); lsum[qs] += p[e]; }
                        w.x = pk2(p[0], p[1]); w.y = pk2(p[2], p[3]); w.z = pk2(p[4], p[5]); w.w = pk2(p[6], p[7]); pb[qs][jp] = __builtin_bit_cast(bf16x8, w); }
                SBA_;
#pragma unroll
                for (int i = 0; i < 8; ++i) { const int vt = i >> 1, jp = i & 1;
                    if (i + 2 < 8) vfr[(i + 2) % 3] = VFRAG(kk, i + 2);
                    SBA_;
                    o[0][vt] = MFMA32(vfr[i % 3], pb[0][jp], o[0][vt]); o[1][vt] = MFMA32(vfr[i % 3], pb[1][jp], o[1][vt]);
                    SBA_; }
            }
#undef KFRAG
#undef VFRAG
#undef SBA_
        }
#undef ISSUE_TILE
#undef KROW0
        __syncthreads();
        float cm[2];
#pragma unroll
        for (int qs = 0; qs < 2; ++qs) { const float lt = lsum[qs] + __shfl_xor(lsum[qs], 32); cm[qs] = m ? lam / lt : 1.0f / lt; }
        if (m) {
#pragma unroll
            for (int qs = 0; qs < 2; ++qs)
#pragma unroll
                for (int vt = 0; vt < 4; ++vt)
#pragma unroll
                    for (int i = 0; i < 16; ++i) xch[((g * 2 + qs) * 64 + vt * 16 + i) * 64 + lane] = o[qs][vt][i] * cm[qs];
        }
        __syncthreads();
        if (!m) {
#pragma unroll
            for (int qs = 0; qs < 2; ++qs) {
                float ss = 0.f;
#pragma unroll
                for (int vt = 0; vt < 4; ++vt)
#pragma unroll
                    for (int i = 0; i < 16; ++i) { const float v = o[qs][vt][i] * cm[qs] - xch[((g * 2 + qs) * 64 + vt * 16 + i) * 64 + lane]; o[qs][vt][i] = v; ss += v * v; }
                ss += __shfl_xor(ss, 32);
                const float rn = rsqrtf(ss * (1.0f / 128.0f) + 1e-6f) * lamfac;
                bf16_t* op = ATT + (size_t)(qrow0 + g * 64 + qs * 32 + l32) * 512 + h * 128;
#pragma unroll
                for (int vt = 0; vt < 4; ++vt)
#pragma unroll
                    for (int q4 = 0; q4 < 4; ++q4) { const int vd = vt * 32 + q4 * 8 + hh * 4; const f32x4 g4 = *(const LAS f32x4*)(sgl + vd);
                        u32x2 w; w.x = pk2(o[qs][vt][4 * q4] * rn * g4[0], o[qs][vt][4 * q4 + 1] * rn * g4[1]); w.y = pk2(o[qs][vt][4 * q4 + 2] * rn * g4[2], o[qs][vt][4 * q4 + 3] * rn * g4[3]);
                        *(u32x2*)(op + vd) = w; }
            }
        }
    }
}

DI int crow_(int reg, int h) { return (reg & 3) + 8 * (reg >> 2) + 4 * h; }
DI int swz(int row, int chunk) { return row * 128 + ((chunk ^ ((row >> 1) & 7)) << 4); }
constexpr int SL_A = 0, SL_B = 8192, SL_K = 16384, SL_V = 24576, SL_T = 32768, SL_R = 40960, WAVE_LDS = 49152;
typedef LAS unsigned char* lds_t;
DI bf16x8 fragN(lds_t base, int row, int k0, int h) { return *(const LAS bf16x8*)(base + swz(row, (k0 >> 3) + h)); }
DI bf16x8 fragK(lds_t base, int row, int kt, int s, int h) { const int c0 = 4 * kt + 2 * s; const u32x2 a = *(const LAS u32x2*)(base + swz(row, c0) + 8 * h), b = *(const LAS u32x2*)(base + swz(row, c0 + 1) + 8 * h);
    return __builtin_bit_cast(bf16x8, (u32x4){a.x, a.y, b.x, b.y}); }
DI void zero_acc(f32x16 (&acc)[2][2]) {
#pragma unroll
    for (int a = 0; a < 2; ++a)
#pragma unroll
        for (int b = 0; b < 2; ++b)
#pragma unroll
            for (int i = 0; i < 16; ++i) acc[a][b][i] = 0.f; }
DI void mm_nn(f32x16 (&acc)[2][2], lds_t A, lds_t B, int l32, int h) {
    l32 = launder(l32); h = launder(h);
    bf16x8 af[4][2], bf[4][2];
#pragma unroll
    for (int ks = 0; ks < 4; ++ks)
#pragma unroll
        for (int q = 0; q < 2; ++q) { af[ks][q] = fragN(A, 32 * q + l32, 16 * ks, h); bf[ks][q] = fragN(B, 32 * q + l32, 16 * ks, h); }
#pragma unroll
    for (int ks = 0; ks < 4; ++ks)
#pragma unroll
        for (int ra = 0; ra < 2; ++ra)
#pragma unroll
            for (int cb = 0; cb < 2; ++cb) if (!(ra == 1 && cb == 0)) acc[ra][cb] = MFMA32(af[ks][ra], bf[ks][cb], acc[ra][cb]);
}
DI void mm_nn_lp(f32x16 (&acc)[2][2], lds_t A, lds_t B, int l32, int h) {
    l32 = launder(l32); h = launder(h);
#pragma unroll
    for (int kp = 0; kp < 2; ++kp) { bf16x8 af[2][2], bf[2][2];
#pragma unroll
        for (int ks = 0; ks < 2; ++ks)
#pragma unroll
            for (int q = 0; q < 2; ++q) { af[ks][q] = fragN(A, 32 * q + l32, 16 * (2 * kp + ks), h); bf[ks][q] = fragN(B, 32 * q + l32, 16 * (2 * kp + ks), h); }
#pragma unroll
        for (int ks = 0; ks < 2; ++ks)
#pragma unroll
            for (int ra = 0; ra < 2; ++ra)
#pragma unroll
                for (int cb = 0; cb < 2; ++cb) acc[ra][cb] = MFMA32(af[ks][ra], bf[ks][cb], acc[ra][cb]); }
}
DI void mm_xt(f32x16 (&acc)[2][2], const bf16x8 (&xf)[2][2][2], lds_t Y, int l32, int h) {
    l32 = launder(l32); h = launder(h);
#pragma unroll
    for (int it = 0; it < 2; ++it)
#pragma unroll
        for (int s = 0; s < 2; ++s) { bf16x8 yf[2];
#pragma unroll
            for (int vt = 0; vt < 2; ++vt) yf[vt] = fragK(Y, 32 * vt + l32, it, s, h);
#pragma unroll
            for (int tt = 0; tt < 2; ++tt)
#pragma unroll
                for (int vt = 0; vt < 2; ++vt) if (!(it == 1 && tt == 0)) acc[vt][tt] = MFMA32(yf[vt], xf[it][tt][s], acc[vt][tt]); }
}
DI void mm_st(f32x16 (&acc)[2][2], lds_t A, const bf16x8 (&sf)[2][2][2], int l32, int h) {
    l32 = launder(l32); h = launder(h);
#pragma unroll
    for (int ct = 0; ct < 2; ++ct)
#pragma unroll
        for (int s = 0; s < 2; ++s) { bf16x8 af[2];
#pragma unroll
            for (int tt = 0; tt < 2; ++tt) af[tt] = fragK(A, 32 * tt + l32, ct, s, h);
#pragma unroll
            for (int tt = 0; tt < 2; ++tt)
#pragma unroll
                for (int vt = 0; vt < 2; ++vt) acc[vt][tt] = MFMA32(sf[ct][vt][s], af[tt], acc[vt][tt]); }
}
DI bf16x8 pack_regs(const f32x16& x, int s) { u32x4 w; w.x = pk2(x[8 * s], x[8 * s + 1]); w.y = pk2(x[8 * s + 2], x[8 * s + 3]); w.z = pk2(x[8 * s + 4], x[8 * s + 5]); w.w = pk2(x[8 * s + 6], x[8 * s + 7]); return __builtin_bit_cast(bf16x8, w); }
template <int INCL> DI void pack_masked(const f32x16 (&acc)[2][2], bf16x8 (&xf)[2][2][2], int l32, int h) {
    l32 = launder(l32); h = launder(h);
#pragma unroll
    for (int it = 0; it < 2; ++it)
#pragma unroll
        for (int tt = 0; tt < 2; ++tt) {
            if (it > tt) { xf[it][tt][0] = (bf16x8){0, 0, 0, 0, 0, 0, 0, 0}; xf[it][tt][1] = (bf16x8){0, 0, 0, 0, 0, 0, 0, 0}; continue; }
            if (it < tt) { xf[it][tt][0] = pack_regs(acc[it][tt], 0); xf[it][tt][1] = pack_regs(acc[it][tt], 1); continue; }
            f32x16 m;
#pragma unroll
            for (int r = 0; r < 16; ++r) { const int i = crow_(r, h); m[r] = (INCL ? i <= l32 : i < l32) ? acc[it][tt][r] : 0.f; }
            xf[it][tt][0] = pack_regs(m, 0); xf[it][tt][1] = pack_regs(m, 1); }
}
DI void store_tm(const f32x16 (&acc)[2][2], lds_t img, int l32, int h) {
    l32 = launder(l32); h = launder(h);
#pragma unroll
    for (int a = 0; a < 2; ++a)
#pragma unroll
        for (int b = 0; b < 2; ++b)
#pragma unroll
            for (int q = 0; q < 4; ++q) { u32x2 w; w.x = pk2(acc[a][b][4 * q], acc[a][b][4 * q + 1]); w.y = pk2(acc[a][b][4 * q + 2], acc[a][b][4 * q + 3]);
                *(LAS u32x2*)(img + swz(32 * b + l32, 4 * a + q) + 8 * h) = w; }
}
DI void solve_rows(lds_t rhs, lds_t tab, lds_t out, int lane) {
    lane = launder(lane);
    lds_t orow = out + lane * 128; const int sw = (lane >> 1) & 7; const int rb = ((lane >> 3) << 4), rl = (lane & 7) * 2;
    const int l32 = lane & 31, h = lane >> 5;
#define DOT4(a, cw, xw, j0) asm volatile("v_dot2c_f32_bf16 %0, %4, %20\n\tv_dot2c_f32_bf16 %1, %8, %20\n\tv_dot2c_f32_bf16 %2, %12, %20\n\tv_dot2c_f32_bf16 %3, %16, %20\n\t" \
                              "v_dot2c_f32_bf16 %0, %5, %21\n\tv_dot2c_f32_bf16 %1, %9, %21\n\tv_dot2c_f32_bf16 %2, %13, %21\n\tv_dot2c_f32_bf16 %3, %17, %21\n\t" \
                              "v_dot2c_f32_bf16 %0, %6, %22\n\tv_dot2c_f32_bf16 %1, %10, %22\n\tv_dot2c_f32_bf16 %2, %14, %22\n\tv_dot2c_f32_bf16 %3, %18, %22\n\t" \
                              "v_dot2c_f32_bf16 %0, %7, %23\n\tv_dot2c_f32_bf16 %1, %11, %23\n\tv_dot2c_f32_bf16 %2, %15, %23\n\tv_dot2c_f32_bf16 %3, %19, %23\n\ts_nop 3" \
                : "+v"(a[j0]), "+v"(a[j0 + 1]), "+v"(a[j0 + 2]), "+v"(a[j0 + 3]) \
                : "v"(cw[j0].x), "v"(cw[j0].y), "v"(cw[j0].z), "v"(cw[j0].w), "v"(cw[j0 + 1].x), "v"(cw[j0 + 1].y), "v"(cw[j0 + 1].z), "v"(cw[j0 + 1].w), \
                  "v"(cw[j0 + 2].x), "v"(cw[j0 + 2].y), "v"(cw[j0 + 2].z), "v"(cw[j0 + 2].w), "v"(cw[j0 + 3].x), "v"(cw[j0 + 3].y), "v"(cw[j0 + 3].z), "v"(cw[j0 + 3].w), \
                  "v"(xw.x), "v"(xw.y), "v"(xw.z), "v"(xw.w))
    f32x16 u0[2], u1[2], zero;
#pragma unroll
    for (int i = 0; i < 16; ++i) { zero[i] = 0.f; u1[0][i] = 0.f; u1[1][i] = 0.f; u0[0][i] = 0.f; u0[1][i] = 0.f; }
#pragma unroll
    for (int b = 0; b < 4; ++b) {
        const int tA = 16 * b, tB = tA + 8, cA = 2 * b, cB = cA + 1;
        float a[8], a2[8]; u32x4 dg0[8], cw[8], dg1[8];
#pragma unroll
        for (int j = 0; j < 8; ++j) { const int t = tA + j, u = tB + j;
            a[j] = bf2f(*(const LAS bf16_t*)(rhs + t * 128 + (rb ^ (((t >> 1) & 7) << 4)) + rl)); a2[j] = bf2f(*(const LAS bf16_t*)(rhs + u * 128 + (rb ^ (((u >> 1) & 7) << 4)) + rl)); }
#pragma unroll
        for (int j = 0; j < 8; ++j) { const int t = tA + j, u = tB + j;
            dg0[j] = *(const LAS u32x4*)(tab + t * 128 + ((cA ^ ((t >> 1) & 7)) << 4)); cw[j] = *(const LAS u32x4*)(tab + u * 128 + ((cA ^ ((u >> 1) & 7)) << 4)); dg1[j] = *(const LAS u32x4*)(tab + u * 128 + ((cB ^ ((u >> 1) & 7)) << 4)); }
        if (b > 0) { const int k0 = 16 * (b - 1); const bf16x8 xb0 = fragN(out, l32, k0, h), xb1 = fragN(out, 32 + l32, k0, h);
            if (b == 1) { const bf16x8 af0 = fragN(tab, l32, k0, h); u0[0] = MFMA32(af0, xb0, zero); u0[1] = MFMA32(af0, xb1, zero); }
            const bf16x8 af1 = fragN(tab, 32 + l32, k0, h); u1[0] = MFMA32(af1, xb0, u1[0]); u1[1] = MFMA32(af1, xb1, u1[1]);
            const int R0 = (b == 2) ? 0 : 8;
#pragma unroll
            for (int i = 0; i < 8; ++i) { const float X = (b == 1) ? u0[0][R0 + i] : u1[0][R0 + i], Y = (b == 1) ? u0[1][R0 + i] : u1[1][R0 + i];
                const auto r = __builtin_amdgcn_permlane32_swap(__float_as_uint(X), __float_as_uint(Y), false, false);
                const float lo = __uint_as_float(r[0]), hi = __uint_as_float(r[1]);
                if (i < 4) { a[i] += lo; a[4 + i] += hi; } else { a2[i - 4] += lo; a2[i] += hi; } }
        }
#pragma unroll
        for (int j = 1; j < 8; ++j) { float cf[8]; unpack8(dg0[j], cf);
#pragma unroll
            for (int q = 0; q < 8; ++q) if (q < j) a[j] += cf[q] * a[q]; }
        const u32x4 x0 = pack8(a);
        *(LAS u32x4*)(orow + ((cA ^ sw) << 4)) = x0;
        DOT4(a2, cw, x0, 0); DOT4(a2, cw, x0, 4);
#pragma unroll
        for (int j = 1; j < 8; ++j) { float cf[8]; unpack8(dg1[j], cf);
#pragma unroll
            for (int q = 0; q < 8; ++q) if (q < j) a2[j] += cf[q] * a2[q]; }
        *(LAS u32x4*)(orow + ((cB ^ sw) << 4)) = pack8(a2);
    }
#undef DOT4
}
struct ScanTask { int chain, h, r0, sgn; };
DI int scan_order(int q) { const int rbk = q >> 5, j = q & 31, dir = j & 1, bh = j >> 1, chain = dir * 16 + bh;
    const int ck = dir ? (rbk < 4 ? 3 - rbk : 4 + 255 - (rbk - 4)) : rbk; return chain * NCHUNK + ck; }
DI int scan_deal(int bid, int slot3, int trip, int G) {
    if (G != 256) { const int q = bid * 3 + slot3 + trip * G * 3; return q < 32 * NCHUNK ? scan_order(q) : -1; }
    const int xcd = bid & 7, sl = (bid >> 3) * 3 + slot3, grp = (trip * 8 + xcd) * 6 + sl / 16, mem = sl % 16;
    if (grp >= 2 * NCHUNK) return -1;
    const int rbk = grp >> 1, b = grp & 1, dir = mem & 1, hd = mem >> 1, chain = dir * 16 + b * 8 + hd;
    const int ck = dir ? (rbk < 4 ? 3 - rbk : 4 + 255 - (rbk - 4)) : rbk; return chain * NCHUNK + ck; }

DI ScanTask scan_task(int task) { ScanTask T; T.chain = task / NCHUNK; const int ck = task % NCHUNK, dir = T.chain >> 4, b = (T.chain >> 3) & 1; T.h = T.chain & 7;
    int base, len, c2; if (ck < 4) { base = b * CTXL; len = CTXL; c2 = ck; } else { base = NCTX + b * SEQ; len = SEQ; c2 = ck - 4; }
    T.r0 = dir ? base + len - 1 - 64 * c2 : base + 64 * c2; T.sgn = dir ? -1 : 1; return T; }
DI void write_cm_row(lds_t img, const unsigned (&pk)[32], int lane) {
    lane = launder(lane);
#pragma unroll
    for (int ch = 0; ch < 8; ++ch) *(LAS u32x4*)(img + swz(lane, ch)) = (u32x4){pk[4 * ch], pk[4 * ch + 1], pk[4 * ch + 2], pk[4 * ch + 3]};
}
DI void stage_raw(const bf16_t* src, const ScanTask& T, lds_t dst, int lane) {
    lane = launder(lane);
#pragma unroll
    for (int i = 0; i < 8; ++i) { const int q = lane + 64 * i, t = q >> 3, c8 = q & 7;
        *(LAS u32x4*)(dst + swz(t, c8)) = *(const u32x4*)(src + (size_t)(T.r0 + T.sgn * t) * 512 + T.h * 64 + c8 * 8); }
}
template <int N> DI void stage_raw_n(const bf16_t* const (&src)[N], const int (&slot)[N], const ScanTask& T, lds_t wl, int lane) {
    lane = launder(lane);
    u32x4 v[N][8];
    __builtin_amdgcn_sched_barrier(0);
#pragma unroll
    for (int p = 0; p < N; ++p)
#pragma unroll
        for (int i = 0; i < 8; ++i) { const int q = lane + 64 * i, t = q >> 3, c8 = q & 7; v[p][i] = *(const u32x4*)(src[p] + (size_t)(T.r0 + T.sgn * t) * 512 + T.h * 64 + c8 * 8); }
    __builtin_amdgcn_sched_barrier(0);
#pragma unroll
    for (int p = 0; p < N; ++p)
#pragma unroll
        for (int i = 0; i < 8; ++i) { const int q = lane + 64 * i, t = q >> 3, c8 = q & 7; *(LAS u32x4*)(wl + slot[p] + swz(t, c8)) = v[p][i]; }
    __builtin_amdgcn_sched_barrier(0);
}
DI void read_col(lds_t img, unsigned (&pk)[32], int lane) {
    lane = launder(lane);
    const int tw = ((lane >> 3) << 4), tb = (lane & 7) * 2;
    unsigned lo[32], hi[32];
#pragma unroll
    for (int t2 = 0; t2 < 32; ++t2) { const int ta = 2 * t2, tc = 2 * t2 + 1;
        lo[t2] = *(const LAS bf16_t*)(img + ta * 128 + (tw ^ (((ta >> 1) & 7) << 4)) + tb); hi[t2] = *(const LAS bf16_t*)(img + tc * 128 + (tw ^ (((tc >> 1) & 7) << 4)) + tb); }
#pragma unroll
    for (int t2 = 0; t2 < 32; ++t2) pk[t2] = lo[t2] | (hi[t2] << 16);
}
template <bool P3>
DI float scan_prep(const Frame& F, int l, const ScanTask& T, lds_t wl, int lane) {
    const int dir = T.chain >> 4;
    if (P3) { const bf16_t* const src[6] = {wsp<bf16_t>(F, OFF_RKK), wsp<bf16_t>(F, OFF_RK), wsp<bf16_t>(F, dir ? OFF_AB : OFF_AF), wsp<bf16_t>(F, dir ? OFF_EB : OFF_EF), wsp<bf16_t>(F, OFF_RV), wsp<bf16_t>(F, OFF_RR)};
        const int slot[6] = {SL_A, SL_K, SL_B, SL_T, SL_V, SL_R}; stage_raw_n<6>(src, slot, T, wl, lane); }
    else { const bf16_t* const src[5] = {wsp<bf16_t>(F, OFF_RKK), wsp<bf16_t>(F, OFF_RK), wsp<bf16_t>(F, dir ? OFF_AB : OFF_AF), wsp<bf16_t>(F, dir ? OFF_EB : OFF_EF), wsp<bf16_t>(F, OFF_RV)};
        const int slot[5] = {SL_A, SL_K, SL_B, SL_T, SL_V}; stage_raw_n<5>(src, slot, T, wl, lane); }
    const float ka = F.in[I_KA][(size_t)l * 512 + T.h * 64 + lane];
    float E2 = 0.f, gprev = 1.f;
    lane = launder(lane);
    const int tw = ((lane >> 3) << 4), tb = (lane & 7) * 2;
#pragma unroll 1
    for (int t8 = 0; t8 < 8; ++t8) {
        float kk_[8], k_[8], al_[8], e_[8], r_[8]; int off_[8];
#pragma unroll
        for (int j = 0; j < 8; ++j) { const int t = t8 * 8 + j; off_[j] = t * 128 + (tw ^ (((t >> 1) & 7) << 4)) + tb;
            kk_[j] = bf2f(*(const LAS bf16_t*)(wl + SL_A + off_[j])); k_[j] = bf2f(*(const LAS bf16_t*)(wl + SL_K + off_[j])); al_[j] = bf2f(*(const LAS bf16_t*)(wl + SL_B + off_[j]));
            e_[j] = bf2f(*(const LAS bf16_t*)(wl + SL_T + off_[j])); r_[j] = P3 ? bf2f(*(const LAS bf16_t*)(wl + SL_R + off_[j])) : 0.f; }
#pragma unroll
        for (int j = 0; j < 8; ++j) {
            E2 += e_[j] * 1.4426950408889634f;
            const float g = __builtin_amdgcn_exp2f(-E2), ex = __builtin_amdgcn_rcpf(g);
            const float at = -kk_[j] * gprev, bh = kk_[j] * al_[j] * ex, kh = k_[j] * (1.0f + (al_[j] - 1.0f) * ka) * ex;
            gprev = g;
            if (P3) *(LAS bf16_t*)(wl + SL_R + off_[j]) = f2bf(r_[j] * g);
            *(LAS bf16_t*)(wl + SL_A + off_[j]) = f2bf(at); *(LAS bf16_t*)(wl + SL_B + off_[j]) = f2bf(bh); *(LAS bf16_t*)(wl + SL_K + off_[j]) = f2bf(kh);
        }
    }
    { unsigned vcm[32]; read_col(wl + SL_V, vcm, lane); write_cm_row(wl + SL_V, vcm, lane); }
    return gprev;
}
DI void make_table(lds_t wl, int l32, int h, int slot_b = SL_B) {
    l32 = launder(l32); h = launder(h);
    f32x16 acc[2][2]; zero_acc(acc); mm_nn(acc, wl + slot_b, wl + SL_A, l32, h);
#pragma unroll
    for (int it = 0; it < 2; ++it)
#pragma unroll
        for (int tt = 0; tt < 2; ++tt)
#pragma unroll
            for (int q = 0; q < 4; ++q) { if (it > tt) continue;
                const int t = 32 * tt + l32, i0 = 8 * q + 4 * h; float v[4];
#pragma unroll
                for (int e = 0; e < 4; ++e) v[e] = (it < tt || i0 + e < l32) ? acc[it][tt][4 * q + e] : 0.f;
                u32x2 w; w.x = pk2(v[0], v[1]); w.y = pk2(v[2], v[3]);
                *(LAS u32x2*)(wl + SL_T + swz(t, 4 * it + q) + 8 * h) = w; }
}
DI void scan_pass1(const Frame& F, int l) {
    const int lane = F.lane, l32 = lane & 31, h = lane >> 5, pr = F.wid >> 1, role = F.wid & 1;
    lds_t wl = F.lds + (pr < 3 ? pr : 0) * WAVE_LDS; LAS float* gtab = (LAS float*)(F.lds + MISC_OFF + 512 + (pr < 3 ? pr : 0) * 256);
    u32x4* MP = wsp<u32x4>(F, OFF_MP); u32x4* NS = wsp<u32x4>(F, OFF_NS);
    const int ntrip = (32 * NCHUNK + F.G * 3 - 1) / (F.G * 3);
    u32x4 pf[3][8];
#define P1_REQUEST(task_) do { const ScanTask Tq_ = scan_task(task_); const int dq_ = Tq_.chain >> 4; const int ln_ = launder(lane); \
        const bf16_t* s0_ = role ? wsp<bf16_t>(F, OFF_RK) : wsp<bf16_t>(F, OFF_RKK); const bf16_t* s1_ = role ? wsp<bf16_t>(F, OFF_RV) : wsp<bf16_t>(F, dq_ ? OFF_AB : OFF_AF); const bf16_t* s2_ = wsp<bf16_t>(F, dq_ ? OFF_EB : OFF_EF); \
        __builtin_amdgcn_sched_barrier(0); \
        _Pragma("unroll") for (int i_ = 0; i_ < 8; ++i_) { const int q_ = ln_ + 64 * i_, t_ = q_ >> 3, c8_ = q_ & 7; const size_t ro_ = (size_t)(Tq_.r0 + Tq_.sgn * t_) * 512 + Tq_.h * 64 + c8_ * 8; \
            pf[0][i_] = *(const u32x4*)(s0_ + ro_); pf[1][i_] = *(const u32x4*)(s1_ + ro_); if (role == 0) pf[2][i_] = *(const u32x4*)(s2_ + ro_); else asm volatile("" : "=v"(pf[2][i_].x), "=v"(pf[2][i_].y), "=v"(pf[2][i_].z), "=v"(pf[2][i_].w)); } \
        __builtin_amdgcn_sched_barrier(0); } while (0)
#define P1_UNDEF() do { _Pragma("unroll") for (int p_ = 0; p_ < 3; ++p_) _Pragma("unroll") for (int i_ = 0; i_ < 8; ++i_) asm volatile("" : "=v"(pf[p_][i_].x), "=v"(pf[p_][i_].y), "=v"(pf[p_][i_].z), "=v"(pf[p_][i_].w)); } while (0)
    { const int t0_ = pr < 3 ? scan_deal(F.bid, pr, 0, F.G) : -1; if (t0_ >= 0) P1_REQUEST(t0_); else P1_UNDEF(); }
    for (int trip = 0; trip < ntrip; ++trip) {
        const int task_ = pr < 3 ? scan_deal(F.bid, pr, trip, F.G) : -1; const bool on = task_ >= 0; const int task = on ? task_ : 0;
        ScanTask T = scan_task(on ? task : 0); const int dir = T.chain >> 4; (void)dir;
        const int tw = ((launder(lane) >> 3) << 4), tb = (launder(lane) & 7) * 2;
        if (on) { const int ln_ = launder(lane);
#pragma unroll
            for (int i_ = 0; i_ < 8; ++i_) { const int q_ = ln_ + 64 * i_, t_ = q_ >> 3, c8_ = q_ & 7;
                *(LAS u32x4*)(wl + (role ? SL_K : SL_A) + swz(t_, c8_)) = pf[0][i_]; *(LAS u32x4*)(wl + (role ? SL_V : SL_B) + swz(t_, c8_)) = pf[1][i_]; if (role == 0) *(LAS u32x4*)(wl + SL_T + swz(t_, c8_)) = pf[2][i_]; } }
        __syncthreads();
        if (on) {
            const float ka = F.in[I_KA][(size_t)l * 512 + T.h * 64 + lane];
            float E2 = 0.f, gprev = 1.f;
#pragma unroll 1
            for (int t8 = 0; t8 < 8; ++t8) {
                float x_[8], al_[8], e_[8]; int off_[8];
#pragma unroll
                for (int j = 0; j < 8; ++j) { const int t = t8 * 8 + j; off_[j] = t * 128 + (tw ^ (((t >> 1) & 7) << 4)) + tb;
                    x_[j] = bf2f(*(const LAS bf16_t*)(wl + (role ? SL_K : SL_A) + off_[j])); al_[j] = bf2f(*(const LAS bf16_t*)(wl + SL_B + off_[j])); e_[j] = bf2f(*(const LAS bf16_t*)(wl + SL_T + off_[j])); }
#pragma unroll
                for (int j = 0; j < 8; ++j) {
                    E2 += e_[j] * 1.4426950408889634f;
                    const float g = __builtin_amdgcn_exp2f(-E2), ex = __builtin_amdgcn_rcpf(g);
                    if (role == 0) { *(LAS bf16_t*)(wl + SL_A + off_[j]) = f2bf(-x_[j] * gprev); *(LAS bf16_t*)(wl + SL_R + off_[j]) = f2bf(x_[j] * al_[j] * ex); }
                    else *(LAS bf16_t*)(wl + SL_K + off_[j]) = f2bf(x_[j] * (1.0f + (al_[j] - 1.0f) * ka) * ex);
                    gprev = g;
                }
            }
            if (role == 0) gtab[lane] = gprev;
            else { unsigned vcm[32]; read_col(wl + SL_V, vcm, lane); write_cm_row(wl + SL_V, vcm, lane); }
        }
        __syncthreads();
        if (on) {
            if (role == 0) make_table(wl, l32, h, SL_R);
            else { bf16x8 xf[2][2][2];
                { f32x16 acc[2][2]; zero_acc(acc); mm_nn(acc, wl + SL_K, wl + SL_A, l32, h); pack_masked<0>(acc, xf, l32, h); }
                __builtin_amdgcn_sched_barrier(0);
                { f32x16 acc[2][2]; zero_acc(acc); mm_xt(acc, xf, wl + SL_V, l32, h); store_tm(acc, wl + SL_B, l32, h); } }
        }
        __syncthreads();
        if (on) {
            if (role == 0) { unsigned bcm[32]; read_col(wl + SL_R, bcm, lane); __builtin_amdgcn_sched_barrier(0);
                solve_rows(wl + SL_A, wl + SL_T, wl + SL_R, lane); __builtin_amdgcn_sched_barrier(0);
                write_cm_row(wl + SL_A, bcm, lane); }
            else { unsigned kcm[32]; read_col(wl + SL_K, kcm, lane); __builtin_amdgcn_sched_barrier(0);
                solve_rows(wl + SL_B, wl + SL_T, wl + SL_K, lane); __builtin_amdgcn_sched_barrier(0);
                write_cm_row(wl + SL_B, kcm, lane); }
        }
        __syncthreads();
        { const int tn_ = (pr < 3 && trip + 1 < ntrip) ? scan_deal(F.bid, pr, trip + 1, F.G) : -1; if (tn_ >= 0) P1_REQUEST(tn_); else P1_UNDEF(); }
        if (on) {
            if (role == 0) { u32x4* mp = MP + (size_t)task * 512 + launder(lane);
                f32x16 acc[2][2]; zero_acc(acc); mm_nn_lp(acc, wl + SL_R, wl + SL_A, l32, h);
#pragma unroll
                for (int ct = 0; ct < 2; ++ct)
#pragma unroll
                    for (int cp = 0; cp < 2; ++cp) { const float gc = gtab[32 * cp + launder(l32)]; f32x16 m;
#pragma unroll
                        for (int r = 0; r < 16; ++r) m[r] = (acc[ct][cp][r] + ((ct == cp && crow_(r, h) == l32) ? 1.0f : 0.0f)) * gc;
                        mp[((ct * 2 + cp) * 2 + 0) * 64] = __builtin_bit_cast(u32x4, pack_regs(m, 0)); mp[((ct * 2 + cp) * 2 + 1) * 64] = __builtin_bit_cast(u32x4, pack_regs(m, 1)); }
            } else { u32x4* ns = NS + (size_t)task * 512 + launder(lane);
                f32x16 acc[2][2]; zero_acc(acc); mm_nn_lp(acc, wl + SL_A, wl + SL_K, l32, h); mm_nn_lp(acc, wl + SL_B, wl + SL_V, l32, h);
#pragma unroll
                for (int cp = 0; cp < 2; ++cp)
#pragma unroll
                    for (int vt = 0; vt < 2; ++vt) { f32x16 m;
#pragma unroll
                        for (int q = 0; q < 4; ++q) { const f32x4 g4 = *(const LAS f32x4*)(gtab + 32 * cp + 8 * q + 4 * h);
#pragma unroll
                            for (int e = 0; e < 4; ++e) m[4 * q + e] = acc[cp][vt][4 * q + e] * g4[e]; }
                        ns[((cp * 2 + vt) * 2 + 0) * 64] = __builtin_bit_cast(u32x4, pack_regs(m, 0)); ns[((cp * 2 + vt) * 2 + 1) * 64] = __builtin_bit_cast(u32x4, pack_regs(m, 1)); }
            }
        }
        __syncthreads();
    }
#undef P1_REQUEST
#undef P1_UNDEF
}
DI void scan_pass2(const Frame& F) {
    if (F.wid != 0) return;
    const int lane = F.lane;
    for (int task = F.bid; task < 64; task += F.G) {
        const int chain = task >> 1, vt = task & 1;
        const u32x4* MP = wsp<u32x4>(F, OFF_MP) + (size_t)chain * NCHUNK * 512 + lane; u32x4* NS = wsp<u32x4>(F, OFF_NS) + (size_t)chain * NCHUNK * 512 + lane;
        u32x4 sf[2][2], mA[8], nA[2][2], mB[8], nB[2][2], mC[8], nC[2][2];
#define P2_LOAD(m_, n_, ck_) do { _Pragma("unroll") for (int i_ = 0; i_ < 8; ++i_) m_[i_] = MP[(size_t)(ck_) * 512 + i_ * 64]; \
        _Pragma("unroll") for (int a_ = 0; a_ < 2; ++a_) _Pragma("unroll") for (int st_ = 0; st_ < 2; ++st_) n_[a_][st_] = NS[(size_t)(ck_) * 512 + ((a_ * 2 + vt) * 2 + st_) * 64]; } while (0)
#define P2_STEP(m_, n_, ck_) do { \
        _Pragma("unroll") for (int a_ = 0; a_ < 2; ++a_) _Pragma("unroll") for (int st_ = 0; st_ < 2; ++st_) NS[(size_t)(ck_) * 512 + ((a_ * 2 + vt) * 2 + st_) * 64] = sf[a_][st_];        \
        f32x16 acc_[2]; \
        _Pragma("unroll") for (int cp_ = 0; cp_ < 2; ++cp_) _Pragma("unroll") for (int st_ = 0; st_ < 2; ++st_) { float f_[8]; unpack8(n_[cp_][st_], f_); \
            _Pragma("unroll") for (int j_ = 0; j_ < 8; ++j_) acc_[cp_][8 * st_ + j_] = f_[j_]; } \
        _Pragma("unroll") for (int ct_ = 0; ct_ < 2; ++ct_) _Pragma("unroll") for (int st_ = 0; st_ < 2; ++st_) _Pragma("unroll") for (int cp_ = 0; cp_ < 2; ++cp_) \
            acc_[cp_] = MFMA32(__builtin_bit_cast(bf16x8, m_[(ct_ * 2 + cp_) * 2 + st_]), __builtin_bit_cast(bf16x8, sf[ct_][st_]), acc_[cp_]); \
        _Pragma("unroll") for (int ct_ = 0; ct_ < 2; ++ct_) { sf[ct_][0] = __builtin_bit_cast(u32x4, pack_regs(acc_[ct_], 0)); sf[ct_][1] = __builtin_bit_cast(u32x4, pack_regs(acc_[ct_], 1)); } } while (0)
#pragma unroll
        for (int a = 0; a < 2; ++a)
#pragma unroll
            for (int st = 0; st < 2; ++st) sf[a][st] = (u32x4){0u, 0u, 0u, 0u};
        P2_LOAD(mA, nA, 0); P2_LOAD(mB, nB, 1);
        for (int ck = 0; ck < NCHUNK; ck += 3) {
            { const int nx = ck + 2 < NCHUNK ? ck + 2 : NCHUNK - 1; P2_LOAD(mC, nC, nx); }
            P2_STEP(mA, nA, ck);
            if (ck + 1 < NCHUNK) { { const int nx = ck + 3 < NCHUNK ? ck + 3 : NCHUNK - 1; P2_LOAD(mA, nA, nx); } P2_STEP(mB, nB, ck + 1); }
            if (ck + 2 < NCHUNK) { { const int nx = ck + 4 < NCHUNK ? ck + 4 : NCHUNK - 1; P2_LOAD(mB, nB, nx); } P2_STEP(mC, nC, ck + 2); }
        }
#undef P2_LOAD
#undef P2_STEP
    }
}
DI void scan_pass3(const Frame& F, int l) {
    if (F.wid >= 3) return;
    const int lane = F.lane, l32 = lane & 31, h = lane >> 5;
    lds_t wl = F.lds + F.wid * WAVE_LDS;
    const u32x4* NS = wsp<u32x4>(F, OFF_NS);
    const int ntrip3 = (32 * NCHUNK + F.G * 3 - 1) / (F.G * 3);
    for (int trip = 0; trip < ntrip3; ++trip) {
        const int task = scan_deal(F.bid, F.wid, trip, F.G); if (task < 0) continue;
        const ScanTask T = scan_task(task);
        (void)scan_prep<true>(F, l, T, wl, lane);
        make_table(wl, l32, h);
#define SB_ __builtin_amdgcn_sched_barrier(0)
#define LOAD_SF() do { const u32x4* ns = NS + (size_t)task * 512 + lane; _Pragma("unroll") for (int i = 0; i < 8; ++i) sf[i >> 2][(i >> 1) & 1][i & 1] = __builtin_bit_cast(bf16x8, ns[i * 64]); } while (0)
        bf16x8 xf[2][2][2], xg[2][2][2];
        { f32x16 acc[2][2]; zero_acc(acc); mm_nn(acc, wl + SL_K, wl + SL_A, l32, h); pack_masked<0>(acc, xf, l32, h); }
        SB_;
        { bf16x8 sf[2][2][2]; LOAD_SF(); f32x16 acc[2][2]; zero_acc(acc); mm_st(acc, wl + SL_A, sf, l32, h); SB_; mm_xt(acc, xf, wl + SL_V, l32, h); SB_; store_tm(acc, wl + SL_A, l32, h); }
        SB_;
        { f32x16 acc[2][2]; zero_acc(acc); mm_nn(acc, wl + SL_B, wl + SL_R, l32, h); pack_masked<1>(acc, xf, l32, h); }
        SB_;
        solve_rows(wl + SL_A, wl + SL_T, wl + SL_B, lane);
        SB_;
        unsigned tch[7]; const int tn_ = trip + 1 < ntrip3 ? scan_deal(F.bid, F.wid, trip + 1, F.G) : -1;
        if (tn_ >= 0) { const ScanTask Tn = scan_task(tn_); const int dn = Tn.chain >> 4; const size_t ro = (size_t)(Tn.r0 + Tn.sgn * launder(lane)) * 512 + Tn.h * 64;
            tch[0] = *(const unsigned*)(wsp<bf16_t>(F, OFF_RKK) + ro); tch[1] = *(const unsigned*)(wsp<bf16_t>(F, OFF_RK) + ro); tch[2] = *(const unsigned*)(wsp<bf16_t>(F, dn ? OFF_AB : OFF_AF) + ro);
            tch[3] = *(const unsigned*)(wsp<bf16_t>(F, dn ? OFF_EB : OFF_EF) + ro); tch[4] = *(const unsigned*)(wsp<bf16_t>(F, OFF_RV) + ro); tch[5] = *(const unsigned*)(wsp<bf16_t>(F, OFF_RR) + ro);
            tch[6] = *((const unsigned*)(NS + (size_t)tn_ * 512) + launder(lane) * 32); }
        else {
#pragma unroll
            for (int i = 0; i < 7; ++i) tch[i] = 0u; }
        SB_;
        f32x16 y[2][2]; zero_acc(y);
        mm_xt(y, xf, wl + SL_B, l32, h);
        SB_;
        { bf16x8 sf[2][2][2]; LOAD_SF(); mm_st(y, wl + SL_R, sf, l32, h); }
        SB_;
        { f32x16 acc[2][2]; zero_acc(acc); mm_nn(acc, wl + SL_K, wl + SL_R, l32, h); pack_masked<1>(acc, xg, l32, h); }
        SB_;
        mm_xt(y, xg, wl + SL_V, l32, h);
        SB_;
#undef LOAD_SF
        bf16_t* Y = wsp<bf16_t>(F, (T.chain >> 4) ? OFF_YB : OFF_YF);
        store_tm(y, wl + SL_A, l32, h);
        { const int ln = launder(lane);
#pragma unroll
          for (int i = 0; i < 8; ++i) { const int q = ln + 64 * i, t = q >> 3, c8 = q & 7;
              *(u32x4*)(Y + (size_t)(T.r0 + T.sgn * t) * 512 + T.h * 64 + c8 * 8) = *(const LAS u32x4*)(wl + SL_A + swz(t, c8)); } }
#pragma unroll
        for (int i = 0; i < 7; ++i) asm volatile("" :: "v"(tch[i]));
    }
}
DI void rwkv_out_rows(const Frame& F, int l, int r_begin) {
    const int gw = F.bid * 8 + F.wid, nw = F.G * 8, lane = F.lane, c0 = 8 * lane;
    const bf16_t* RR = wsp<bf16_t>(F, OFF_RR); const bf16_t* RK = wsp<bf16_t>(F, OFF_RK); const bf16_t* RV = wsp<bf16_t>(F, OFF_RV);
    const bf16_t* AF = wsp<bf16_t>(F, OFF_AF); const bf16_t* AB = wsp<bf16_t>(F, OFF_AB); const bf16_t* GG = wsp<bf16_t>(F, OFF_GG);
    bf16_t* YF = wsp<bf16_t>(F, OFF_YF); const bf16_t* YB = wsp<bf16_t>(F, OFF_YB);
    float ka[8], rk[8], gw_[8], gb_[8];
#pragma unroll
    for (int e = 0; e < 8; ++e) { ka[e] = F.in[I_KA][(size_t)l * 512 + c0 + e]; rk[e] = F.in[I_RK][(size_t)l * 512 + c0 + e]; gw_[e] = F.in[I_GNW][(size_t)l * 512 + c0 + e]; gb_[e] = F.in[I_GNB][(size_t)l * 512 + c0 + e]; }
    for (int ra = r_begin + gw; ra < MROWS; ra += 2 * nw) {
        const bool two = ra + nw < MROWS; u32x4 w[2][8];
#pragma unroll
        for (int q = 0; q < 2; ++q) { const size_t ro = (size_t)(q && two ? ra + nw : ra) * 512 + c0;
            w[q][0] = *(const u32x4*)(YF + ro); w[q][1] = *(const u32x4*)(YB + ro); w[q][2] = *(const u32x4*)(RR + ro); w[q][3] = *(const u32x4*)(RK + ro); w[q][4] = *(const u32x4*)(RV + ro);
            w[q][5] = *(const u32x4*)(AF + ro); w[q][6] = *(const u32x4*)(AB + ro); w[q][7] = *(const u32x4*)(GG + ro); }
#pragma unroll
        for (int q = 0; q < 2; ++q) { if (q && !two) break;
            const size_t ro = (size_t)(q ? ra + nw : ra) * 512 + c0; float yf[8], yb[8], y[8], rr[8], k[8], v[8], af[8], ab[8], g[8];
            unpack8(w[q][0], yf); unpack8(w[q][1], yb); unpack8(w[q][2], rr); unpack8(w[q][3], k); unpack8(w[q][4], v); unpack8(w[q][5], af); unpack8(w[q][6], ab); unpack8(w[q][7], g);
            float s = 0.f;
#pragma unroll
            for (int e = 0; e < 8; ++e) { y[e] = yf[e] + yb[e]; s += y[e]; }
            const float mean = sum8(s) * (1.0f / 64.0f); float qq = 0.f, cf = 0.f;
#pragma unroll
            for (int e = 0; e < 8; ++e) { const float d = y[e] - mean; qq += d * d; const float kmf = k[e] * (1.0f + (af[e] - 1.0f) * ka[e]), kmb = k[e] * (1.0f + (ab[e] - 1.0f) * ka[e]); cf += rr[e] * (kmf + kmb) * rk[e]; }
            const float rstd = rsqrtf(sum8(qq) * (1.0f / 64.0f) + 64e-5f); cf = sum8(cf);
            float o[8];
#pragma unroll
            for (int e = 0; e < 8; ++e) o[e] = ((y[e] - mean) * rstd * gw_[e] + gb_[e] + cf * v[e]) * g[e];
            *(u32x4*)(YF + ro) = pack8(o); }
    }
}

struct RouteRec { int e0, e1; float g0, g1; int s0, s1; int pad0, pad1; };
DI void route_phase(const Frame& F, int l, int r_begin) {
    LAS int* hist = (LAS int*)(F.lds);
    if (F.tid < 32) hist[F.tid] = 0;
    __syncthreads();
    const float* lg = wsp<const float>(F, OFF_LOGITS); RouteRec* rec = wsp<RouteRec>(F, OFF_ROUTE);
    { int* st = wsp<int>(F, OFF_SLOTTOK); for (int i = F.bid * 512 + F.tid; i < PMAX; i += F.G * 512) st[i] = 0; }
    for (int tok = r_begin + F.bid * 512 + F.tid; tok < MROWS; tok += F.G * 512) {
        const float* p = lg + (size_t)tok * 64; const f32x4 g4 = *(const f32x4*)p;
        int grp = 0; float mx = g4[0];
#pragma unroll
        for (int i = 1; i < 4; ++i) if (g4[i] > mx) { mx = g4[i]; grp = i; }
        float den = 0.f;
#pragma unroll
        for (int i = 0; i < 4; ++i) den += __expf(g4[i] - mx);
        const float pg = 1.0f / den;
        const f32x4 ea = *(const f32x4*)(p + 4 + grp * 8), eb = *(const f32x4*)(p + 8 + grp * 8); float le[8] = {ea[0], ea[1], ea[2], ea[3], eb[0], eb[1], eb[2], eb[3]};
        int i1 = 0; float v1 = le[0];
#pragma unroll
        for (int i = 1; i < 8; ++i) if (le[i] > v1) { v1 = le[i]; i1 = i; }
        int i2 = -1; float v2 = -3.0e38f;
#pragma unroll
        for (int i = 0; i < 8; ++i) if (i != i1 && le[i] > v2) { v2 = le[i]; i2 = i; }
        const float ex = __expf(v2 - v1), w1 = 1.0f / (1.0f + ex), w2 = ex * w1;
        RouteRec rc; rc.e0 = grp * 8 + i1; rc.e1 = grp * 8 + i2; rc.g0 = pg * w1; rc.g1 = pg * w2; rc.s0 = 0; rc.s1 = 0; rc.pad0 = 0; rc.pad1 = 0;
        rec[tok] = rc;
        __hip_atomic_fetch_add(&hist[rc.e0], 1, __ATOMIC_RELAXED, __HIP_MEMORY_SCOPE_WORKGROUP); __hip_atomic_fetch_add(&hist[rc.e1], 1, __ATOMIC_RELAXED, __HIP_MEMORY_SCOPE_WORKGROUP);
    }
    __syncthreads();
    if (F.tid < 32 && hist[F.tid]) atomicAdd(wsp<int>(F, OFF_CTL) + CW_CNT + l * 32 + F.tid, hist[F.tid]);
}
DI void build_tab(const Frame& F, int l, LAS int* tab) {
    if (F.tid < 64) { const int* cnt = wsp<int>(F, OFF_CTL) + CW_CNT + l * 32; const int lane = F.tid;
        int v = lane < 32 ? ((__hip_atomic_load(cnt + lane, __ATOMIC_RELAXED, __HIP_MEMORY_SCOPE_AGENT) + 255) >> 8) : 0;
        int inc = v;
#pragma unroll
        for (int sft = 1; sft < 32; sft <<= 1) { const int o = __shfl_up(inc, sft); if (lane >= sft) inc += o; }
        if (lane < 32) tab[lane] = inc - v;
        if (lane == 31) tab[32] = inc; }
    __syncthreads();
}
DI void assign_gather_phase(const Frame& F, int l, int r_begin) {
    LAS int* tab = (LAS int*)(F.lds + MISC_OFF + 64); LAS int* lcnt = tab + 40; LAS int* gbase = lcnt + 32;
    build_tab(F, l, tab);
    if (F.tid < 32) lcnt[F.tid] = 0;
    __syncthreads();
    const int per = (MROWS - r_begin + F.G - 1) / F.G, t0 = r_begin + F.bid * per, t1 = min(MROWS, t0 + per);
    RouteRec* rec = wsp<RouteRec>(F, OFF_ROUTE);
    int e0 = 0, e1 = 0, r0 = 0, r1 = 0; const int tok = t0 + F.tid; const bool act = tok < t1;
    if (act) { e0 = rec[tok].e0; e1 = rec[tok].e1; r0 = __hip_atomic_fetch_add(&lcnt[e0], 1, __ATOMIC_RELAXED, __HIP_MEMORY_SCOPE_WORKGROUP); r1 = __hip_atomic_fetch_add(&lcnt[e1], 1, __ATOMIC_RELAXED, __HIP_MEMORY_SCOPE_WORKGROUP); }
    __syncthreads();
    if (F.tid < 32) { const int n = lcnt[F.tid]; gbase[F.tid] = tab[F.tid] * 256 + (n ? atomicAdd(wsp<int>(F, OFF_CTL) + CW_CUR + l * 32 + F.tid, n) : 0); }
    __syncthreads();
    if (act) { const int s0 = gbase[e0] + r0, s1 = gbase[e1] + r1; rec[tok].s0 = s0; rec[tok].s1 = s1; int* st = wsp<int>(F, OFF_SLOTTOK); st[s0] = tok; st[s1] = tok; }
}
template <bool NEXT>
DI void combine_rows(const Frame& F, int l, int r_begin, const float* gn, bf16_t* xn) {
    const int gw = F.bid * 8 + F.wid, nw = F.G * 8;
    const RouteRec* rec = wsp<RouteRec>(F, OFF_ROUTE); const bf16_t* YB = wsp<bf16_t>(F, OFF_YBUF); float* ctxb = wsp<float>(F, OFF_CTX);
    for (int r = r_begin + gw; r < MROWS; r += nw) {
        const RouteRec rc = rec[r]; const int cond = row_cond(r); const float* gate = modp(F, l, cond, 5);
        float* xr = r < NCTX ? ctxb + (size_t)r * DM : F.out + (size_t)(r - NCTX) * DM;
        f32x4 xv[2][2]; float ss = 0.f;
        u32x4 wy0[2], wy1[2]; f32x4 xa_[2], xb_[2], ga_[2], gb_[2], g4_[2][2], s4_[2][2], c4_[2][2];
        const float* sh = modp(F, l + 1, cond, 0); const float* sc = modp(F, l + 1, cond, 1);
#pragma unroll
        for (int j = 0; j < 2; ++j) { const int c0 = 8 * F.lane + 512 * j;
            wy0[j] = *(const u32x4*)(YB + (size_t)rc.s0 * DM + c0); wy1[j] = *(const u32x4*)(YB + (size_t)rc.s1 * DM + c0);
            xa_[j] = *(const f32x4*)(xr + c0); xb_[j] = *(const f32x4*)(xr + c0 + 4); ga_[j] = *(const f32x4*)(gate + c0); gb_[j] = *(const f32x4*)(gate + c0 + 4);
            if (NEXT) {
#pragma unroll
                for (int q = 0; q < 2; ++q) { g4_[j][q] = *(const f32x4*)(gn + c0 + 4 * q); s4_[j][q] = *(const f32x4*)(sh + c0 + 4 * q); c4_[j][q] = *(const f32x4*)(sc + c0 + 4 * q); } } }
#pragma unroll
        for (int j = 0; j < 2; ++j) { const int c0 = 8 * F.lane + 512 * j; float y0[8], y1[8];
            unpack8(wy0[j], y0); unpack8(wy1[j], y1);
            f32x4 xa = xa_[j], xb = xb_[j]; const f32x4 ga = ga_[j], gb = gb_[j];
#pragma unroll
            for (int e = 0; e < 4; ++e) { xa[e] += ga[e] * (rc.g0 * y0[e] + rc.g1 * y1[e]); xb[e] += gb[e] * (rc.g0 * y0[4 + e] + rc.g1 * y1[4 + e]); }
            *(f32x4*)(xr + c0) = xa; *(f32x4*)(xr + c0 + 4) = xb;
            if (NEXT) { xv[j][0] = xa; xv[j][1] = xb;
#pragma unroll
                for (int e = 0; e < 4; ++e) ss += xa[e] * xa[e] + xb[e] * xb[e]; } }
        if (NEXT) {
            ss = wave_sum(ss); const float inv = rsqrtf(ss * (1.0f / DM) + 1e-6f);
#pragma unroll
            for (int j = 0; j < 2; ++j) { const int c0 = 8 * F.lane + 512 * j; float o[8];
#pragma unroll
                for (int q = 0; q < 2; ++q) { const f32x4 g4 = g4_[j][q], s4 = s4_[j][q], c4 = c4_[j][q];
#pragma unroll
                    for (int e = 0; e < 4; ++e) o[4 * q + e] = (xv[j][q][e] * inv * g4[e]) * (1.0f + c4[e]) + s4[e]; }
                *(u32x4*)(xn + (size_t)r * DM + c0) = pack8(o); }
        }
    }
}

constexpr int PH_PER_LAYER = 19, N_PHASES = 1 + 2 * PH_PER_LAYER;
#if MK_ONE_LAUNCH
#define GRID_BAR() xcd_barrier(bar)
#else
#define GRID_BAR() do { } while (0)
#endif
#ifndef PH_MASK
#define PH_MASK 0xFFFFFFFFu
#endif
#define PON(j) (((PH_MASK) >> (j)) & 1u)
#ifndef REP_MASK
#define REP_MASK 0u
#endif
#define REPEAT(j) for (int rep_ = 0; rep_ < 1 + (int)(((REP_MASK) >> (j)) & 1u); ++rep_)
#define IN(k) (lo <= (k) && (k) < hi)
#define SEAM(k) do { if (IN((k) + 1)) GRID_BAR(); } while (0)
template <int l, class BarT>
DI void layer_phases(const Frame& F0, const int lo, const int hi, const BarT& bar) {
        const Frame& F = F0;
        constexpr bool LAST = (l == EN_LAYERS - 1);
        constexpr int RB = LAST ? NCTX : 0, PM0 = LAST ? 2 : 0;
        const int pb = 1 + l * PH_PER_LAYER;
        const float* xlat = l == 0 ? F.in[I_X] : F.out;
        const float* modl = wsp<const float>(F, OFF_MOD) + (size_t)l * 3 * 6144;
        if (PON(0) && IN(pb + 0)) { const Frame F = phase_frame(F0); REPEAT(0) {  if (l == 0) norm_rows(F, xlat, F.in[I_N1G] + (size_t)l * DM, l, 0, 1, wsp<bf16_t>(F, OFF_XN));  } if (l == 0) SEAM(pb + 0); }
        if (PON(1) && IN(pb + 1)) { const Frame F = phase_frame(F0); REPEAT(1) {  pg8::Gemm g{wsp<bf16_t>(F, OFF_XN), wsp<bf16_t>(F, OFF_WIN), DM, nullptr, nullptr}; pg8::StaticOrder S; S.init(MROWS, N_INP, F.G, F.bid); EpiInproj E{F.ws};
            pg8::gemm_phase(F.lds, g, S, E, F.tid);  } SEAM(pb + 1); }
        if (PON(2) && IN(pb + 2)) { const Frame F = phase_frame(F0); REPEAT(2) {  phaseC_rows(F, l); __syncthreads(); phaseC_vt(F);  } SEAM(pb + 2); }
        if (PON(3) && IN(pb + 3)) { const Frame F = phase_frame(F0); REPEAT(3) {  pg8::Gemm g{wsp<bf16_t>(F, OFF_ALORA), wsp<bf16_t>(F, OFF_WLORA), LORA_K, nullptr, nullptr}; pg8::StaticOrder S; S.init(MROWS, LORA_N, F.G, F.bid);
            EpiLora E{F.ws, F.in[I_DW0] + (size_t)l * 1024, F.in[I_AA0] + (size_t)l * 1024};
            pg8::gemm_phase(F.lds, g, S, E, F.tid);  } SEAM(pb + 3); }
        if (PON(4) && IN(pb + 4)) { const Frame F = phase_frame(F0); REPEAT(4) {  attn_phase(F, l, LAST ? 512 : 520);  } SEAM(pb + 4); }
        if (PON(5) && IN(pb + 5)) { const Frame F = phase_frame(F0); REPEAT(5) {  scan_pass1(F, l);  } SEAM(pb + 5); }
        if (PON(6) && IN(pb + 6)) { const Frame F = phase_frame(F0); REPEAT(6) {  scan_pass2(F);  } SEAM(pb + 6); }
        if (PON(7) && IN(pb + 7)) { const Frame F = phase_frame(F0); REPEAT(7) {  scan_pass3(F, l);  } SEAM(pb + 7); }
        if (PON(8) && IN(pb + 8)) { const Frame F = phase_frame(F0); REPEAT(8) {  rwkv_out_rows(F, l, RB); norm_rows(F, xlat, F.in[I_N1G] + (size_t)l * DM, l, 0, 1, wsp<bf16_t>(F, OFF_XN2), RB);  } SEAM(pb + 8); }
        if (PON(9) && IN(pb + 9)) { const Frame F = phase_frame(F0); REPEAT(9) {  pg8::Gemm g{wsp<bf16_t>(F, OFF_XN2), wsp<bf16_t>(F, OFF_WIN) + (size_t)N_INP * DM, DM, nullptr, nullptr}; pg8::StaticOrder S; S.init(MROWS, N_GATE, F.G, F.bid, PM0); EpiGates E{wsp<bf16_t>(F, OFF_G)};
            pg8::gemm_phase(F.lds, g, S, E, F.tid);  } SEAM(pb + 9); }
        if (PON(10) && IN(pb + 10)) { const Frame F = phase_frame(F0); REPEAT(10) {
            pg8::Gemm g{wsp<bf16_t>(F, OFF_PDIFF), wsp<bf16_t>(F, OFF_WMG), 1536, wsp<bf16_t>(F, OFF_POOL), wsp<bf16_t>(F, OFF_YF)}; pg8::StaticOrder S; S.init(MROWS, DM, F.G, F.bid, PM0);
            EpiMerge E{wsp<bf16_t>(F, OFF_G), wsp<bf16_t>(F, OFF_MERGED)};
            pg8::gemm_phase(F.lds, g, S, E, F.tid); } SEAM(pb + 10); }
        if (PON(11) && IN(pb + 11)) { const Frame F = phase_frame(F0); REPEAT(11) {  pg8::Gemm g{wsp<bf16_t>(F, OFF_MERGED), wsp<bf16_t>(F, OFF_WOUT), DM, nullptr, nullptr}; pg8::StaticOrder S; S.init(MROWS, DM, F.G, F.bid, PM0); EpiResid E{xlat, F.out, wsp<float>(F, OFF_CTX), modl};
            pg8::gemm_phase(F.lds, g, S, E, F.tid);  } SEAM(pb + 11); }
#if EN_MOE
        if (PON(12) && IN(pb + 12)) { const Frame F = phase_frame(F0); REPEAT(12) {  conv_router_weights(F, l); norm_rows(F, F.out, F.in[I_N2G] + (size_t)l * DM, l, 3, 4, wsp<bf16_t>(F, OFF_XN), RB);  } SEAM(pb + 12); }
        if (PON(13) && IN(pb + 13)) { const Frame F = phase_frame(F0); REPEAT(13) {  pg8::Gemm g{wsp<bf16_t>(F, OFF_XN), wsp<bf16_t>(F, OFF_WRT), DM, nullptr, nullptr}; pg8::StaticOrder S; S.init(MROWS, 256, F.G, F.bid, PM0); EpiLogits E{wsp<float>(F, OFF_LOGITS)};
            pg8::gemm_phase(F.lds, g, S, E, F.tid);  } SEAM(pb + 13); }
        if (PON(14) && IN(pb + 14)) { const Frame F = phase_frame(F0); REPEAT(14) {  route_phase(F, l, RB);  } SEAM(pb + 14); }
        if (PON(15) && IN(pb + 15)) { const Frame F = phase_frame(F0); REPEAT(15) {  assign_gather_phase(F, l, RB); __syncthreads(); conv_expert_weights(F, l);  } SEAM(pb + 15); }
        if (PON(16) && IN(pb + 16)) { const Frame F = phase_frame(F0); REPEAT(16) {  LAS int* tab = (LAS int*)(F.lds + MISC_OFF + 64); build_tab(F, l, tab);
            pg8::Gemm g{wsp<bf16_t>(F, OFF_XN), wsp<bf16_t>(F, OFF_WE1), DM, nullptr, nullptr}; pg8::MoeOrder<true> S{tab, 4, F.G, F.bid, wsp<int>(F, OFF_SLOTTOK)}; EpiAct E{wsp<bf16_t>(F, OFF_ACT)};
            pg8::gemm_phase(F.lds, g, S, E, F.tid);  } SEAM(pb + 16); }
        if (PON(17) && IN(pb + 17)) { const Frame F = phase_frame(F0); REPEAT(17) {  LAS int* tab = (LAS int*)(F.lds + MISC_OFF + 64); build_tab(F, l, tab);
            pg8::Gemm g{wsp<bf16_t>(F, OFF_ACT), wsp<bf16_t>(F, OFF_WE2), FF, nullptr, nullptr}; pg8::MoeOrder<false> S{tab, 4, F.G, F.bid, nullptr}; EpiY E{wsp<bf16_t>(F, OFF_YBUF)};
            pg8::gemm_phase(F.lds, g, S, E, F.tid);  } SEAM(pb + 17); }
        if (PON(18) && IN(pb + 18)) { const Frame F = phase_frame(F0); REPEAT(18) {  if constexpr (!LAST) { conv_small_weights(F, l + 1); combine_rows<true>(F, l, RB, F.in[I_N1G] + (size_t)(l + 1) * DM, wsp<bf16_t>(F, OFF_XN)); } else combine_rows<false>(F, l, RB, nullptr, nullptr);  } SEAM(pb + 18); }
#endif
}
__global__ void __launch_bounds__(512, 2) fwd(Args args) {
    extern __shared__ __attribute__((aligned(16))) unsigned char lds_raw[];
    Frame F0; F0.in = (kain_t)__builtin_amdgcn_kernarg_segment_ptr(); F0.out = args.out; F0.ws = args.ws; F0.lds = (LAS unsigned char*)lds_raw;
    F0.tid = threadIdx.x; F0.lane = F0.tid & 63; F0.wid = __builtin_amdgcn_readfirstlane(F0.tid >> 6); F0.G = gridDim.x; F0.bid = blockIdx.x;
    volatile LAS unsigned* MISC = (volatile LAS unsigned*)(F0.lds + MISC_OFF);
    if (F0.tid < 4) MISC[F0.tid] = 0u;
    __syncthreads();
#if MK_ONE_LAUNCH
    const XcdBarrier bar = xcd_barrier_post((unsigned*)(F0.ws + OFF_CTL) + CW_BAR, MISC);
#else
    const int bar = 0;
#endif
    const int lo = args.ph_lo, hi = args.ph_hi;
    if (PON(31) && IN(0)) { const Frame F = phase_frame(F0); p0_prologue(F); SEAM(0); }
    layer_phases<0>(F0, lo, hi, bar);
#if EN_LAYERS > 1
    layer_phases<1>(F0, lo, hi, bar);
#endif
}

extern "C" void kernel_launch(void* const* d_in, const int* in_sizes, int n_in, void* d_out, int out_size, void* d_ws, size_t ws_size, hipStream_t stream) {
    static int grid = 0;
    if (grid == 0) {
        if (n_in != 33 || out_size != NB * SEQ * DM || ws_size < WS_END) { fprintf(stderr, "kernel_launch: unexpected shapes (n_in %d out %d ws %zu need %zu)\n", n_in, out_size, ws_size, (size_t)WS_END); grid = -1; return; }
        int dev = 0, cus = 0, per_cu = 0;
        if (hipGetDevice(&dev) != hipSuccess || hipDeviceGetAttribute(&cus, hipDeviceAttributeMultiprocessorCount, dev) != hipSuccess) { grid = -1; return; }
        if (hipFuncSetAttribute((const void*)fwd, hipFuncAttributeMaxDynamicSharedMemorySize, LDS_BYTES) != hipSuccess) { fprintf(stderr, "kernel_launch: hipFuncSetAttribute failed\n"); grid = -1; return; }
        if (hipOccupancyMaxActiveBlocksPerMultiprocessor(&per_cu, (const void*)fwd, 512, LDS_BYTES) != hipSuccess || per_cu < 1) { fprintf(stderr, "kernel_launch: occupancy query says %d\n", per_cu); }
        (void)hipGetLastError();
        grid = cus;
    }
    if (grid < 0) return;
    (void)hipMemsetAsync((char*)d_ws + OFF_CTL, 0, 65536, stream);
    Args a{};
    for (int i = 0; i < 33; ++i) a.in[i] = (const float*)d_in[i];
    a.out = (float*)d_out; a.ws = (unsigned char*)d_ws;
#if MK_ONE_LAUNCH
    a.ph_lo = 0; a.ph_hi = N_PHASES;
    hipLaunchKernelGGL(fwd, dim3(grid), dim3(512), LDS_BYTES, stream, a);
#else
    for (int p = 0; p < N_PHASES; ++p) {
        if (p >= 1 + EN_LAYERS * PH_PER_LAYER) break;
#if !EN_MOE
        if (p >= 1 && ((p - 1) % PH_PER_LAYER) >= 12) continue;
#endif
        a.ph_lo = p; a.ph_hi = p + 1;
        hipLaunchKernelGGL(fwd, dim3(grid), dim3(512), LDS_BYTES, stream, a);
    }
#endif
}
```

```cpp
#include <hip/hip_runtime.h>
#include <stdint.h>
#include <stdio.h>
#include <stddef.h>
#include <utility>

#ifndef MK_ONE_LAUNCH
#define MK_ONE_LAUNCH 1
#endif
#ifndef EN_MOE
#define EN_MOE 1
#endif
#ifndef EN_LAYERS
#define EN_LAYERS 2
#endif

#define LAS __attribute__((address_space(3)))
#define DI __device__ __forceinline__
typedef unsigned short bf16_t;
typedef short bf16x8 __attribute__((ext_vector_type(8)));
typedef float f32x4 __attribute__((ext_vector_type(4)));
typedef float f32x2 __attribute__((ext_vector_type(2)));
typedef float f32x16 __attribute__((ext_vector_type(16)));
typedef unsigned u32x4 __attribute__((ext_vector_type(4)));
typedef unsigned u32x2 __attribute__((ext_vector_type(2)));
typedef __bf16 bfv2 __attribute__((ext_vector_type(2)));

constexpr int DM = 1024, NB = 2, SEQ = 16384, CTXL = 256, NCTX = NB * CTXL  , MROWS = NCTX + NB * SEQ  ;
constexpr int NPAN = MROWS / 256;
constexpr int IN_W = 7040, N_INP = 4096  , N_GATE = 3072, N_INT = N_INP + N_GATE  ;
constexpr int RW_IN = 1920, LORA_K = 384, LORA_N = 2560;
constexpr int NEXP = 32, FF = 512;
constexpr int PMAX = 74752;
constexpr int KEYS = CTXL + SEQ;
constexpr size_t U_EL = (size_t)MROWS * 512;
constexpr size_t U_B = U_EL * 2;
constexpr size_t OFF_CTL = 0, OFF_MOD = 65536, OFF_CTX = 327680, OFF_WIN = 2424832, OFF_WMG = 17104896, OFF_WOUT = 20250624, OFF_WLORA = 22347776, OFF_WRT = 24313856;
constexpr size_t R1 = 25165824, R2 = R1 + 4 * U_B, R3 = R2 + 5 * U_B, R4 = R3 + 4 * U_B, R6 = R4 + 2 * U_B, RVT = R6 + 2 * U_B, WS_END = RVT + U_B;
constexpr size_t OFF_POOL = R1, OFF_Q = R1 + U_B, OFF_K = R1 + 2 * U_B, OFF_V = R1 + 3 * U_B;
constexpr size_t OFF_RWRAW = R2, OFF_EF = R2, OFF_EB = R2 + U_B, OFF_AF = R2 + 2 * U_B, OFF_AB = R2 + 3 * U_B, OFF_GG = R2 + 4 * U_B;
constexpr size_t OFF_RR = R3, OFF_RK = R3 + U_B, OFF_RV = R3 + 2 * U_B, OFF_RKK = R3 + 3 * U_B;
constexpr size_t OFF_YF = R4, OFF_YB = R4 + U_B;
constexpr size_t OFF_MP = R1 + U_B;
constexpr size_t OFF_NS = R6 + U_B;
constexpr int NCHUNK = KEYS / 64;
constexpr size_t OFF_PDIFF = R6, OFF_ALORA = R6 + U_B, OFF_XN = R6;
constexpr size_t OFF_XN2 = R1 + 2 * U_B;
constexpr size_t OFF_G = R2;
constexpr size_t OFF_MERGED = R3 + U_B;
constexpr size_t OFF_WE1 = R3, OFF_WE2 = R3 + (size_t)NEXP * 1024 * 1024 * 2;
constexpr size_t OFF_XB = R1, OFF_ACT = R1 + (size_t)PMAX * 2048, OFF_YBUF = R1;
constexpr size_t OFF_LOGITS = R4, OFF_ROUTE = R4 + (size_t)MROWS * 64 * 4, OFF_SLOTTOK = OFF_ROUTE + (size_t)MROWS * 32;
constexpr int CW_BAR = 0, CW_CNT = 4096, CW_CUR = 4096 + 64, CW_DYN = 4096 + 128, CW_END = 4096 + 130;
constexpr int LDS_BYTES = 151552, MISC_OFF = 147456;

DI int launder(int x) { asm volatile("" : "+v"(x)); return x; }
DI int lane_id() { return (int)__builtin_amdgcn_mbcnt_hi(~0u, __builtin_amdgcn_mbcnt_lo(~0u, 0u)); }
DI float bf2f(bf16_t v) { return __uint_as_float(((unsigned)v) << 16); }
DI unsigned pk2(float lo, float hi) { f32x2 v = {lo, hi}; bfv2 r = __builtin_convertvector(v, bfv2); return __builtin_bit_cast(unsigned, r); }
DI bf16_t f2bf(float f) { return (bf16_t)(pk2(f, 0.f) & 0xffffu); }
DI float lo_f(unsigned w) { return __uint_as_float(w << 16); }
DI float hi_f(unsigned w) { return __uint_as_float(w & 0xffff0000u); }
DI void unpack8(const u32x4 w, float (&f)[8]) { f[0] = lo_f(w.x); f[1] = hi_f(w.x); f[2] = lo_f(w.y); f[3] = hi_f(w.y); f[4] = lo_f(w.z); f[5] = hi_f(w.z); f[6] = lo_f(w.w); f[7] = hi_f(w.w); }
DI u32x4 pack8(const float (&f)[8]) { u32x4 w; w.x = pk2(f[0], f[1]); w.y = pk2(f[2], f[3]); w.z = pk2(f[4], f[5]); w.w = pk2(f[6], f[7]); return w; }
DI float sigmoidf_(float x) { return __builtin_amdgcn_rcpf(1.0f + __expf(-x)); }
DI float wave_sum(float v) { v += __shfl_xor(v, 1); v += __shfl_xor(v, 2); v += __shfl_xor(v, 4); v += __shfl_xor(v, 8); v += __shfl_xor(v, 16); v += __shfl_xor(v, 32); return v; }
DI float sum8(float v) { v += __shfl_xor(v, 1); v += __shfl_xor(v, 2); v += __shfl_xor(v, 4); return v; }
template <int CTRL> DI float dppf(float v) { return __builtin_bit_cast(float, __builtin_amdgcn_update_dpp(0, __builtin_bit_cast(int, v), CTRL, 0xf, 0xf, true)); }
DI float allsum16(float v) { v += dppf<0xB1>(v); v += dppf<0x4E>(v); v += dppf<0x141>(v); v += dppf<0x140>(v); return v; }

#define XB_TMO      128
#define XB_XCNT(j)  (256  + 64 * (j))
#define XB_XSUB(j)  (1280 + 64 * (j))
#define XB_XGEN(j)  (2304 + 64 * (j))
#define XB_TOP      3328
#define XB_TOPGEN   3392
#define XCD_BAR_WORDS 3456
#define XB_SPIN_CAP (1u << 22)
DI unsigned xb_ld(unsigned* p)              { return __hip_atomic_load(p, __ATOMIC_RELAXED, __HIP_MEMORY_SCOPE_AGENT); }
DI unsigned xb_add(unsigned* p, unsigned v) { return __hip_atomic_fetch_add(p, v, __ATOMIC_RELAXED, __HIP_MEMORY_SCOPE_AGENT); }
DI unsigned xb_xcc_id() { return (unsigned)__builtin_amdgcn_s_getreg((3 << 11) | 20) & 0xFu; }
#define XB_SPIN(cond, bar) do { unsigned _sp = 0; while (cond) { __builtin_amdgcn_s_sleep(1); \
    if ((++_sp & 255u) == 0u) { if (xb_ld(&(bar)[XB_TMO])) break; if (_sp > XB_SPIN_CAP) { atomicAdd(&(bar)[XB_TMO], 1u); break; } } } } while (0)
struct XcdBarrier { unsigned* bar; unsigned x; volatile LAS unsigned* st; bool t0; };
DI XcdBarrier xcd_barrier_post(unsigned* bar, volatile LAS unsigned* st) {
    XcdBarrier b; b.bar = bar; b.x = xb_xcc_id(); b.st = st; b.t0 = threadIdx.x == 0;
    if (b.t0) (void)xb_add(&bar[XB_XCNT(b.x)], 1u);
    return b;
}
DI void xcd_barrier_complete(unsigned* bar, unsigned x, unsigned& nloc, unsigned& nx) {
    const unsigned G = gridDim.x * gridDim.y * gridDim.z;
    unsigned sum, cnt, mine, sp = 0u;
    for (;;) {
        sum = 0u; cnt = 0u; mine = 0u;
#pragma unroll
        for (unsigned j = 0; j < 16; ++j) { const unsigned c = xb_ld(&bar[XB_XCNT(j)]); sum += c; cnt += (c > 0u) ? 1u : 0u; mine = (j == x) ? c : mine; }
        if (sum == G) break;
        __builtin_amdgcn_s_sleep(1);
        if ((++sp & 255u) == 0u) { if (xb_ld(&bar[XB_TMO])) break; if (sp > XB_SPIN_CAP) { atomicAdd(&bar[XB_TMO], 1u); break; } }
    }
    nloc = mine > 0u ? mine : 1u; nx = cnt > 0u ? cnt : 1u;
}
DI void xcd_barrier(const XcdBarrier& b) {
    asm volatile("s_waitcnt vmcnt(0)" ::: "memory");
    __syncthreads();
    if (b.t0) {
        unsigned* bar = b.bar;
        __builtin_amdgcn_s_waitcnt(0);
        unsigned nloc = b.st[0], nx = b.st[1];
        if (nloc == 0u) { xcd_barrier_complete(bar, b.x, nloc, nx); b.st[0] = nloc; b.st[1] = nx; }
        const unsigned old = xb_add(&bar[XB_XSUB(b.x)], 1u);
        const unsigned gen = old / nloc;
        if (old + 1u == (gen + 1u) * nloc) {
            __builtin_amdgcn_fence(__ATOMIC_RELEASE, "agent");
            asm volatile("s_waitcnt vmcnt(0)" ::: "memory");
            const unsigned og = xb_add(&bar[XB_TOP], 1u);
            const unsigned tg = og / nx;
            if (og + 1u == (tg + 1u) * nx) xb_add(&bar[XB_TOPGEN], 1u);
            else XB_SPIN(xb_ld(&bar[XB_TOPGEN]) == tg, bar);
            __builtin_amdgcn_fence(__ATOMIC_ACQUIRE, "agent");
            xb_add(&bar[XB_XGEN(b.x)], 1u);
            asm volatile("s_waitcnt vmcnt(0)" ::: "memory");
        } else {
            XB_SPIN(xb_ld(&bar[XB_XGEN(b.x)]) == gen, bar);
            __builtin_amdgcn_fence(__ATOMIC_ACQUIRE, "agent");
            asm volatile("s_waitcnt vmcnt(0)" ::: "memory");
        }
    }
    __syncthreads();
}

namespace pg8 {
constexpr int BM = 256, BK = 64, HALF = 128, HTB = HALF * BK * 2, STAGE_BYTES = 8 * HTB, NXCD = 8, WGM = 8;
DI int lds_byte(int r, int c) { const int st = (r >> 4) * 2 + (c >> 5), rr = r & 15, cc = c & 31, ob = rr * 64 + cc * 2; return st * 1024 + (ob ^ (((ob >> 9) & 1) << 5)); }
DI void stage_rc(int b, int& R, int& C) { const int st = b / 1024, sb = b % 1024, swz = sb ^ (((sb >> 9) & 1) << 5); R = (st >> 1) * 16 + swz / 64; C = (st & 1) * 32 + (swz % 64) / 2; }
DI int perm32(int rho) { const int n = rho >> 4, i = rho & 15; return 8 * (i >> 2) + 4 * n + (i & 3); }
struct Unit { int pm, pn, pb; };
struct Gemm { const bf16_t* A; const bf16_t* Bt; int K; const bf16_t* A1; const bf16_t* A2; };
struct StaticOrder {
    static constexpr bool GATHER = false;
    int nM, nN, nwg, G, c, pm0;
    DI void init(int M, int N, int G_, int c_, int pm0_ = 0) { pm0 = pm0_; nM = M / BM - pm0_; nN = N / BM; nwg = nM * nN; G = G_; c = c_; }
    DI bool next(int i, Unit& u) const {
        const long L = (long)i * G + c; if (L >= nwg) return false;
        int wgid = (int)L; { const int q = nwg / NXCD, r = nwg % NXCD, xcd = wgid % NXCD, off = wgid / NXCD; wgid = (xcd < r ? xcd * (q + 1) : r * (q + 1) + (xcd - r) * q) + off; }
        const int nig = WGM * nN, gid = wgid / nig, fm = gid * WGM, gsz = (nM - fm) < WGM ? (nM - fm) : WGM;
        u.pm = pm0 + fm + ((wgid % nig) % gsz); u.pn = (wgid % nig) / gsz; u.pb = u.pn; return true;
    }
};
template <bool GATHER_> struct MoeOrder {
    static constexpr bool GATHER = GATHER_;
    const LAS int* tab; int NT, G, c; const int* slot_tok;
    DI bool next(int i, Unit& u) const {
        int L = i * G + c; const int np = tab[32], nwg = np * NT; if (L >= nwg) return false;
        { const int q = nwg / NXCD, r = nwg % NXCD, xcd = L % NXCD, off = L / NXCD; L = (xcd < r ? xcd * (q + 1) : r * (q + 1) + (xcd - r) * q) + off; }
        const int p = L / NT, pn = L % NT; int e = 0;
#pragma unroll 1
        for (int j = 1; j < 32; ++j) e = (tab[j] <= p) ? j : e;
        u.pm = p; u.pn = pn; u.pb = e * NT + pn; return true;
    }
};

template <class Epi, class Sched>
DI void gemm_phase(LAS unsigned char* lds, const Gemm g, const Sched& S, const Epi& E, int tid_) {
    const int tid = launder(tid_), wid = __builtin_amdgcn_readfirstlane(tid >> 6), lane = tid & 63, wr = wid >> 2, wc = wid & 3, fr = lane & 15, fq = lane >> 4;
    const int K = g.K, nt = K / BK, lda = Epi::SEG ? 512 : K;
    unsigned voffA[2], voffB[2];
#pragma unroll
    for (int i = 0; i < 2; ++i) { int R, C; stage_rc(tid * 16 + i * 8192, R, C); const int Rb = Epi::PERM ? ((R & ~31) + perm32(R & 31)) : R;
        voffA[i] = (unsigned)(R * lda + C) * 2u; voffB[i] = (unsigned)(Rb * K + C) * 2u; }
    const size_t kstep = (size_t)(BK * 2);
    const size_t hstep = (size_t)HALF * K * 2;
    const size_t tstep = 2 * hstep;
    const size_t hstepA = (size_t)HALF * lda * 2, tstepA = 2 * hstepA;
    constexpr bool GA = Sched::GATHER;
    unsigned cv[2][2], nv[2][2]; int gR[2], gC[2];
#pragma unroll
    for (int i = 0; i < 2; ++i) { stage_rc(tid * 16 + i * 8192, gR[i], gC[i]); cv[0][i] = cv[1][i] = nv[0][i] = nv[1][i] = 0u; }
#define PG8_GVOFF(v, pm_) do { _Pragma("unroll") for (int h_ = 0; h_ < 2; ++h_) _Pragma("unroll") for (int i_ = 0; i_ < 2; ++i_) \
        (v)[h_][i_] = ((unsigned)S.slot_tok[(pm_) * 256 + h_ * 128 + gR[i_]] * (unsigned)lda + (unsigned)gC[i_]) * 2u; } while (0)
#define PG8_ATILE(ub, t) (Epi::SEG ? (const char*)((t) < 8 ? g.A : ((t) < 16 ? g.A1 : g.A2)) + (ub) + (size_t)((t) & 7) * kstep : (const char*)g.A + (ub) + (size_t)(t) * kstep)
    const unsigned ldsw = (unsigned)wid * 1024u;
    const int aoff = lds_byte(wr * 64 + fr, fq * 8), boff = lds_byte(wc * 32 + fr, fq * 8);
#define PG8_SA(b, h) (((b) * 2 + (h)) * HTB)
#define PG8_SB(b, h) ((4 + (b) * 2 + (h)) * HTB)
#define PG8_STAGE(bufoff, gbase, voff) do { _Pragma("unroll") for (int _i = 0; _i < 2; ++_i) \
        __builtin_amdgcn_global_load_lds((const unsigned*)((const char*)(gbase) + (voff)[_i]), (LAS unsigned*)(lds + (bufoff) + ldsw + _i * 8192), 16, 0, 0); } while (0)
#define PG8_LDA(dst, b, h) do { _Pragma("unroll") for (int m = 0; m < 4; ++m) _Pragma("unroll") for (int k = 0; k < 2; ++k) dst[m][k] = *(const LAS bf16x8*)(lds + PG8_SA(b, h) + aoff + m * 2048 + k * 1024); } while (0)
#define PG8_LDB(dst, b, h) do { _Pragma("unroll") for (int n = 0; n < 2; ++n) _Pragma("unroll") for (int k = 0; k < 2; ++k) dst[n][k] = *(const LAS bf16x8*)(lds + PG8_SB(b, h) + boff + n * 2048 + k * 1024); } while (0)
#define PG8_MMA(ai, bj, At, Bt) do { __builtin_amdgcn_s_setprio(1); _Pragma("unroll") for (int m = 0; m < 4; ++m) _Pragma("unroll") for (int n = 0; n < 2; ++n) _Pragma("unroll") for (int k = 0; k < 2; ++k) \
        acc[ai][bj][m][n] = __builtin_amdgcn_mfma_f32_16x16x32_bf16(Bt[n][k], At[m][k], acc[ai][bj][m][n], 0, 0, 0); __builtin_amdgcn_s_setprio(0); } while (0)
#define PG8_WAIT_V(n) asm volatile("s_waitcnt vmcnt(" #n ")" ::: "memory")
#define PG8_WAIT_L(n) asm volatile("s_waitcnt lgkmcnt(" #n ")" ::: "memory")
#define PG8_BAR __builtin_amdgcn_s_barrier()
#define PG8_SCHED __builtin_amdgcn_sched_barrier(0)
    Unit cur, nxt; int ui = 0;
    if (!S.next(0, cur)) return;
    f32x4 acc[2][2][4][2];
#pragma unroll
    for (int a = 0; a < 2; ++a)
#pragma unroll
        for (int b = 0; b < 2; ++b)
#pragma unroll
            for (int m = 0; m < 4; ++m)
#pragma unroll
                for (int n = 0; n < 2; ++n) acc[a][b][m][n] = (f32x4){0.f, 0.f, 0.f, 0.f};
    bf16x8 At[4][2], B0[2][2], B1[2][2];
    size_t ubA = (size_t)cur.pm * tstepA; const char* cA = PG8_ATILE(ubA, 0); const char* cB = (const char*)g.Bt + (size_t)cur.pb * tstep;
    const char* const gA = (const char*)g.A;
    if constexpr (GA) { PG8_GVOFF(cv, cur.pm); }
    PG8_STAGE(PG8_SB(0, 0), cB, voffB);
    if constexpr (GA) PG8_STAGE(PG8_SA(0, 0), gA, cv[0]); else PG8_STAGE(PG8_SA(0, 0), cA, voffA);
    PG8_STAGE(PG8_SB(0, 1), cB + hstep, voffB);
    if constexpr (GA) PG8_STAGE(PG8_SA(0, 1), gA, cv[1]); else PG8_STAGE(PG8_SA(0, 1), cA + hstepA, voffA);
    if (wr == 1) PG8_BAR;
    PG8_WAIT_V(4); PG8_BAR;
    PG8_STAGE(PG8_SB(1, 0), cB + kstep, voffB);
    if constexpr (GA) PG8_STAGE(PG8_SA(1, 0), gA + kstep, cv[0]); else PG8_STAGE(PG8_SA(1, 0), cA + kstep, voffA);
    PG8_STAGE(PG8_SB(1, 1), cB + hstep + kstep, voffB);
    PG8_WAIT_V(6); PG8_BAR;
    for (;;) {
        const bool has_next = S.next(ui + 1, nxt);
        const size_t nubA = has_next ? (size_t)nxt.pm * tstepA : ubA;
        const char* nA = PG8_ATILE(nubA, 0); const char* nB = has_next ? (const char*)g.Bt + (size_t)nxt.pb * tstep : cB;
        if constexpr (GA) { if (has_next) { PG8_GVOFF(nv, nxt.pm); } else {
#pragma unroll
            for (int h_ = 0; h_ < 2; ++h_) { nv[h_][0] = cv[h_][0]; nv[h_][1] = cv[h_][1]; } } }
        for (int t = 0; t < nt; t += 2) {
            const bool last = (t == nt - 2);
            const char* a1 = PG8_ATILE(ubA, t + 1);
            const char* a2 = last ? nA : PG8_ATILE(ubA, t + 2); const char* b2 = last ? nB : cB + (size_t)(t + 2) * kstep;
            const char* a3 = a2 + kstep; const char* b3 = b2 + kstep;
            const char* gk2 = gA + (last ? (size_t)0 : (size_t)(t + 2) * kstep);
            unsigned s0[2] = {last ? nv[0][0] : cv[0][0], last ? nv[0][1] : cv[0][1]}, s1[2] = {last ? nv[1][0] : cv[1][0], last ? nv[1][1] : cv[1][1]};
            PG8_LDB(B0, 0, 0); PG8_SCHED; PG8_LDA(At, 0, 0);
            if constexpr (GA) PG8_STAGE(PG8_SA(1, 1), gA + (size_t)(t + 1) * kstep, cv[1]); else PG8_STAGE(PG8_SA(1, 1), a1 + hstepA, voffA);
            PG8_WAIT_L(8); PG8_BAR; PG8_WAIT_L(0); PG8_MMA(0, 0, At, B0); PG8_BAR; PG8_SCHED;
            PG8_LDB(B1, 0, 1); PG8_STAGE(PG8_SB(0, 0), b2, voffB);
            PG8_BAR; PG8_WAIT_L(0); PG8_MMA(0, 1, At, B1); PG8_BAR;
            PG8_LDA(At, 0, 1); if constexpr (GA) PG8_STAGE(PG8_SA(0, 0), gk2, s0); else PG8_STAGE(PG8_SA(0, 0), a2, voffA);
            PG8_BAR; PG8_WAIT_L(0); PG8_MMA(1, 0, At, B0); PG8_BAR; PG8_SCHED;
            PG8_STAGE(PG8_SB(0, 1), b2 + hstep, voffB);
            PG8_WAIT_V(6); PG8_BAR; PG8_MMA(1, 1, At, B1); PG8_BAR;
            PG8_LDB(B0, 1, 0); PG8_SCHED; PG8_LDA(At, 1, 0); if constexpr (GA) PG8_STAGE(PG8_SA(0, 1), gk2, s1); else PG8_STAGE(PG8_SA(0, 1), a2 + hstepA, voffA);
            PG8_WAIT_L(8); PG8_BAR; PG8_WAIT_L(0); PG8_MMA(0, 0, At, B0); PG8_BAR; PG8_SCHED;
            PG8_LDB(B1, 1, 1); PG8_STAGE(PG8_SB(1, 0), b3, voffB);
            PG8_BAR; PG8_WAIT_L(0); PG8_MMA(0, 1, At, B1); PG8_BAR;
            PG8_LDA(At, 1, 1); if constexpr (GA) PG8_STAGE(PG8_SA(1, 0), gk2 + kstep, s0); else PG8_STAGE(PG8_SA(1, 0), a3, voffA);
            PG8_BAR; PG8_WAIT_L(0); PG8_MMA(1, 0, At, B0); PG8_BAR; PG8_SCHED;
            PG8_STAGE(PG8_SB(1, 1), b3 + hstep, voffB);
            PG8_WAIT_V(6); PG8_BAR; PG8_MMA(1, 1, At, B1); PG8_BAR;
            if constexpr (Epi::SEG) { if (((t + 2) & 7) == 0 && !last) E.mid(acc, cur, (t + 2) >> 3, wr, wc, fr, fq); }
        }
        E(acc, cur, wr, wc, fr, fq);
        if (!has_next) break;
#pragma unroll
        for (int a = 0; a < 2; ++a)
#pragma unroll
            for (int b = 0; b < 2; ++b)
#pragma unroll
                for (int m = 0; m < 4; ++m)
#pragma unroll
                    for (int n = 0; n < 2; ++n) acc[a][b][m][n] = (f32x4){0.f, 0.f, 0.f, 0.f};
        cur = nxt; cA = nA; cB = nB; ubA = nubA; ++ui;
        if constexpr (GA) {
#pragma unroll
            for (int h_ = 0; h_ < 2; ++h_) { cv[h_][0] = nv[h_][0]; cv[h_][1] = nv[h_][1]; } }
    }
    PG8_WAIT_V(0);
    if (wr == 0) PG8_BAR;
    PG8_BAR;
#undef PG8_ATILE
#undef PG8_GVOFF
#undef PG8_SA
#undef PG8_SB
#undef PG8_STAGE
#undef PG8_LDA
#undef PG8_LDB
#undef PG8_MMA
#undef PG8_WAIT_V
#undef PG8_WAIT_L
#undef PG8_BAR
#undef PG8_SCHED
}
}

struct Args { const float* in[33]; float* out; unsigned char* ws; int ph_lo, ph_hi; };
static_assert(offsetof(Args, out) == 264 && offsetof(Args, ws) == 272, "kernarg layout");
typedef const float* cfptr_t;
typedef __attribute__((address_space(4))) const cfptr_t* kain_t;
typedef __attribute__((address_space(4))) const unsigned char* kab_t;
struct Frame {
    kain_t in; float* out; unsigned char* ws; LAS unsigned char* lds;
    int tid, lane, wid, G, bid;
};
enum { I_X = 0, I_C, I_CTX, I_CCTX, I_WADA, I_BADA, I_N1G, I_N2G, I_WIN, I_POOLW, I_POOLS, I_QNG, I_KNG, I_LAMQK, I_SUBLN, I_SHMU, I_DW0, I_DW2, I_AA0, I_AA2, I_GW2, I_KK, I_KA, I_RK, I_GNW, I_GNB,
       I_WBR, I_WOUT, I_WRG, I_WRE, I_WEG, I_WEU, I_WED };
template <class T> DI T* wsp(const Frame& F, size_t off) { return (T*)(F.ws + off); }
DI const float* xrow_ptr(const Frame& F, const float* xlat, int r) { return r < NCTX ? wsp<const float>(F, OFF_CTX) + (size_t)r * DM : xlat + (size_t)(r - NCTX) * DM; }
DI Frame phase_frame(const Frame& F0) { Frame F = F0; F.lane = launder(lane_id()); F.wid = F0.wid; F.tid = (F.wid << 6) | F.lane;
    kab_t ka = (kab_t)__builtin_amdgcn_kernarg_segment_ptr(); asm volatile("" : "+s"(ka));
    F.in = (kain_t)ka; F.out = *(float* const __attribute__((address_space(4)))*)(ka + 264); F.ws = *(unsigned char* const __attribute__((address_space(4)))*)(ka + 272); return F; }
DI int row_cond(int r) { return r < NCTX ? 2 : (r - NCTX) / SEQ; }
DI const float* modp(const Frame& F, int l, int cond, int j) { return wsp<const float>(F, OFF_MOD) + ((size_t)(l * 3 + cond) * 6 + j) * DM; }

DI void convT_tile(const Frame& F, const float* src, int src_ld, int k0, int n0, bf16_t* dst, int dst_ld, int drow0) {
    LAS float* tile = (LAS float*)F.lds;
    const int t = F.tid;
    { const int k = t >> 3, n8 = (t & 7) * 8; const float* p = src + (size_t)(k0 + k) * src_ld + n0 + n8;
      const f32x4 a = *(const f32x4*)p, b = *(const f32x4*)(p + 4);
      LAS float* q = tile + k * 65 + n8; q[0] = a[0]; q[1] = a[1]; q[2] = a[2]; q[3] = a[3]; q[4] = b[0]; q[5] = b[1]; q[6] = b[2]; q[7] = b[3]; }
    __syncthreads();
    { const int n = t >> 3, k8 = (t & 7) * 8; float f[8];
#pragma unroll
      for (int j = 0; j < 8; ++j) f[j] = tile[(k8 + j) * 65 + n];
      *(u32x4*)(dst + (size_t)(drow0 + n) * dst_ld + k0 + k8) = pack8(f); }
    __syncthreads();
}
DI void convT(const Frame& F, const float* src, int src_ld, int K, int n_lo, int n_hi, bf16_t* dst, int dst_ld, int drow_base, int rot) {
    const int tk = K / 64, tn = (n_hi - n_lo) / 64, ntile = tk * tn;
    for (int t = (F.bid + rot) % F.G; t < ntile; t += F.G) { const int kt = t % tk, nt_ = t / tk; convT_tile(F, src, src_ld, kt * 64, n_lo + nt_ * 64, dst, dst_ld, drow_base + nt_ * 64); }
}

DI void conv_small_weights(const Frame& F, int l) {
    const int gt = F.bid * 512 + F.tid, gn = F.G * 512;
    bf16_t* win = wsp<bf16_t>(F, OFF_WIN);
    const float* w_in = F.in[I_WIN] + (size_t)l * DM * IN_W;
    convT(F, w_in, IN_W, DM, 0, 3968, win, DM, 0, 0);
    convT(F, w_in, IN_W, DM, 3968, IN_W, win, DM, 4096, 64);
    for (int i = gt; i < 128 * DM / 8; i += gn) *(u32x4*)(win + (size_t)3968 * DM + (size_t)i * 8) = (u32x4){0u, 0u, 0u, 0u};
    bf16_t* wmg = wsp<bf16_t>(F, OFF_WMG);
    const float* w_br = F.in[I_WBR] + (size_t)l * 3 * 512 * DM;
    convT(F, w_br + (size_t)1 * 512 * DM, DM, 512, 0, DM, wmg + 512, 1536, 0, 128);
    convT(F, w_br + (size_t)2 * 512 * DM, DM, 512, 0, DM, wmg + 1024, 1536, 0, 192);
    {
        const float* pw = F.in[I_POOLW] + (size_t)l * 4 * 128 * 128; const float* ps = F.in[I_POOLS] + (size_t)l * 512;
        for (int i = gt; i < DM * 64; i += gn) {
            const int n = i & 1023, c8 = i >> 10, k0 = c8 * 8, g = k0 >> 7, c0 = k0 & 127; float acc[8];
#pragma unroll
            for (int j = 0; j < 8; ++j) acc[j] = 0.f;
            for (int d = 0; d < 128; ++d) { const float wb = ps[g * 128 + d] * w_br[(size_t)(g * 128 + d) * DM + n];
#pragma unroll
                for (int j = 0; j < 8; ++j) acc[j] += pw[(size_t)(g * 128 + c0 + j) * 128 + d] * wb; }
            *(u32x4*)(wmg + (size_t)n * 1536 + k0) = pack8(acc);
        }
    }
    convT(F, F.in[I_WOUT] + (size_t)l * DM * DM, DM, DM, 0, DM, wsp<bf16_t>(F, OFF_WOUT), DM, 0, 32);
    {
        bf16_t* wl = wsp<bf16_t>(F, OFF_WLORA);
        const float* dw2 = F.in[I_DW2] + (size_t)l * 2 * 64 * 512; const float* aa2 = F.in[I_AA2] + (size_t)l * 2 * 64 * 512; const float* gw2 = F.in[I_GW2] + (size_t)l * 128 * 512;
        for (int i = gt; i < LORA_N * (LORA_K / 8); i += gn) {
            const int n = i % LORA_N, k0 = (i / LORA_N) * 8, kind = n >> 9, c = n & 511; float f[8];
#pragma unroll
            for (int j = 0; j < 8; ++j) { const int k = k0 + j; float v = 0.f;
                if (kind < 2) { if (k >= kind * 64 && k < kind * 64 + 64) v = dw2[((size_t)kind * 64 + (k - kind * 64)) * 512 + c]; }
                else if (kind < 4) { const int d = kind - 2; if (k >= 128 + d * 64 && k < 192 + d * 64) v = aa2[((size_t)d * 64 + (k - 128 - d * 64)) * 512 + c]; }
                else { if (k >= 256) v = gw2[(size_t)(k - 256) * 512 + c]; }
                f[j] = v; }
            *(u32x4*)(wl + (size_t)n * LORA_K + k0) = pack8(f);
        }
    }
}
DI void conv_expert_weights(const Frame& F, int l) {
    const int gt = F.bid * 512 + F.tid, gn = F.G * 512;
    bf16_t* w1 = wsp<bf16_t>(F, OFF_WE1); bf16_t* w2 = wsp<bf16_t>(F, OFF_WE2);
    const float* wg = F.in[I_WEG] + (size_t)l * NEXP * DM * FF; const float* wu = F.in[I_WEU] + (size_t)l * NEXP * DM * FF; const float* wd = F.in[I_WED] + (size_t)l * NEXP * FF * DM;
    const int tt = F.tid, lk = tt >> 3, l8 = (tt & 7) * 8;
    const int NT = NEXP * 384;
#define EXP_TILE(t_, srcp_, dstp_) do { const int e_ = (t_) / 384, r_ = (t_) % 384; \
        if (r_ < 256) { const int up_ = r_ >> 7, q_ = r_ & 127, kt_ = q_ & 15, nt_ = q_ >> 4, ff0_ = nt_ * 64, drow_ = 256 * (ff0_ >> 7) + 128 * up_ + (ff0_ & 127); \
            srcp_ = (up_ ? wu : wg) + (size_t)e_ * DM * FF + (size_t)(kt_ * 64 + lk) * FF + ff0_ + l8; dstp_ = w1 + (size_t)e_ * 1024 * 1024 + (size_t)(drow_ + lk) * DM + kt_ * 64 + l8; } \
        else { const int q_ = r_ - 256, kt_ = q_ & 7, nt_ = q_ >> 3; \
            srcp_ = wd + (size_t)e_ * FF * DM + (size_t)(kt_ * 64 + lk) * DM + nt_ * 64 + l8; dstp_ = w2 + (size_t)e_ * 1024 * 512 + (size_t)(nt_ * 64 + lk) * FF + kt_ * 64 + l8; } } while (0)
    int* cursor = wsp<int>(F, OFF_CTL) + CW_DYN + l; LAS int* shb = (LAS int*)(F.lds + MISC_OFF + 3072);
    for (;;) {
        if (F.tid == 0) *shb = atomicAdd(cursor, 4);
        __syncthreads();
        const int base = *shb;
        if (base >= NT) break;
        f32x4 ra[4], rb[4]; bf16_t* dp[4];
#pragma unroll
        for (int s_ = 0; s_ < 4; ++s_) { const int t = base + s_; const float* sp; EXP_TILE(t, sp, dp[s_]); ra[s_] = *(const f32x4*)sp; rb[s_] = *(const f32x4*)(sp + 4); }
#pragma unroll
        for (int s_ = 0; s_ < 4; ++s_) { LAS float* q = (LAS float*)F.lds + s_ * (64 * 65) + lk * 65 + l8; const f32x4 a = ra[s_], b = rb[s_]; q[0] = a[0]; q[1] = a[1]; q[2] = a[2]; q[3] = a[3]; q[4] = b[0]; q[5] = b[1]; q[6] = b[2]; q[7] = b[3]; }
        __syncthreads();
#pragma unroll
        for (int s_ = 0; s_ < 4; ++s_) { const LAS float* tile = (const LAS float*)F.lds + s_ * (64 * 65); float f[8];
#pragma unroll
            for (int j = 0; j < 8; ++j) f[j] = tile[(l8 + j) * 65 + lk];
            *(u32x4*)dp[s_] = pack8(f); }
        __syncthreads();
    }
#undef EXP_TILE
}
DI void conv_router_weights(const Frame& F, int l) {
    const int gt = F.bid * 512 + F.tid, gn = F.G * 512;
    bf16_t* wr = wsp<bf16_t>(F, OFF_WRT);
    const float* wrg = F.in[I_WRG] + (size_t)l * DM * 4; const float* wre = F.in[I_WRE] + (size_t)l * DM * 32;
    for (int i = gt; i < 256 * (DM / 8); i += gn) { const int n = i & 255, k0 = (i >> 8) * 8; float f[8];
#pragma unroll
        for (int j = 0; j < 8; ++j) f[j] = n < 4 ? wrg[(size_t)(k0 + j) * 4 + n] : (n < 36 ? wre[(size_t)(k0 + j) * 32 + (n - 4)] : 0.f);
        *(u32x4*)(wr + (size_t)n * DM + k0) = pack8(f); }
}
DI void p0_prologue(const Frame& F) {
    LAS float* sl = (LAS float*)F.lds;
    LAS float* red = sl + 3 * DM;
    for (int i = F.tid; i < 3 * DM; i += 512) { const int cond = i >> 10, k = i & 1023; const float v = cond < 2 ? F.in[I_C][cond * DM + k] : F.in[I_CCTX][k]; sl[i] = v * sigmoidf_(v); }
    __syncthreads();
    for (int cg = F.bid; cg < 192; cg += F.G) {
        const int l = cg / 96, col = (cg % 96) * 64 + F.lane;
        const float* W = F.in[I_WADA] + (size_t)l * DM * 6144 + col;
        float s0 = 0.f, s1 = 0.f, s2 = 0.f;
        const int kb = F.wid * 128;
#pragma unroll 8
        for (int k = kb; k < kb + 128; ++k) { const float w = W[(size_t)k * 6144]; s0 += sl[k] * w; s1 += sl[DM + k] * w; s2 += sl[2 * DM + k] * w; }
        red[(F.wid * 3 + 0) * 64 + F.lane] = s0; red[(F.wid * 3 + 1) * 64 + F.lane] = s1; red[(F.wid * 3 + 2) * 64 + F.lane] = s2;
        __syncthreads();
        if (F.tid < 192) { const int cond = F.tid >> 6, ln = F.tid & 63; float s = 0.f;
#pragma unroll
            for (int w = 0; w < 8; ++w) s += red[(w * 3 + cond) * 64 + ln];
            const int n = (cg % 96) * 64 + ln;
            wsp<float>(F, OFF_MOD)[(size_t)(l * 3 + cond) * 6144 + n] = s + F.in[I_BADA][(size_t)l * 6144 + n]; }
        __syncthreads();
    }
    { const int gt = F.bid * 512 + F.tid, gn = F.G * 512; float* cx = wsp<float>(F, OFF_CTX);
      for (int i = gt; i < NCTX * DM / 4; i += gn) ((f32x4*)cx)[i] = ((const f32x4*)F.in[I_CTX])[i]; }
    __syncthreads();
    conv_small_weights(F, 0);
}

DI void norm_rows(const Frame& F, const float* xlat, const float* g, int l, int j_shift, int j_scale, bf16_t* dst, int r_begin = 0) {
    const int gw = F.bid * 8 + F.wid, nw = F.G * 8;
    f32x4 gv[4];
#pragma unroll
    for (int j = 0; j < 4; ++j) gv[j] = *(const f32x4*)(g + 4 * F.lane + 256 * j);
    for (int r0 = r_begin + gw * 4; r0 < MROWS; r0 += nw * 4) {
        f32x4 v[4][4]; float ss[4];
#pragma unroll
        for (int q = 0; q < 4; ++q) { const float* xr = xrow_ptr(F, xlat, r0 + q);
#pragma unroll
            for (int j = 0; j < 4; ++j) v[q][j] = *(const f32x4*)(xr + 4 * F.lane + 256 * j); }
        const int cond = row_cond(r0); const float* sh = modp(F, l, cond, j_shift); const float* sc = modp(F, l, cond, j_scale);
        f32x4 s4v[4], c4v[4];
#pragma unroll
        for (int j = 0; j < 4; ++j) { s4v[j] = *(const f32x4*)(sh + 4 * F.lane + 256 * j); c4v[j] = *(const f32x4*)(sc + 4 * F.lane + 256 * j); }
#pragma unroll
        for (int q = 0; q < 4; ++q) { float a = 0.f;
#pragma unroll
            for (int j = 0; j < 4; ++j) a += v[q][j][0] * v[q][j][0] + v[q][j][1] * v[q][j][1] + v[q][j][2] * v[q][j][2] + v[q][j][3] * v[q][j][3];
            ss[q] = a; }
#pragma unroll
        for (int sft = 1; sft < 64; sft <<= 1) {
#pragma unroll
            for (int q = 0; q < 4; ++q) ss[q] += __shfl_xor(ss[q], sft); }
#pragma unroll
        for (int j = 0; j < 4; ++j) { const f32x4 s4 = s4v[j], c4 = c4v[j];
#pragma unroll
            for (int q = 0; q < 4; ++q) { const float inv = rsqrtf(ss[q] * (1.0f / DM) + 1e-6f); float o[4];
#pragma unroll
                for (int e = 0; e < 4; ++e) o[e] = (v[q][j][e] * inv * gv[j][e]) * (1.0f + c4[e]) + s4[e];
                u32x2 w; w.x = pk2(o[0], o[1]); w.y = pk2(o[2], o[3]);
                *(u32x2*)(dst + (size_t)(r0 + q) * DM + 4 * F.lane + 256 * j) = w; } }
    }
}

struct EpiInproj {
    static constexpr bool PERM = true, SEG = false;
    unsigned char* ws;
    DI void operator()(const f32x4 (&acc)[2][2][4][2], const pg8::Unit& u, int wr, int wc, int fr, int fq) const {
        bf16_t* dst; int ld, colt;
        if (u.pn < 8) { dst = (bf16_t*)(ws + R1) + (size_t)(u.pn >> 1) * U_EL; ld = 512; colt = (u.pn & 1) * 256; } else { dst = (bf16_t*)(ws + OFF_RWRAW); ld = 2048; colt = (u.pn - 8) * 256; }
        const int row0 = u.pm * 256 + wr * 64 + fr, col0 = colt + wc * 32 + 8 * fq;
#pragma unroll
        for (int ai = 0; ai < 2; ++ai)
#pragma unroll
            for (int m = 0; m < 4; ++m) { bf16_t* rowp = dst + (size_t)(row0 + ai * 128 + m * 16) * ld + col0;
#pragma unroll
                for (int bj = 0; bj < 2; ++bj) { const f32x4 v0 = acc[ai][bj][m][0], v1 = acc[ai][bj][m][1]; u32x4 w; w.x = pk2(v0[0], v0[1]); w.y = pk2(v0[2], v0[3]); w.z = pk2(v1[0], v1[1]); w.w = pk2(v1[2], v1[3]);
                    *(u32x4*)(rowp + bj * 128) = w; } }
    }
};
struct EpiLora {
    static constexpr bool PERM = true, SEG = false;
    unsigned char* ws; const float* w0; const float* a0;
    DI void operator()(const f32x4 (&acc)[2][2][4][2], const pg8::Unit& u, int wr, int wc, int fr, int fq) const {
        fr = launder(fr); fq = launder(fq);
        const int kind = u.pn >> 1; bf16_t* dst = (bf16_t*)(ws + R2) + (size_t)kind * U_EL; const int colt = (u.pn & 1) * 256;
        const int row0 = u.pm * 256 + wr * 64 + fr, col0 = colt + wc * 32 + 8 * fq;
        const float* bias = kind < 2 ? w0 + kind * 512 : a0 + ((kind - 2) & 1) * 512;
        const float mul = kind < 2 ? 0.60653065971f : 1.0f;
        if (kind < 4) {
#pragma unroll
            for (int bj = 0; bj < 2; ++bj) { const f32x4 b0 = *(const f32x4*)(bias + col0 + bj * 128), b1 = *(const f32x4*)(bias + col0 + bj * 128 + 4);
#pragma unroll
                for (int ai = 0; ai < 2; ++ai)
#pragma unroll
                    for (int m = 0; m < 4; ++m) { bf16_t* rowp = dst + (size_t)(row0 + ai * 128 + m * 16) * 512 + col0;
                        f32x4 v0 = acc[ai][bj][m][0], v1 = acc[ai][bj][m][1];
#pragma unroll
                        for (int e = 0; e < 4; ++e) { v0[e] = mul * sigmoidf_(v0[e] + b0[e]); v1[e] = mul * sigmoidf_(v1[e] + b1[e]); }
                        u32x4 w; w.x = pk2(v0[0], v0[1]); w.y = pk2(v0[2], v0[3]); w.z = pk2(v1[0], v1[1]); w.w = pk2(v1[2], v1[3]);
                        *(u32x4*)(rowp + bj * 128) = w; }
                asm volatile("" ::: "memory"); }
        } else {
#pragma unroll
            for (int bj = 0; bj < 2; ++bj)
#pragma unroll
                for (int ai = 0; ai < 2; ++ai)
#pragma unroll
                    for (int m = 0; m < 4; ++m) { bf16_t* rowp = dst + (size_t)(row0 + ai * 128 + m * 16) * 512 + col0;
                        const f32x4 v0 = acc[ai][bj][m][0], v1 = acc[ai][bj][m][1];
                        u32x4 w; w.x = pk2(v0[0], v0[1]); w.y = pk2(v0[2], v0[3]); w.z = pk2(v1[0], v1[1]); w.w = pk2(v1[2], v1[3]);
                        *(u32x4*)(rowp + bj * 128) = w; }
        }
    }
};
struct EpiGates {
    static constexpr bool PERM = true, SEG = false;
    bf16_t* G;
    DI void operator()(const f32x4 (&acc)[2][2][4][2], const pg8::Unit& u, int wr, int wc, int fr, int fq) const {
        const int row0 = u.pm * 256 + wr * 64 + fr, col0 = u.pn * 256 + wc * 32 + 8 * fq;
#pragma unroll
        for (int ai = 0; ai < 2; ++ai)
#pragma unroll
            for (int m = 0; m < 4; ++m) { bf16_t* rowp = G + (size_t)(row0 + ai * 128 + m * 16) * N_GATE + col0;
#pragma unroll
                for (int bj = 0; bj < 2; ++bj) { f32x4 v0 = acc[ai][bj][m][0], v1 = acc[ai][bj][m][1];
#pragma unroll
                    for (int e = 0; e < 4; ++e) { v0[e] = sigmoidf_(v0[e]); v1[e] = sigmoidf_(v1[e]); }
                    u32x4 w; w.x = pk2(v0[0], v0[1]); w.y = pk2(v0[2], v0[3]); w.z = pk2(v1[0], v1[1]); w.w = pk2(v1[2], v1[3]);
                    *(u32x4*)(rowp + bj * 128) = w; } }
    }
};
struct EpiMerge {
    static constexpr bool PERM = true, SEG = true;
    const bf16_t* G; bf16_t* mg;
    DI void mid(f32x4 (&acc)[2][2][4][2], const pg8::Unit& u, int seg, int wr, int wc, int fr, int fq) const {
        const int row0 = u.pm * 256 + wr * 64 + fr, col0 = u.pn * 256 + wc * 32 + 8 * fq;
#pragma unroll
        for (int ai = 0; ai < 2; ++ai)
#pragma unroll
            for (int m = 0; m < 4; ++m) { const bf16_t* gp = G + (size_t)(row0 + ai * 128 + m * 16) * N_GATE + (seg - 1) * DM + col0;
#pragma unroll
                for (int bj = 0; bj < 2; ++bj) { float ga[8], gb[8]; unpack8(*(const u32x4*)(gp + bj * 128), ga); unpack8(*(const u32x4*)(gp + DM + bj * 128), gb);
#pragma unroll
                    for (int e = 0; e < 4; ++e) { acc[ai][bj][m][0][e] *= fmaxf(ga[e], 1e-30f) * __builtin_amdgcn_rcpf(fmaxf(gb[e], 1e-30f)); acc[ai][bj][m][1][e] *= fmaxf(ga[4 + e], 1e-30f) * __builtin_amdgcn_rcpf(fmaxf(gb[4 + e], 1e-30f)); } }
                asm volatile("" ::: "memory"); }
    }
    DI void operator()(const f32x4 (&acc)[2][2][4][2], const pg8::Unit& u, int wr, int wc, int fr, int fq) const {
        const int row0 = u.pm * 256 + wr * 64 + fr, col0 = u.pn * 256 + wc * 32 + 8 * fq;
#pragma unroll
        for (int ai = 0; ai < 2; ++ai)
#pragma unroll
            for (int m = 0; m < 4; ++m) { const size_t row = (size_t)(row0 + ai * 128 + m * 16);
#pragma unroll
                for (int bj = 0; bj < 2; ++bj) { const f32x4 v0 = acc[ai][bj][m][0], v1 = acc[ai][bj][m][1];
                    float gv[8], o[8]; unpack8(*(const u32x4*)(G + row * N_GATE + 2 * DM + col0 + bj * 128), gv);
#pragma unroll
                    for (int e = 0; e < 4; ++e) { o[e] = fmaxf(gv[e], 1e-30f) * v0[e]; o[4 + e] = fmaxf(gv[4 + e], 1e-30f) * v1[e]; }
                    *(u32x4*)(mg + row * DM + col0 + bj * 128) = pack8(o); }
                asm volatile("" ::: "memory"); }
    }
};
struct EpiResid {
    static constexpr bool PERM = false, SEG = false;
    const float* xlat_in; float* xlat_out; float* ctxb; const float* modl;
    DI void operator()(const f32x4 (&acc)[2][2][4][2], const pg8::Unit& u, int wr, int wc, int fr, int fq) const {
        const int col0 = u.pn * 256 + wc * 32 + 4 * fq; const bool isctx = u.pm < 2; const int cond = isctx ? 2 : (u.pm - 2) / 64;
        const float* src = isctx ? ctxb + (size_t)u.pm * 256 * DM : xlat_in + (size_t)(u.pm - 2) * 256 * DM;
        float* dst = isctx ? ctxb + (size_t)u.pm * 256 * DM : xlat_out + (size_t)(u.pm - 2) * 256 * DM;
        const float* gate = modl + (size_t)(cond * 6 + 2) * DM + col0;
#pragma unroll
        for (int bj = 0; bj < 2; ++bj)
#pragma unroll
            for (int n = 0; n < 2; ++n) { const f32x4 gv = *(const f32x4*)(gate + bj * 128 + n * 16);
#pragma unroll
                for (int ai = 0; ai < 2; ++ai) { f32x4 xo[4];
#pragma unroll
                    for (int m = 0; m < 4; ++m) xo[m] = *(const f32x4*)(src + (size_t)(wr * 64 + fr + ai * 128 + m * 16) * DM + col0 + bj * 128 + n * 16);
#pragma unroll
                    for (int m = 0; m < 4; ++m) *(f32x4*)(dst + (size_t)(wr * 64 + fr + ai * 128 + m * 16) * DM + col0 + bj * 128 + n * 16) = xo[m] + gv * acc[ai][bj][m][n];
                    asm volatile("" ::: "memory"); } }
    }
};
struct EpiLogits {
    static constexpr bool PERM = false, SEG = false;
    float* lg;
    DI void operator()(const f32x4 (&acc)[2][2][4][2], const pg8::Unit& u, int wr, int wc, int fr, int fq) const {
        if (wc >= 2) return;
        const int row0 = u.pm * 256 + wr * 64 + fr, col0 = wc * 32 + 4 * fq;
#pragma unroll
        for (int ai = 0; ai < 2; ++ai)
#pragma unroll
            for (int m = 0; m < 4; ++m)
#pragma unroll
                for (int n = 0; n < 2; ++n) *(f32x4*)(lg + (size_t)(row0 + ai * 128 + m * 16) * 64 + col0 + n * 16) = acc[ai][0][m][n];
    }
};
struct EpiAct {
    static constexpr bool PERM = true, SEG = false;
    bf16_t* act;
    DI void operator()(const f32x4 (&acc)[2][2][4][2], const pg8::Unit& u, int wr, int wc, int fr, int fq) const {
        const int row0 = u.pm * 256 + wr * 64 + fr, col0 = u.pn * 128 + wc * 32 + 8 * fq;
#pragma unroll
        for (int ai = 0; ai < 2; ++ai)
#pragma unroll
            for (int m = 0; m < 4; ++m) { float o[8];
#pragma unroll
                for (int n = 0; n < 2; ++n)
#pragma unroll
                    for (int e = 0; e < 4; ++e) { const float gt = acc[ai][0][m][n][e], up = acc[ai][1][m][n][e]; o[4 * n + e] = gt * sigmoidf_(gt) * up; }
                *(u32x4*)(act + (size_t)(row0 + ai * 128 + m * 16) * FF + col0) = pack8(o); }
    }
};
struct EpiY {
    static constexpr bool PERM = true, SEG = false;
    bf16_t* y;
    DI void operator()(const f32x4 (&acc)[2][2][4][2], const pg8::Unit& u, int wr, int wc, int fr, int fq) const {
        const int row0 = u.pm * 256 + wr * 64 + fr, col0 = u.pn * 256 + wc * 32 + 8 * fq;
#pragma unroll
        for (int ai = 0; ai < 2; ++ai)
#pragma unroll
            for (int m = 0; m < 4; ++m) { bf16_t* rowp = y + (size_t)(row0 + ai * 128 + m * 16) * DM + col0;
#pragma unroll
                for (int bj = 0; bj < 2; ++bj) { const f32x4 v0 = acc[ai][bj][m][0], v1 = acc[ai][bj][m][1]; u32x4 w; w.x = pk2(v0[0], v0[1]); w.y = pk2(v0[2], v0[3]); w.z = pk2(v1[0], v1[1]); w.w = pk2(v1[2], v1[3]);
                    *(u32x4*)(rowp + bj * 128) = w; } }
    }
};

DI void seq_of_row(int r, int& t, int& len) { if (r < NCTX) { t = r & 255; len = CTXL; } else { t = (r - NCTX) & (SEQ - 1); len = SEQ; } }

DI void phaseC_rows(const Frame& F, int l) {
    const int gw = F.bid * 8 + F.wid, nw = F.G * 8, lane = F.lane;
    bf16_t* Q = wsp<bf16_t>(F, OFF_Q); bf16_t* Kp = wsp<bf16_t>(F, OFF_K);
    const bf16_t* POOL = wsp<bf16_t>(F, OFF_POOL); bf16_t* PD = wsp<bf16_t>(F, OFF_PDIFF);
    const bf16_t* RW = wsp<bf16_t>(F, OFF_RWRAW); bf16_t* AL = wsp<bf16_t>(F, OFF_ALORA);
    bf16_t* RR = wsp<bf16_t>(F, OFF_RR); bf16_t* RK = wsp<bf16_t>(F, OFF_RK); bf16_t* RV = wsp<bf16_t>(F, OFF_RV); bf16_t* RKK = wsp<bf16_t>(F, OFF_RKK);
    const int i8 = lane & 7, axis = i8 >> 2, sec = (i8 >> 1) & 1, fb = (i8 & 1) * 8;
    float qg[8], kg[8];
#pragma unroll
    for (int e = 0; e < 8; ++e) { qg[e] = F.in[I_QNG][l * 64 + i8 * 8 + e]; kg[e] = F.in[I_KNG][l * 64 + i8 * 8 + e]; }
    LAS float* mul_ = (LAS float*)(F.lds + 32768);
    { const float* mu = F.in[I_SHMU] + (size_t)l * 2 * RW_IN; const float* kkw = F.in[I_KK] + (size_t)l * 512;
      for (int i = F.tid; i < 2 * RW_IN + 512; i += 512) mul_[i] = i < 2 * RW_IN ? mu[i] : kkw[i - 2 * RW_IN]; }
    __syncthreads();
    const float QSCALE = 0.125f * 1.4426950408889634f;
    for (int r = gw; r < MROWS; r += nw) {
        int t, len; seq_of_row(r, t, len);
        const int half = 1 << (lane >> 4); const int lo = max(t - half, 0), hi = min(t + half - 1, len - 1);
        const bool hp = t > 0, hn = t < len - 1; const bf16_t* cur = RW + (size_t)r * 2048;
        u32x4 wq, wk, wself, xw[16], rc[4], rp[4], rn[4];
        __builtin_amdgcn_sched_barrier(0);
        wq = *(const u32x4*)(Q + (size_t)r * 512 + 8 * lane); wk = *(const u32x4*)(Kp + (size_t)r * 512 + 8 * lane);
        wself = *(const u32x4*)(POOL + (size_t)r * 512 + 8 * lane);
#pragma unroll
        for (int j = 0; j < 16; ++j) { const int tt = t - 8 + j; const bool ok = tt >= lo && tt <= hi; xw[j] = *(const u32x4*)(POOL + (size_t)(ok ? r + (tt - t) : r) * 512 + 8 * lane); }
#pragma unroll
        for (int ch = 0; ch < 4; ++ch) { const int c0 = ch * 512 + 8 * (ch == 3 ? min(lane, 47) : lane);
            rc[ch] = *(const u32x4*)(cur + c0); rp[ch] = *(const u32x4*)(cur - (hp ? 2048 : 0) + c0); rn[ch] = *(const u32x4*)(cur + (hn ? 2048 : 0) + c0); }
        __builtin_amdgcn_sched_barrier(0);
        float cs[8], sn[8];
        if (r >= NCTX) { const float pos = (float)(axis ? (t & 63) : (t >> 6));
#pragma unroll
            for (int e = 0; e < 8; ++e) { const float invf = __builtin_amdgcn_exp2f(-(float)(fb + e) * 0.83048202372184059f); const float rev = (pos * invf) * 0.15915494309189535f;
                cs[e] = __builtin_amdgcn_cosf(rev); sn[e] = __builtin_amdgcn_sinf(rev); }
        } else {
#pragma unroll
            for (int e = 0; e < 8; ++e) { cs[e] = 1.f; sn[e] = 0.f; } }
#pragma unroll
        for (int which = 0; which < 2; ++which) {
            bf16_t* p = (which ? Kp : Q) + (size_t)r * 512 + 8 * lane; float x[8]; unpack8(which ? wk : wq, x);
            float ss = 0.f;
#pragma unroll
            for (int e = 0; e < 8; ++e) ss += x[e] * x[e];
            ss = sum8(ss); const float rinv = rsqrtf(ss * (1.0f / 64.0f) + 1e-6f);
            float o[8];
#pragma unroll
            for (int e = 0; e < 8; ++e) { const float y = x[e] * rinv * (which ? kg[e] : qg[e]); const float yp = __shfl_xor(y, 2);
                o[e] = y * cs[e] + (sec ? yp : -yp) * sn[e]; if (!which) o[e] *= QSCALE; }
            *(u32x4*)p = pack8(o);
        }
        {
            float s[8], self[8];
#pragma unroll
            for (int e = 0; e < 8; ++e) s[e] = 0.f;
            unpack8(wself, self);
#pragma unroll
            for (int j = 0; j < 16; ++j) { const int tt = t - 8 + j; const float mk = (tt >= lo && tt <= hi) ? 1.0f : 0.0f; float x[8]; unpack8(xw[j], x);
#pragma unroll
                for (int e = 0; e < 8; ++e) s[e] += mk * x[e]; }
            const float ic = 1.0f / (float)(hi - lo + 1); float o[8];
#pragma unroll
            for (int e = 0; e < 8; ++e) o[e] = s[e] * ic - self[e];
            *(u32x4*)(PD + (size_t)r * 512 + 8 * lane) = pack8(o);
        }
        {
#pragma unroll
            for (int ch = 0; ch < 4; ++ch) {
                if (ch == 3 && lane >= 48) break;
                const int c0 = ch * 512 + 8 * lane; float x[8], xp[8], xn[8], u[8];
                unpack8(rc[ch], x); unpack8(rp[ch], xp); unpack8(rn[ch], xn);
                if (!hp) {
#pragma unroll
                    for (int e = 0; e < 8; ++e) xp[e] = 0.f; }
                if (!hn) {
#pragma unroll
                    for (int e = 0; e < 8; ++e) xn[e] = 0.f; }
                const f32x4 m0a = *(const LAS f32x4*)(mul_ + c0), m0b = *(const LAS f32x4*)(mul_ + c0 + 4), m1a = *(const LAS f32x4*)(mul_ + RW_IN + c0), m1b = *(const LAS f32x4*)(mul_ + RW_IN + c0 + 4);
#pragma unroll
                for (int e = 0; e < 8; ++e) { const float m0 = e < 4 ? m0a[e & 3] : m0b[e & 3], m1 = e < 4 ? m1a[e & 3] : m1b[e & 3]; u[e] = x[e] + (xp[e] - x[e]) * m0 + (xn[e] - x[e]) * m1; }
                if (ch == 0) *(u32x4*)(RR + (size_t)r * 512 + 8 * lane) = pack8(u);
                else if (ch == 2) *(u32x4*)(RV + (size_t)r * 512 + 8 * lane) = pack8(u);
                else if (ch == 1) {
                    *(u32x4*)(RK + (size_t)r * 512 + 8 * lane) = pack8(u);
                    const f32x4 kka = *(const LAS f32x4*)(mul_ + 2 * RW_IN + 8 * lane), kkb = *(const LAS f32x4*)(mul_ + 2 * RW_IN + 8 * lane + 4); float kk[8], ss = 0.f;
#pragma unroll
                    for (int e = 0; e < 8; ++e) { kk[e] = u[e] * (e < 4 ? kka[e & 3] : kkb[e & 3]); ss += kk[e] * kk[e]; }
                    ss = sum8(ss); const float inv = 1.0f / fmaxf(sqrtf(ss), 1e-12f);
#pragma unroll
                    for (int e = 0; e < 8; ++e) kk[e] *= inv;
                    *(u32x4*)(RKK + (size_t)r * 512 + 8 * lane) = pack8(kk);
                } else {
                    float o[8];
#pragma unroll
                    for (int e = 0; e < 8; ++e) { if (lane < 16) { const float ex = __expf(2.0f * u[e]); o[e] = 1.0f - 2.0f * __builtin_amdgcn_rcpf(ex + 1.0f); } else if (lane < 32) o[e] = u[e]; else o[e] = sigmoidf_(u[e]); }
                    *(u32x4*)(AL + (size_t)r * LORA_K + 8 * lane) = pack8(o);
                }
            }
        }
    }
}
DI void phaseC_vt(const Frame& F) {
    const bf16_t* V = wsp<bf16_t>(F, OFF_V); bf16_t* VT = wsp<bf16_t>(F, RVT);
    LAS bf16_t* T = (LAS bf16_t*)F.lds;
    for (int task = F.bid; task < NB * 4 * (KEYS / 64); task += F.G) {
        const int kb = task % (KEYS / 64), bh = task / (KEYS / 64), b = bh >> 2, h = bh & 3;
        const int row0 = kb < 4 ? b * CTXL + kb * 64 : NCTX + b * SEQ + (kb - 4) * 64;
#pragma unroll
        for (int i = 0; i < 2; ++i) { const int ci = F.tid + 512 * i, j = ci >> 4, c = ci & 15;
            const u32x4 w = *(const u32x4*)(V + (size_t)(row0 + j) * 512 + h * 128 + c * 8);
            LAS unsigned* q = (LAS unsigned*)(T + j * 136 + c * 8); q[0] = w.x; q[1] = w.y; q[2] = w.z; q[3] = w.w; }
        __syncthreads();
#pragma unroll
        for (int i = 0; i < 2; ++i) { const int ci = F.tid + 512 * i, vd = ci >> 3, p8 = ci & 7; unsigned w[4];
#pragma unroll
            for (int e2 = 0; e2 < 4; ++e2) { unsigned pr = 0;
#pragma unroll
                for (int q = 0; q < 2; ++q) { const int p = p8 * 8 + e2 * 2 + q, gq = p >> 4, pp = p & 15, hh = pp >> 3, ee = pp & 7, ko = 8 * (ee >> 2) + 4 * hh + (ee & 3);
                    pr |= ((unsigned)T[(gq * 16 + ko) * 136 + vd]) << (16 * q); }
                w[e2] = pr; }
            *(u32x4*)(VT + ((size_t)bh * 128 + vd) * KEYS + kb * 64 + p8 * 8) = (u32x4){w[0], w[1], w[2], w[3]}; }
        __syncthreads();
    }
}

#define MFMA32(a, b, c) __builtin_amdgcn_mfma_f32_32x32x16_bf16((a), (b), (c), 0, 0, 0)
constexpr int ATT_KB = 16384, ATT_STG = 32768;
DI void attn_phase(const Frame& F, int l, int nunits) {
    const int tid = F.tid, wid = F.wid, lane = F.lane, l32 = lane & 31, hh = lane >> 5, g = wid >> 1, m = wid & 1;
    const bf16_t* Q = wsp<bf16_t>(F, OFF_Q); const bf16_t* Kg = wsp<bf16_t>(F, OFF_K); const bf16_t* VT = wsp<bf16_t>(F, RVT); bf16_t* ATT = wsp<bf16_t>(F, OFF_POOL);
    const float* lq = F.in[I_LAMQK] + (size_t)l * 256;
    float d0 = lq[lane] * lq[64 + lane], d1 = lq[128 + lane] * lq[192 + lane]; d0 = wave_sum(d0); d1 = wave_sum(d1);
    const float lam_init = 0.8f - 0.6f * expf(-0.3f * (float)l);
    const float lam = expf(d0) - expf(d1) + lam_init, lamfac = 1.0f - lam_init;
    const float* sg = F.in[I_SUBLN] + (size_t)l * 128;
    LAS float* xch = (LAS float*)F.lds;
    LAS float* sgl = (LAS float*)(F.lds + MISC_OFF + 2048);
    if (wid < 2) sgl[wid * 64 + lane] = sg[wid * 64 + lane];
    (void)tid;
    for (int u = F.bid; u < nunits; u += F.G) {
        int b, h, qrow0, nkt;
        if (u < 512) { const int bh = u & 7, qt = ((u >> 3) & 31) + 32 * (u >> 8); b = bh >> 2; h = bh & 3; qrow0 = NCTX + b * SEQ + qt * 256; nkt = KEYS / 64; } else { const int uu = u - 512; b = uu >> 2; h = uu & 3; qrow0 = b * CTXL; nkt = 4; }
        bf16x8 qf[2][4];
#pragma unroll
        for (int qs = 0; qs < 2; ++qs) { const bf16_t* qp = Q + (size_t)(qrow0 + g * 64 + qs * 32 + l32) * 512 + h * 128 + m * 64 + hh * 8;
#pragma unroll
            for (int ks = 0; ks < 4; ++ks) qf[qs][ks] = *(const bf16x8*)(qp + ks * 16); }
        f32x16 o[2][4];
#pragma unroll
        for (int qs = 0; qs < 2; ++qs)
#pragma unroll
            for (int vt = 0; vt < 4; ++vt)
#pragma unroll
                for (int i = 0; i < 16; ++i) o[qs][vt][i] = 0.f;
        float lsum[2] = {0.f, 0.f};
        const bf16_t* vtb = VT + (size_t)(b * 4 + h) * 128 * KEYS;
#define KROW0(kt) ((kt) < 4 ? b * CTXL + (kt) * 64 : NCTX + b * SEQ + ((kt) - 4) * 64)
#define ISSUE_TILE(kt, buf) do { const int ln_ = launder(lane); const int kr0_ = KROW0(kt); _Pragma("unroll") for (int q_ = 0; q_ < 2; ++q_) { const int j_ = 2 * wid + q_; \
            { const int row_ = 4 * j_ + (ln_ >> 4), c_ = (ln_ & 15) ^ (row_ & 15); \
              __builtin_amdgcn_global_load_lds((const unsigned*)(Kg + (size_t)(kr0_ + row_) * 512 + h * 128 + c_ * 8), (LAS unsigned*)(F.lds + (buf) * ATT_STG + j_ * 1024), 16, 0, 0); } \
            { const int row_ = 8 * j_ + (ln_ >> 3), c_ = (ln_ & 7) ^ ((row_ >> 1) & 7); \
              __builtin_amdgcn_global_load_lds((const unsigned*)(vtb + (size_t)row_ * KEYS + (kt) * 64 + c_ * 8), (LAS unsigned*)(F.lds + (buf) * ATT_STG + ATT_KB + j_ * 1024), 16, 0, 0); } } } while (0)
        __syncthreads();
        ISSUE_TILE(0, 0);
        for (int kt = 0; kt < nkt; ++kt) {
            const int buf = kt & 1;
            asm volatile("s_waitcnt vmcnt(0)" ::: "memory");
            __syncthreads();
            const int ln = launder(lane); const int l32b = ln & 31, hb = ln >> 5;
            const LAS unsigned char* Kb = F.lds + buf * ATT_STG + l32b * 256; const int kx = l32b & 15;
            const LAS unsigned char* Vb = F.lds + buf * ATT_STG + ATT_KB + l32b * 128; const int vx = (l32b >> 1) & 7;
#define KFRAG(kk_, ks_) (*(const LAS bf16x8*)(Kb + (kk_) * 8192 + (((m * 8 + (ks_) * 2 + hb) ^ kx) << 4)))
#define VFRAG(kk_, i_) (*(const LAS bf16x8*)(Vb + ((i_) >> 1) * 4096 + ((((kk_) * 4 + ((i_) & 1) * 2 + hb) ^ vx) << 4)))
#define SBA_ __builtin_amdgcn_sched_barrier(0)
            bf16x8 kf[4];
#pragma unroll
            for (int ks = 0; ks < 4; ++ks) kf[ks] = KFRAG(0, ks);
            SBA_;
            if (kt + 1 < nkt) ISSUE_TILE(kt + 1, buf ^ 1);
            SBA_;
#pragma unroll
            for (int kk = 0; kk < 2; ++kk) {
                f32x16 sv[2];
#pragma unroll
                for (int qs = 0; qs < 2; ++qs)
#pragma unroll
                    for (int i = 0; i < 16; ++i) sv[qs][i] = 0.f;
#pragma unroll
                for (int ks = 0; ks < 4; ++ks) { sv[0] = MFMA32(kf[ks], qf[0][ks], sv[0]); sv[1] = MFMA32(kf[ks], qf[1][ks], sv[1]); }
                SBA_;
                bf16x8 vfr[3]; vfr[0] = VFRAG(kk, 0); vfr[1] = VFRAG(kk, 1);
                if (kk == 0) {
#pragma unroll
                    for (int ks = 0; ks < 4; ++ks) kf[ks] = KFRAG(1, ks); }
                SBA_;
                bf16x8 pb[2][2];
#pragma unroll
                for (int qs = 0; qs < 2; ++qs)
#pragma unroll
                    for (int jp = 0; jp < 2; ++jp) { u32x4 w; float p[8];
#pragma unroll
                        for (int e = 0; e < 8; ++e) { p[e] = __builtin_amdgcn_exp2f(sv[qs][8 * jp + e]); lsum[qs] += p[e]; }
                        w.x = pk2(p[0], p[1]); w.y = pk2(p[2], p[3]); w.z = pk2(p[4], p[5]); w.w = pk2(p[6], p[7]); pb[qs][jp] = __builtin_bit_cast(bf16x8, w); }
                SBA_;
#pragma unroll
                for (int i = 0; i < 8; ++i) { const int vt = i >> 1, jp = i & 1;
                    if (i + 2 < 8) vfr[(i + 2) % 3] = VFRAG(kk, i + 2);
                    SBA_;
                    o[0][vt] = MFMA32(vfr[i % 3], pb[0][jp], o[0][vt]); o[1][vt] = MFMA32(vfr[i % 3], pb[1][jp], o[1][vt]);
                    SBA_; }
            }
#undef KFRAG
#undef VFRAG
#undef SBA_
        }
#undef ISSUE_TILE
#undef KROW0
        __syncthreads();
        float cm[2];
#pragma unroll
        for (int qs = 0; qs < 2; ++qs) { const float lt = lsum[qs] + __shfl_xor(lsum[qs], 32); cm[qs] = m ? lam / lt : 1.0f / lt; }
        if (m) {
#pragma unroll
            for (int qs = 0; qs < 2; ++qs)
#pragma unroll
                for (int vt = 0; vt < 4; ++vt)
#pragma unroll
                    for (int i = 0; i < 16; ++i) xch[((g * 2 + qs) * 64 + vt * 16 + i) * 64 + lane] = o[qs][vt][i] * cm[qs];
        }
        __syncthreads();
        if (!m) {
#pragma unroll
            for (int qs = 0; qs < 2; ++qs) {
                float ss = 0.f;
#pragma unroll
                for (int vt = 0; vt < 4; ++vt)
#pragma unroll
                    for (int i = 0; i < 16; ++i) { const float v = o[qs][vt][i] * cm[qs] - xch[((g * 2 + qs) * 64 + vt * 16 + i) * 64 + lane]; o[qs][vt][i] = v; ss += v * v; }
                ss += __shfl_xor(ss, 32);
                const float rn = rsqrtf(ss * (1.0f / 128.0f) + 1e-6f) * lamfac;
                bf16_t* op = ATT + (size_t)(qrow0 + g * 64 + qs * 32 + l32) * 512 + h * 128;
#pragma unroll
                for (int vt = 0; vt < 4; ++vt)
#pragma unroll
                    for (int q4 = 0; q4 < 4; ++q4) { const int vd = vt * 32 + q4 * 8 + hh * 4; const f32x4 g4 = *(const LAS f32x4*)(sgl + vd);
                        u32x2 w; w.x = pk2(o[qs][vt][4 * q4] * rn * g4[0], o[qs][vt][4 * q4 + 1] * rn * g4[1]); w.y = pk2(o[qs][vt][4 * q4 + 2] * rn * g4[2], o[qs][vt][4 * q4 + 3] * rn * g4[3]);
                        *(u32x2*)(op + vd) = w; }
            }
        }
    }
}

DI int crow_(int reg, int h) { return (reg & 3) + 8 * (reg >> 2) + 4 * h; }
DI int swz(int row, int chunk) { return row * 128 + ((chunk ^ ((row >> 1) & 7)) << 4); }
constexpr int SL_A = 0, SL_B = 8192, SL_K = 16384, SL_V = 24576, SL_T = 32768, SL_R = 40960, WAVE_LDS = 49152;
typedef LAS unsigned char* lds_t;
DI bf16x8 fragN(lds_t base, int row, int k0, int h) { return *(const LAS bf16x8*)(base + swz(row, (k0 >> 3) + h)); }
DI bf16x8 fragK(lds_t base, int row, int kt, int s, int h) { const int c0 = 4 * kt + 2 * s; const u32x2 a = *(const LAS u32x2*)(base + swz(row, c0) + 8 * h), b = *(const LAS u32x2*)(base + swz(row, c0 + 1) + 8 * h);
    return __builtin_bit_cast(bf16x8, (u32x4){a.x, a.y, b.x, b.y}); }
DI void zero_acc(f32x16 (&acc)[2][2]) {
#pragma unroll
    for (int a = 0; a < 2; ++a)
#pragma unroll
        for (int b = 0; b < 2; ++b)
#pragma unroll
            for (int i = 0; i < 16; ++i) acc[a][b][i] = 0.f; }
DI void mm_nn(f32x16 (&acc)[2][2], lds_t A, lds_t B, int l32, int h) {
    l32 = launder(l32); h = launder(h);
    bf16x8 af[4][2], bf[4][2];
#pragma unroll
    for (int ks = 0; ks < 4; ++ks)
#pragma unroll
        for (int q = 0; q < 2; ++q) { af[ks][q] = fragN(A, 32 * q + l32, 16 * ks, h); bf[ks][q] = fragN(B, 32 * q + l32, 16 * ks, h); }
#pragma unroll
    for (int ks = 0; ks < 4; ++ks)
#pragma unroll
        for (int ra = 0; ra < 2; ++ra)
#pragma unroll
            for (int cb = 0; cb < 2; ++cb) if (!(ra == 1 && cb == 0)) acc[ra][cb] = MFMA32(af[ks][ra], bf[ks][cb], acc[ra][cb]);
}
DI void mm_nn_lp(f32x16 (&acc)[2][2], lds_t A, lds_t B, int l32, int h) {
    l32 = launder(l32); h = launder(h);
#pragma unroll
    for (int kp = 0; kp < 2; ++kp) { bf16x8 af[2][2], bf[2][2];
#pragma unroll
        for (int ks = 0; ks < 2; ++ks)
#pragma unroll
            for (int q = 0; q < 2; ++q) { af[ks][q] = fragN(A, 32 * q + l32, 16 * (2 * kp + ks), h); bf[ks][q] = fragN(B, 32 * q + l32, 16 * (2 * kp + ks), h); }
#pragma unroll
        for (int ks = 0; ks < 2; ++ks)
#pragma unroll
            for (int ra = 0; ra < 2; ++ra)
#pragma unroll
                for (int cb = 0; cb < 2; ++cb) acc[ra][cb] = MFMA32(af[ks][ra], bf[ks][cb], acc[ra][cb]); }
}
DI void mm_xt(f32x16 (&acc)[2][2], const bf16x8 (&xf)[2][2][2], lds_t Y, int l32, int h) {
    l32 = launder(l32); h = launder(h);
#pragma unroll
    for (int it = 0; it < 2; ++it)
#pragma unroll
        for (int s = 0; s < 2; ++s) { bf16x8 yf[2];
#pragma unroll
            for (int vt = 0; vt < 2; ++vt) yf[vt] = fragK(Y, 32 * vt + l32, it, s, h);
#pragma unroll
            for (int tt = 0; tt < 2; ++tt)
#pragma unroll
                for (int vt = 0; vt < 2; ++vt) if (!(it == 1 && tt == 0)) acc[vt][tt] = MFMA32(yf[vt], xf[it][tt][s], acc[vt][tt]); }
}
DI void mm_st(f32x16 (&acc)[2][2], lds_t A, const bf16x8 (&sf)[2][2][2], int l32, int h) {
    l32 = launder(l32); h = launder(h);
#pragma unroll
    for (int ct = 0; ct < 2; ++ct)
#pragma unroll
        for (int s = 0; s < 2; ++s) { bf16x8 af[2];
#pragma unroll
            for (int tt = 0; tt < 2; ++tt) af[tt] = fragK(A, 32 * tt + l32, ct, s, h);
#pragma unroll
            for (int tt = 0; tt < 2; ++tt)
#pragma unroll
                for (int vt = 0; vt < 2; ++vt) acc[vt][tt] = MFMA32(sf[ct][vt][s], af[tt], acc[vt][tt]); }
}
DI bf16x8 pack_regs(const f32x16& x, int s) { u32x4 w; w.x = pk2(x[8 * s], x[8 * s + 1]); w.y = pk2(x[8 * s + 2], x[8 * s + 3]); w.z = pk2(x[8 * s + 4], x[8 * s + 5]); w.w = pk2(x[8 * s + 6], x[8 * s + 7]); return __builtin_bit_cast(bf16x8, w); }
template <int INCL> DI void pack_masked(const f32x16 (&acc)[2][2], bf16x8 (&xf)[2][2][2], int l32, int h) {
    l32 = launder(l32); h = launder(h);
#pragma unroll
    for (int it = 0; it < 2; ++it)
#pragma unroll
        for (int tt = 0; tt < 2; ++tt) {
            if (it > tt) { xf[it][tt][0] = (bf16x8){0, 0, 0, 0, 0, 0, 0, 0}; xf[it][tt][1] = (bf16x8){0, 0, 0, 0, 0, 0, 0, 0}; continue; }
            if (it < tt) { xf[it][tt][0] = pack_regs(acc[it][tt], 0); xf[it][tt][1] = pack_regs(acc[it][tt], 1); continue; }
            f32x16 m;
#pragma unroll
            for (int r = 0; r < 16; ++r) { const int i = crow_(r, h); m[r] = (INCL ? i <= l32 : i < l32) ? acc[it][tt][r] : 0.f; }
            xf[it][tt][0] = pack_regs(m, 0); xf[it][tt][1] = pack_regs(m, 1); }
}
DI void store_tm(const f32x16 (&acc)[2][2], lds_t img, int l32, int h) {
    l32 = launder(l32); h = launder(h);
#pragma unroll
    for (int a = 0; a < 2; ++a)
#pragma unroll
        for (int b = 0; b < 2; ++b)
#pragma unroll
            for (int q = 0; q < 4; ++q) { u32x2 w; w.x = pk2(acc[a][b][4 * q], acc[a][b][4 * q + 1]); w.y = pk2(acc[a][b][4 * q + 2], acc[a][b][4 * q + 3]);
                *(LAS u32x2*)(img + swz(32 * b + l32, 4 * a + q) + 8 * h) = w; }
}
DI void solve_rows(lds_t rhs, lds_t tab, lds_t out, int lane) {
    lane = launder(lane);
    lds_t orow = out + lane * 128; const int sw = (lane >> 1) & 7; const int rb = ((lane >> 3) << 4), rl = (lane & 7) * 2;
    const int l32 = lane & 31, h = lane >> 5;
#define DOT4(a, cw, xw, j0) asm volatile("v_dot2c_f32_bf16 %0, %4, %20\n\tv_dot2c_f32_bf16 %1, %8, %20\n\tv_dot2c_f32_bf16 %2, %12, %20\n\tv_dot2c_f32_bf16 %3, %16, %20\n\t" \
                              "v_dot2c_f32_bf16 %0, %5, %21\n\tv_dot2c_f32_bf16 %1, %9, %21\n\tv_dot2c_f32_bf16 %2, %13, %21\n\tv_dot2c_f32_bf16 %3, %17, %21\n\t" \
                              "v_dot2c_f32_bf16 %0, %6, %22\n\tv_dot2c_f32_bf16 %1, %10, %22\n\tv_dot2c_f32_bf16 %2, %14, %22\n\tv_dot2c_f32_bf16 %3, %18, %22\n\t" \
                              "v_dot2c_f32_bf16 %0, %7, %23\n\tv_dot2c_f32_bf16 %1, %11, %23\n\tv_dot2c_f32_bf16 %2, %15, %23\n\tv_dot2c_f32_bf16 %3, %19, %23\n\ts_nop 3" \
                : "+v"(a[j0]), "+v"(a[j0 + 1]), "+v"(a[j0 + 2]), "+v"(a[j0 + 3]) \
                : "v"(cw[j0].x), "v"(cw[j0].y), "v"(cw[j0].z), "v"(cw[j0].w), "v"(cw[j0 + 1].x), "v"(cw[j0 + 1].y), "v"(cw[j0 + 1].z), "v"(cw[j0 + 1].w), \
                  "v"(cw[j0 + 2].x), "v"(cw[j0 + 2].y), "v"(cw[j0 + 2].z), "v"(cw[j0 + 2].w), "v"(cw[j0 + 3].x), "v"(cw[j0 + 3].y), "v"(cw[j0 + 3].z), "v"(cw[j0 + 3].w), \
                  "v"(xw.x), "v"(xw.y), "v"(xw.z), "v"(xw.w))
    f32x16 u0[2], u1[2], zero;
#pragma unroll
    for (int i = 0; i < 16; ++i) { zero[i] = 0.f; u1[0][i] = 0.f; u1[1][i] = 0.f; u0[0][i] = 0.f; u0[1][i] = 0.f; }
#pragma unroll
    for (int b = 0; b < 4; ++b) {
        const int tA = 16 * b, tB = tA + 8, cA = 2 * b, cB = cA + 1;
        float a[8], a2[8]; u32x4 dg0[8], cw[8], dg1[8];
#pragma unroll
        for (int j = 0; j < 8; ++j) { const int t = tA + j, u = tB + j;
            a[j] = bf2f(*(const LAS bf16_t*)(rhs + t * 128 + (rb ^ (((t >> 1) & 7) << 4)) + rl)); a2[j] = bf2f(*(const LAS bf16_t*)(rhs + u * 128 + (rb ^ (((u >> 1) & 7) << 4)) + rl)); }
#pragma unroll
        for (int j = 0; j < 8; ++j) { const int t = tA + j, u = tB + j;
            dg0[j] = *(const LAS u32x4*)(tab + t * 128 + ((cA ^ ((t >> 1) & 7)) << 4)); cw[j] = *(const LAS u32x4*)(tab + u * 128 + ((cA ^ ((u >> 1) & 7)) << 4)); dg1[j] = *(const LAS u32x4*)(tab + u * 128 + ((cB ^ ((u >> 1) & 7)) << 4)); }
        if (b > 0) { const int k0 = 16 * (b - 1); const bf16x8 xb0 = fragN(out, l32, k0, h), xb1 = fragN(out, 32 + l32, k0, h);
            if (b == 1) { const bf16x8 af0 = fragN(tab, l32, k0, h); u0[0] = MFMA32(af0, xb0, zero); u0[1] = MFMA32(af0, xb1, zero); }
            const bf16x8 af1 = fragN(tab, 32 + l32, k0, h); u1[0] = MFMA32(af1, xb0, u1[0]); u1[1] = MFMA32(af1, xb1, u1[1]);
            const int R0 = (b == 2) ? 0 : 8;
#pragma unroll
            for (int i = 0; i < 8; ++i) { const float X = (b == 1) ? u0[0][R0 + i] : u1[0][R0 + i], Y = (b == 1) ? u0[1][R0 + i] : u1[1][R0 + i];
                const auto r = __builtin_amdgcn_permlane32_swap(__float_as_uint(X), __float_as_uint(Y), false, false);
                const float lo = __uint_as_float(r[0]), hi = __uint_as_float(r[1]);
                if (i < 4) { a[i] += lo; a[4 + i] += hi; } else { a2[i - 4] += lo; a2[i] += hi; } }
        }
#pragma unroll
        for (int j = 1; j < 8; ++j) { float cf[8]; unpack8(dg0[j], cf);
#pragma unroll
            for (int q = 0; q < 8; ++q) if (q < j) a[j] += cf[q] * a[q]; }
        const u32x4 x0 = pack8(a);
        *(LAS u32x4*)(orow + ((cA ^ sw) << 4)) = x0;
        DOT4(a2, cw, x0, 0); DOT4(a2, cw, x0, 4);
#pragma unroll
        for (int j = 1; j < 8; ++j) { float cf[8]; unpack8(dg1[j], cf);
#pragma unroll
            for (int q = 0; q < 8; ++q) if (q < j) a2[j] += cf[q] * a2[q]; }
        *(LAS u32x4*)(orow + ((cB ^ sw) << 4)) = pack8(a2);
    }
#undef DOT4
}
struct ScanTask { int chain, h, r0, sgn; };
DI int scan_order(int q) { const int rbk = q >> 5, j = q & 31, dir = j & 1, bh = j >> 1, chain = dir * 16 + bh;
    const int ck = dir ? (rbk < 4 ? 3 - rbk : 4 + 255 - (rbk - 4)) : rbk; return chain * NCHUNK + ck; }
DI int scan_deal(int bid, int slot3, int trip, int G) {
    if (G != 256) { const int q = bid * 3 + slot3 + trip * G * 3; return q < 32 * NCHUNK ? scan_order(q) : -1; }
    const int xcd = bid & 7, sl = (bid >> 3) * 3 + slot3, grp = (trip * 8 + xcd) * 6 + sl / 16, mem = sl % 16;
    if (grp >= 2 * NCHUNK) return -1;
    const int rbk = grp >> 1, b = grp & 1, dir = mem & 1, hd = mem >> 1, chain = dir * 16 + b * 8 + hd;
    const int ck = dir ? (rbk < 4 ? 3 - rbk : 4 + 255 - (rbk - 4)) : rbk; return chain * NCHUNK + ck; }

DI ScanTask scan_task(int task) { ScanTask T; T.chain = task / NCHUNK; const int ck = task % NCHUNK, dir = T.chain >> 4, b = (T.chain >> 3) & 1; T.h = T.chain & 7;
    int base, len, c2; if (ck < 4) { base = b * CTXL; len = CTXL; c2 = ck; } else { base = NCTX + b * SEQ; len = SEQ; c2 = ck - 4; }
    T.r0 = dir ? base + len - 1 - 64 * c2 : base + 64 * c2; T.sgn = dir ? -1 : 1; return T; }
DI void write_cm_row(lds_t img, const unsigned (&pk)[32], int lane) {
    lane = launder(lane);
#pragma unroll
    for (int ch = 0; ch < 8; ++ch) *(LAS u32x4*)(img + swz(lane, ch)) = (u32x4){pk[4 * ch], pk[4 * ch + 1], pk[4 * ch + 2], pk[4 * ch + 3]};
}
DI void stage_raw(const bf16_t* src, const ScanTask& T, lds_t dst, int lane) {
    lane = launder(lane);
#pragma unroll
    for (int i = 0; i < 8; ++i) { const int q = lane + 64 * i, t = q >> 3, c8 = q & 7;
        *(LAS u32x4*)(dst + swz(t, c8)) = *(const u32x4*)(src + (size_t)(T.r0 + T.sgn * t) * 512 + T.h * 64 + c8 * 8); }
}
template <int N> DI void stage_raw_n(const bf16_t* const (&src)[N], const int (&slot)[N], const ScanTask& T, lds_t wl, int lane) {
    lane = launder(lane);
    u32x4 v[N][8];
    __builtin_amdgcn_sched_barrier(0);
#pragma unroll
    for (int p = 0; p < N; ++p)
#pragma unroll
        for (int i = 0; i < 8; ++i) { const int q = lane + 64 * i, t = q >> 3, c8 = q & 7; v[p][i] = *(const u32x4*)(src[p] + (size_t)(T.r0 + T.sgn * t) * 512 + T.h * 64 + c8 * 8); }
    __builtin_amdgcn_sched_barrier(0);
#pragma unroll
    for (int p = 0; p < N; ++p)
#pragma unroll
        for (int i = 0; i < 8; ++i) { const int q = lane + 64 * i, t = q >> 3, c8 = q & 7; *(LAS u32x4*)(wl + slot[p] + swz(t, c8)) = v[p][i]; }
    __builtin_amdgcn_sched_barrier(0);
}
DI void read_col(lds_t img, unsigned (&pk)[32], int lane) {
    lane = launder(lane);
    const int tw = ((lane >> 3) << 4), tb = (lane & 7) * 2;
    unsigned lo[32], hi[32];
#pragma unroll
    for (int t2 = 0; t2 < 32; ++t2) { const int ta = 2 * t2, tc = 2 * t2 + 1;
        lo[t2] = *(const LAS bf16_t*)(img + ta * 128 + (tw ^ (((ta >> 1) & 7) << 4)) + tb); hi[t2] = *(const LAS bf16_t*)(img + tc * 128 + (tw ^ (((tc >> 1) & 7) << 4)) + tb); }
#pragma unroll
    for (int t2 = 0; t2 < 32; ++t2) pk[t2] = lo[t2] | (hi[t2] << 16);
}
template <bool P3>
DI float scan_prep(const Frame& F, int l, const ScanTask& T, lds_t wl, int lane) {
    const int dir = T.chain >> 4;
    if (P3) { const bf16_t* const src[6] = {wsp<bf16_t>(F, OFF_RKK), wsp<bf16_t>(F, OFF_RK), wsp<bf16_t>(F, dir ? OFF_AB : OFF_AF), wsp<bf16_t>(F, dir ? OFF_EB : OFF_EF), wsp<bf16_t>(F, OFF_RV), wsp<bf16_t>(F, OFF_RR)};
        const int slot[6] = {SL_A, SL_K, SL_B, SL_T, SL_V, SL_R}; stage_raw_n<6>(src, slot, T, wl, lane); }
    else { const bf16_t* const src[5] = {wsp<bf16_t>(F, OFF_RKK), wsp<bf16_t>(F, OFF_RK), wsp<bf16_t>(F, dir ? OFF_AB : OFF_AF), wsp<bf16_t>(F, dir ? OFF_EB : OFF_EF), wsp<bf16_t>(F, OFF_RV)};
        const int slot[5] = {SL_A, SL_K, SL_B, SL_T, SL_V}; stage_raw_n<5>(src, slot, T, wl, lane); }
    const float ka = F.in[I_KA][(size_t)l * 512 + T.h * 64 + lane];
    float E2 = 0.f, gprev = 1.f;
    lane = launder(lane);
    const int tw = ((lane >> 3) << 4), tb = (lane & 7) * 2;
#pragma unroll 1
    for (int t8 = 0; t8 < 8; ++t8) {
        float kk_[8], k_[8], al_[8], e_[8], r_[8]; int off_[8];
#pragma unroll
        for (int j = 0; j < 8; ++j) { const int t = t8 * 8 + j; off_[j] = t * 128 + (tw ^ (((t >> 1) & 7) << 4)) + tb;
            kk_[j] = bf2f(*(const LAS bf16_t*)(wl + SL_A + off_[j])); k_[j] = bf2f(*(const LAS bf16_t*)(wl + SL_K + off_[j])); al_[j] = bf2f(*(const LAS bf16_t*)(wl + SL_B + off_[j]));
            e_[j] = bf2f(*(const LAS bf16_t*)(wl + SL_T + off_[j])); r_[j] = P3 ? bf2f(*(const LAS bf16_t*)(wl + SL_R + off_[j])) : 0.f; }
#pragma unroll
        for (int j = 0; j < 8; ++j) {
            E2 += e_[j] * 1.4426950408889634f;
            const float g = __builtin_amdgcn_exp2f(-E2), ex = __builtin_amdgcn_rcpf(g);
            const float at = -kk_[j] * gprev, bh = kk_[j] * al_[j] * ex, kh = k_[j] * (1.0f + (al_[j] - 1.0f) * ka) * ex;
            gprev = g;
            if (P3) *(LAS bf16_t*)(wl + SL_R + off_[j]) = f2bf(r_[j] * g);
            *(LAS bf16_t*)(wl + SL_A + off_[j]) = f2bf(at); *(LAS bf16_t*)(wl + SL_B + off_[j]) = f2bf(bh); *(LAS bf16_t*)(wl + SL_K + off_[j]) = f2bf(kh);
        }
    }
    { unsigned vcm[32]; read_col(wl + SL_V, vcm, lane); write_cm_row(wl + SL_V, vcm, lane); }
    return gprev;
}
DI void make_table(lds_t wl, int l32, int h, int slot_b = SL_B) {
    l32 = launder(l32); h = launder(h);
    f32x16 acc[2][2]; zero_acc(acc); mm_nn(acc, wl + slot_b, wl + SL_A, l32, h);
#pragma unroll
    for (int it = 0; it < 2; ++it)
#pragma unroll
        for (int tt = 0; tt < 2; ++tt)
#pragma unroll
            for (int q = 0; q < 4; ++q) { if (it > tt) continue;
                const int t = 32 * tt + l32, i0 = 8 * q + 4 * h; float v[4];
#pragma unroll
                for (int e = 0; e < 4; ++e) v[e] = (it < tt || i0 + e < l32) ? acc[it][tt][4 * q + e] : 0.f;
                u32x2 w; w.x = pk2(v[0], v[1]); w.y = pk2(v[2], v[3]);
                *(LAS u32x2*)(wl + SL_T + swz(t, 4 * it + q) + 8 * h) = w; }
}
DI void scan_pass1(const Frame& F, int l) {
    const int lane = F.lane, l32 = lane & 31, h = lane >> 5, pr = F.wid >> 1, role = F.wid & 1;
    lds_t wl = F.lds + (pr < 3 ? pr : 0) * WAVE_LDS; LAS float* gtab = (LAS float*)(F.lds + MISC_OFF + 512 + (pr < 3 ? pr : 0) * 256);
    u32x4* MP = wsp<u32x4>(F, OFF_MP); u32x4* NS = wsp<u32x4>(F, OFF_NS);
    const int ntrip = (32 * NCHUNK + F.G * 3 - 1) / (F.G * 3);
    u32x4 pf[3][8];
#define P1_REQUEST(task_) do { const ScanTask Tq_ = scan_task(task_); const int dq_ = Tq_.chain >> 4; const int ln_ = launder(lane); \
        const bf16_t* s0_ = role ? wsp<bf16_t>(F, OFF_RK) : wsp<bf16_t>(F, OFF_RKK); const bf16_t* s1_ = role ? wsp<bf16_t>(F, OFF_RV) : wsp<bf16_t>(F, dq_ ? OFF_AB : OFF_AF); const bf16_t* s2_ = wsp<bf16_t>(F, dq_ ? OFF_EB : OFF_EF); \
        __builtin_amdgcn_sched_barrier(0); \
        _Pragma("unroll") for (int i_ = 0; i_ < 8; ++i_) { const int q_ = ln_ + 64 * i_, t_ = q_ >> 3, c8_ = q_ & 7; const size_t ro_ = (size_t)(Tq_.r0 + Tq_.sgn * t_) * 512 + Tq_.h * 64 + c8_ * 8; \
            pf[0][i_] = *(const u32x4*)(s0_ + ro_); pf[1][i_] = *(const u32x4*)(s1_ + ro_); if (role == 0) pf[2][i_] = *(const u32x4*)(s2_ + ro_); else asm volatile("" : "=v"(pf[2][i_].x), "=v"(pf[2][i_].y), "=v"(pf[2][i_].z), "=v"(pf[2][i_].w)); } \
        __builtin_amdgcn_sched_barrier(0); } while (0)
#define P1_UNDEF() do { _Pragma("unroll") for (int p_ = 0; p_ < 3; ++p_) _Pragma("unroll") for (int i_ = 0; i_ < 8; ++i_) asm volatile("" : "=v"(pf[p_][i_].x), "=v"(pf[p_][i_].y), "=v"(pf[p_][i_].z), "=v"(pf[p_][i_].w)); } while (0)
    { const int t0_ = pr < 3 ? scan_deal(F.bid, pr, 0, F.G) : -1; if (t0_ >= 0) P1_REQUEST(t0_); else P1_UNDEF(); }
    for (int trip = 0; trip < ntrip; ++trip) {
        const int task_ = pr < 3 ? scan_deal(F.bid, pr, trip, F.G) : -1; const bool on = task_ >= 0; const int task = on ? task_ : 0;
        ScanTask T = scan_task(on ? task : 0); const int dir = T.chain >> 4; (void)dir;
        const int tw = ((launder(lane) >> 3) << 4), tb = (launder(lane) & 7) * 2;
        if (on) { const int ln_ = launder(lane);
#pragma unroll
            for (int i_ = 0; i_ < 8; ++i_) { const int q_ = ln_ + 64 * i_, t_ = q_ >> 3, c8_ = q_ & 7;
                *(LAS u32x4*)(wl + (role ? SL_K : SL_A) + swz(t_, c8_)) = pf[0][i_]; *(LAS u32x4*)(wl + (role ? SL_V : SL_B) + swz(t_, c8_)) = pf[1][i_]; if (role == 0) *(LAS u32x4*)(wl + SL_T + swz(t_, c8_)) = pf[2][i_]; } }
        __syncthreads();
        if (on) {
            const float ka = F.in[I_KA][(size_t)l * 512 + T.h * 64 + lane];
            float E2 = 0.f, gprev = 1.f;
#pragma unroll 1
            for (int t8 = 0; t8 < 8; ++t8) {
                float x_[8], al_[8], e_[8]; int off_[8];
#pragma unroll
                for (int j = 0; j < 8; ++j) { const int t = t8 * 8 + j; off_[j] = t * 128 + (tw ^ (((t >> 1) & 7) << 4)) + tb;
                    x_[j] = bf2f(*(const LAS bf16_t*)(wl + (role ? SL_K : SL_A) + off_[j])); al_[j] = bf2f(*(const LAS bf16_t*)(wl + SL_B + off_[j])); e_[j] = bf2f(*(const LAS bf16_t*)(wl + SL_T + off_[j])); }
#pragma unroll
                for (int j = 0; j < 8; ++j) {
                    E2 += e_[j] * 1.4426950408889634f;
                    const float g = __builtin_amdgcn_exp2f(-E2), ex = __builtin_amdgcn_rcpf(g);
                    if (role == 0) { *(LAS bf16_t*)(wl + SL_A + off_[j]) = f2bf(-x_[j] * gprev); *(LAS bf16_t*)(wl + SL_R + off_[j]) = f2bf(x_[j] * al_[j] * ex); }
                    else *(LAS bf16_t*)(wl + SL_K + off_[j]) = f2bf(x_[j] * (1.0f + (al_[j] - 1.0f) * ka) * ex);
                    gprev = g;
                }
            }
            if (role == 0) gtab[lane] = gprev;
            else { unsigned vcm[32]; read_col(wl + SL_V, vcm, lane); write_cm_row(wl + SL_V, vcm, lane); }
        }
        __syncthreads();
        if (on) {
            if (role == 0) make_table(wl, l32, h, SL_R);
            else { bf16x8 xf[2][2][2];
                { f32x16 acc[2][2]; zero_acc(acc); mm_nn(acc, wl + SL_K, wl + SL_A, l32, h); pack_masked<0>(acc, xf, l32, h); }
                __builtin_amdgcn_sched_barrier(0);
                { f32x16 acc[2][2]; zero_acc(acc); mm_xt(acc, xf, wl + SL_V, l32, h); store_tm(acc, wl + SL_B, l32, h); } }
        }
        __syncthreads();
        if (on) {
            if (role == 0) { unsigned bcm[32]; read_col(wl + SL_R, bcm, lane); __builtin_amdgcn_sched_barrier(0);
                solve_rows(wl + SL_A, wl + SL_T, wl + SL_R, lane); __builtin_amdgcn_sched_barrier(0);
                write_cm_row(wl + SL_A, bcm, lane); }
            else { unsigned kcm[32]; read_col(wl + SL_K, kcm, lane); __builtin_amdgcn_sched_barrier(0);
                solve_rows(wl + SL_B, wl + SL_T, wl + SL_K, lane); __builtin_amdgcn_sched_barrier(0);
                write_cm_row(wl + SL_B, kcm, lane); }
        }
        __syncthreads();
        { const int tn_ = (pr < 3 && trip + 1 < ntrip) ? scan_deal(F.bid, pr, trip + 1, F.G) : -1; if (tn_ >= 0) P1_REQUEST(tn_); else P1_UNDEF(); }
        if (on) {
            if (role == 0) { u32x4* mp = MP + (size_t)task * 512 + launder(lane);
                f32x16 acc[2][2]; zero_acc(acc); mm_nn_lp(acc, wl + SL_R, wl + SL_A, l32, h);
#pragma unroll
                for (int ct = 0; ct < 2; ++ct)
#pragma unroll
                    for (int cp = 0; cp < 2; ++cp) { const float gc = gtab[32 * cp + launder(l32)]; f32x16 m;
#pragma unroll
                        for (int r = 0; r < 16; ++r) m[r] = (acc[ct][cp][r] + ((ct == cp && crow_(r, h) == l32) ? 1.0f : 0.0f)) * gc;
                        mp[((ct * 2 + cp) * 2 + 0) * 64] = __builtin_bit_cast(u32x4, pack_regs(m, 0)); mp[((ct * 2 + cp) * 2 + 1) * 64] = __builtin_bit_cast(u32x4, pack_regs(m, 1)); }
            } else { u32x4* ns = NS + (size_t)task * 512 + launder(lane);
                f32x16 acc[2][2]; zero_acc(acc); mm_nn_lp(acc, wl + SL_A, wl + SL_K, l32, h); mm_nn_lp(acc, wl + SL_B, wl + SL_V, l32, h);
#pragma unroll
                for (int cp = 0; cp < 2; ++cp)
#pragma unroll
                    for (int vt = 0; vt < 2; ++vt) { f32x16 m;
#pragma unroll
                        for (int q = 0; q < 4; ++q) { const f32x4 g4 = *(const LAS f32x4*)(gtab + 32 * cp + 8 * q + 4 * h);
#pragma unroll
                            for (int e = 0; e < 4; ++e) m[4 * q + e] = acc[cp][vt][4 * q + e] * g4[e]; }
                        ns[((cp * 2 + vt) * 2 + 0) * 64] = __builtin_bit_cast(u32x4, pack_regs(m, 0)); ns[((cp * 2 + vt) * 2 + 1) * 64] = __builtin_bit_cast(u32x4, pack_regs(m, 1)); }
            }
        }
        __syncthreads();
    }
#undef P1_REQUEST
#undef P1_UNDEF
}
DI void scan_pass2(const Frame& F) {
    if (F.wid != 0) return;
    const int lane = F.lane;
    for (int task = F.bid; task < 64; task += F.G) {
        const int chain = task >> 1, vt = task & 1;
        const u32x4* MP = wsp<u32x4>(F, OFF_MP) + (size_t)chain * NCHUNK * 512 + lane; u32x4* NS = wsp<u32x4>(F, OFF_NS) + (size_t)chain * NCHUNK * 512 + lane;
        u32x4 sf[2][2], mA[8], nA[2][2], mB[8], nB[2][2], mC[8], nC[2][2];
#define P2_LOAD(m_, n_, ck_) do { _Pragma("unroll") for (int i_ = 0; i_ < 8; ++i_) m_[i_] = MP[(size_t)(ck_) * 512 + i_ * 64]; \
        _Pragma("unroll") for (int a_ = 0; a_ < 2; ++a_) _Pragma("unroll") for (int st_ = 0; st_ < 2; ++st_) n_[a_][st_] = NS[(size_t)(ck_) * 512 + ((a_ * 2 + vt) * 2 + st_) * 64]; } while (0)
#define P2_STEP(m_, n_, ck_) do { \
        _Pragma("unroll") for (int a_ = 0; a_ < 2; ++a_) _Pragma("unroll") for (int st_ = 0; st_ < 2; ++st_) NS[(size_t)(ck_) * 512 + ((a_ * 2 + vt) * 2 + st_) * 64] = sf[a_][st_];        \
        f32x16 acc_[2]; \
        _Pragma("unroll") for (int cp_ = 0; cp_ < 2; ++cp_) _Pragma("unroll") for (int st_ = 0; st_ < 2; ++st_) { float f_[8]; unpack8(n_[cp_][st_], f_); \
            _Pragma("unroll") for (int j_ = 0; j_ < 8; ++j_) acc_[cp_][8 * st_ + j_] = f_[j_]; } \
        _Pragma("unroll") for (int ct_ = 0; ct_ < 2; ++ct_) _Pragma("unroll") for (int st_ = 0; st_ < 2; ++st_) _Pragma("unroll") for (int cp_ = 0; cp_ < 2; ++cp_) \
            acc_[cp_] = MFMA32(__builtin_bit_cast(bf16x8, m_[(ct_ * 2 + cp_) * 2 + st_]), __builtin_bit_cast(bf16x8, sf[ct_][st_]), acc_[cp_]); \
        _Pragma("unroll") for (int ct_ = 0; ct_ < 2; ++ct_) { sf[ct_][0] = __builtin_bit_cast(u32x4, pack_regs(acc_[ct_], 0)); sf[ct_][1] = __builtin_bit_cast(u32x4, pack_regs(acc_[ct_], 1)); } } while (0)
#pragma unroll
        for (int a = 0; a < 2; ++a)
#pragma unroll
            for (int st = 0; st < 2; ++st) sf[a][st] = (u32x4){0u, 0u, 0u, 0u};
        P2_LOAD(mA, nA, 0); P2_LOAD(mB, nB, 1);
        for (int ck = 0; ck < NCHUNK; ck += 3) {
            { const int nx = ck + 2 < NCHUNK ? ck + 2 : NCHUNK - 1; P2_LOAD(mC, nC, nx); }
            P2_STEP(mA, nA, ck);
            if (ck + 1 < NCHUNK) { { const int nx = ck + 3 < NCHUNK ? ck + 3 : NCHUNK - 1; P2_LOAD(mA, nA, nx); } P2_STEP(mB, nB, ck + 1); }
            if (ck + 2 < NCHUNK) { { const int nx = ck + 4 < NCHUNK ? ck + 4 : NCHUNK - 1; P2_LOAD(mB, nB, nx); } P2_STEP(mC, nC, ck + 2); }
        }
#undef P2_LOAD
#undef P2_STEP
    }
}
DI void scan_pass3(const Frame& F, int l) {
    if (F.wid >= 3) return;
    const int lane = F.lane, l32 = lane & 31, h = lane >> 5;
    lds_t wl = F.lds + F.wid * WAVE_LDS;
    const u32x4* NS = wsp<u32x4>(F, OFF_NS);
    const int ntrip3 = (32 * NCHUNK + F.G * 3 - 1) / (F.G * 3);
    for (int trip = 0; trip < ntrip3; ++trip) {
        const int task = scan_deal(F.bid, F.wid, trip, F.G); if (task < 0) continue;
        const ScanTask T = scan_task(task);
        (void)scan_prep<true>(F, l, T, wl, lane);
        make_table(wl, l32, h);
#define SB_ __builtin_amdgcn_sched_barrier(0)
#define LOAD_SF() do { const u32x4* ns = NS + (size_t)task * 512 + lane; _Pragma("unroll") for (int i = 0; i < 8; ++i) sf[i >> 2][(i >> 1) & 1][i & 1] = __builtin_bit_cast(bf16x8, ns[i * 64]); } while (0)
        bf16x8 xf[2][2][2], xg[2][2][2];
        { f32x16 acc[2][2]; zero_acc(acc); mm_nn(acc, wl + SL_K, wl + SL_A, l32, h); pack_masked<0>(acc, xf, l32, h); }
        SB_;
        { bf16x8 sf[2][2][2]; LOAD_SF(); f32x16 acc[2][2]; zero_acc(acc); mm_st(acc, wl + SL_A, sf, l32, h); SB_; mm_xt(acc, xf, wl + SL_V, l32, h); SB_; store_tm(acc, wl + SL_A, l32, h); }
        SB_;
        { f32x16 acc[2][2]; zero_acc(acc); mm_nn(acc, wl + SL_B, wl + SL_R, l32, h); pack_masked<1>(acc, xf, l32, h); }
        SB_;
        solve_rows(wl + SL_A, wl + SL_T, wl + SL_B, lane);
        SB_;
        unsigned tch[7]; const int tn_ = trip + 1 < ntrip3 ? scan_deal(F.bid, F.wid, trip + 1, F.G) : -1;
        if (tn_ >= 0) { const ScanTask Tn = scan_task(tn_); const int dn = Tn.chain >> 4; const size_t ro = (size_t)(Tn.r0 + Tn.sgn * launder(lane)) * 512 + Tn.h * 64;
            tch[0] = *(const unsigned*)(wsp<bf16_t>(F, OFF_RKK) + ro); tch[1] = *(const unsigned*)(wsp<bf16_t>(F, OFF_RK) + ro); tch[2] = *(const unsigned*)(wsp<bf16_t>(F, dn ? OFF_AB : OFF_AF) + ro);
            tch[3] = *(const unsigned*)(wsp<bf16_t>(F, dn ? OFF_EB : OFF_EF) + ro); tch[4] = *(const unsigned*)(wsp<bf16_t>(F, OFF_RV) + ro); tch[5] = *(const unsigned*)(wsp<bf16_t>(F, OFF_RR) + ro);
            tch[6] = *((const unsigned*)(NS + (size_t)tn_ * 512) + launder(lane) * 32); }
        else {
#pragma unroll
            for (int i = 0; i < 7; ++i) tch[i] = 0u; }
        SB_;
        f32x16 y[2][2]; zero_acc(y);
        mm_xt(y, xf, wl + SL_B, l32, h);
        SB_;
        { bf16x8 sf[2][2][2]; LOAD_SF(); mm_st(y, wl + SL_R, sf, l32, h); }
        SB_;
        { f32x16 acc[2][2]; zero_acc(acc); mm_nn(acc, wl + SL_K, wl + SL_R, l32, h); pack_masked<1>(acc, xg, l32, h); }
        SB_;
        mm_xt(y, xg, wl + SL_V, l32, h);
        SB_;
#undef LOAD_SF
        bf16_t* Y = wsp<bf16_t>(F, (T.chain >> 4) ? OFF_YB : OFF_YF);
        store_tm(y, wl + SL_A, l32, h);
        { const int ln = launder(lane);
#pragma unroll
          for (int i = 0; i < 8; ++i) { const int q = ln + 64 * i, t = q >> 3, c8 = q & 7;
              *(u32x4*)(Y + (size_t)(T.r0 + T.sgn * t) * 512 + T.h * 64 + c8 * 8) = *(const LAS u32x4*)(wl + SL_A + swz(t, c8)); } }
#pragma unroll
        for (int i = 0; i < 7; ++i) asm volatile("" :: "v"(tch[i]));
    }
}
DI void rwkv_out_rows(const Frame& F, int l, int r_begin) {
    const int gw = F.bid * 8 + F.wid, nw = F.G * 8, lane = F.lane, c0 = 8 * lane;
    const bf16_t* RR = wsp<bf16_t>(F, OFF_RR); const bf16_t* RK = wsp<bf16_t>(F, OFF_RK); const bf16_t* RV = wsp<bf16_t>(F, OFF_RV);
    const bf16_t* AF = wsp<bf16_t>(F, OFF_AF); const bf16_t* AB = wsp<bf16_t>(F, OFF_AB); const bf16_t* GG = wsp<bf16_t>(F, OFF_GG);
    bf16_t* YF = wsp<bf16_t>(F, OFF_YF); const bf16_t* YB = wsp<bf16_t>(F, OFF_YB);
    float ka[8], rk[8], gw_[8], gb_[8];
#pragma unroll
    for (int e = 0; e < 8; ++e) { ka[e] = F.in[I_KA][(size_t)l * 512 + c0 + e]; rk[e] = F.in[I_RK][(size_t)l * 512 + c0 + e]; gw_[e] = F.in[I_GNW][(size_t)l * 512 + c0 + e]; gb_[e] = F.in[I_GNB][(size_t)l * 512 + c0 + e]; }
    for (int ra = r_begin + gw; ra < MROWS; ra += 2 * nw) {
        const bool two = ra + nw < MROWS; u32x4 w[2][8];
#pragma unroll
        for (int q = 0; q < 2; ++q) { const size_t ro = (size_t)(q && two ? ra + nw : ra) * 512 + c0;
            w[q][0] = *(const u32x4*)(YF + ro); w[q][1] = *(const u32x4*)(YB + ro); w[q][2] = *(const u32x4*)(RR + ro); w[q][3] = *(const u32x4*)(RK + ro); w[q][4] = *(const u32x4*)(RV + ro);
            w[q][5] = *(const u32x4*)(AF + ro); w[q][6] = *(const u32x4*)(AB + ro); w[q][7] = *(const u32x4*)(GG + ro); }
#pragma unroll
        for (int q = 0; q < 2; ++q) { if (q && !two) break;
            const size_t ro = (size_t)(q ? ra + nw : ra) * 512 + c0; float yf[8], yb[8], y[8], rr[8], k[8], v[8], af[8], ab[8], g[8];
            unpack8(w[q][0], yf); unpack8(w[q][1], yb); unpack8(w[q][2], rr); unpack8(w[q][3], k); unpack8(w[q][4], v); unpack8(w[q][5], af); unpack8(w[q][6], ab); unpack8(w[q][7], g);
            float s = 0.f;
#pragma unroll
            for (int e = 0; e < 8; ++e) { y[e] = yf[e] + yb[e]; s += y[e]; }
            const float mean = sum8(s) * (1.0f / 64.0f); float qq = 0.f, cf = 0.f;
#pragma unroll
            for (int e = 0; e < 8; ++e) { const float d = y[e] - mean; qq += d * d; const float kmf = k[e] * (1.0f + (af[e] - 1.0f) * ka[e]), kmb = k[e] * (1.0f + (ab[e] - 1.0f) * ka[e]); cf += rr[e] * (kmf + kmb) * rk[e]; }
            const float rstd = rsqrtf(sum8(qq) * (1.0f / 64.0f) + 64e-5f); cf = sum8(cf);
            float o[8];
#pragma unroll
            for (int e = 0; e < 8; ++e) o[e] = ((y[e] - mean) * rstd * gw_[e] + gb_[e] + cf * v[e]) * g[e];
            *(u32x4*)(YF + ro) = pack8(o); }
    }
}

struct RouteRec { int e0, e1; float g0, g1; int s0, s1; int pad0, pad1; };
DI void route_phase(const Frame& F, int l, int r_begin) {
    LAS int* hist = (LAS int*)(F.lds);
    if (F.tid < 32) hist[F.tid] = 0;
    __syncthreads();
    const float* lg = wsp<const float>(F, OFF_LOGITS); RouteRec* rec = wsp<RouteRec>(F, OFF_ROUTE);
    { int* st = wsp<int>(F, OFF_SLOTTOK); for (int i = F.bid * 512 + F.tid; i < PMAX; i += F.G * 512) st[i] = 0; }
    for (int tok = r_begin + F.bid * 512 + F.tid; tok < MROWS; tok += F.G * 512) {
        const float* p = lg + (size_t)tok * 64; const f32x4 g4 = *(const f32x4*)p;
        int grp = 0; float mx = g4[0];
#pragma unroll
        for (int i = 1; i < 4; ++i) if (g4[i] > mx) { mx = g4[i]; grp = i; }
        float den = 0.f;
#pragma unroll
        for (int i = 0; i < 4; ++i) den += __expf(g4[i] - mx);
        const float pg = 1.0f / den;
        const f32x4 ea = *(const f32x4*)(p + 4 + grp * 8), eb = *(const f32x4*)(p + 8 + grp * 8); float le[8] = {ea[0], ea[1], ea[2], ea[3], eb[0], eb[1], eb[2], eb[3]};
        int i1 = 0; float v1 = le[0];
#pragma unroll
        for (int i = 1; i < 8; ++i) if (le[i] > v1) { v1 = le[i]; i1 = i; }
        int i2 = -1; float v2 = -3.0e38f;
#pragma unroll
        for (int i = 0; i < 8; ++i) if (i != i1 && le[i] > v2) { v2 = le[i]; i2 = i; }
        const float ex = __expf(v2 - v1), w1 = 1.0f / (1.0f + ex), w2 = ex * w1;
        RouteRec rc; rc.e0 = grp * 8 + i1; rc.e1 = grp * 8 + i2; rc.g0 = pg * w1; rc.g1 = pg * w2; rc.s0 = 0; rc.s1 = 0; rc.pad0 = 0; rc.pad1 = 0;
        rec[tok] = rc;
        __hip_atomic_fetch_add(&hist[rc.e0], 1, __ATOMIC_RELAXED, __HIP_MEMORY_SCOPE_WORKGROUP); __hip_atomic_fetch_add(&hist[rc.e1], 1, __ATOMIC_RELAXED, __HIP_MEMORY_SCOPE_WORKGROUP);
    }
    __syncthreads();
    if (F.tid < 32 && hist[F.tid]) atomicAdd(wsp<int>(F, OFF_CTL) + CW_CNT + l * 32 + F.tid, hist[F.tid]);
}
DI void build_tab(const Frame& F, int l, LAS int* tab) {
    if (F.tid < 64) { const int* cnt = wsp<int>(F, OFF_CTL) + CW_CNT + l * 32; const int lane = F.tid;
        int v = lane < 32 ? ((__hip_atomic_load(cnt + lane, __ATOMIC_RELAXED, __HIP_MEMORY_SCOPE_AGENT) + 255) >> 8) : 0;
        int inc = v;
#pragma unroll
        for (int sft = 1; sft < 32; sft <<= 1) { const int o = __shfl_up(inc, sft); if (lane >= sft) inc += o; }
        if (lane < 32) tab[lane] = inc - v;
        if (lane == 31) tab[32] = inc; }
    __syncthreads();
}
DI void assign_gather_phase(const Frame& F, int l, int r_begin) {
    LAS int* tab = (LAS int*)(F.lds + MISC_OFF + 64); LAS int* lcnt = tab + 40; LAS int* gbase = lcnt + 32;
    build_tab(F, l, tab);
    if (F.tid < 32) lcnt[F.tid] = 0;
    __syncthreads();
    const int per = (MROWS - r_begin + F.G - 1) / F.G, t0 = r_begin + F.bid * per, t1 = min(MROWS, t0 + per);
    RouteRec* rec = wsp<RouteRec>(F, OFF_ROUTE);
    int e0 = 0, e1 = 0, r0 = 0, r1 = 0; const int tok = t0 + F.tid; const bool act = tok < t1;
    if (act) { e0 = rec[tok].e0; e1 = rec[tok].e1; r0 = __hip_atomic_fetch_add(&lcnt[e0], 1, __ATOMIC_RELAXED, __HIP_MEMORY_SCOPE_WORKGROUP); r1 = __hip_atomic_fetch_add(&lcnt[e1], 1, __ATOMIC_RELAXED, __HIP_MEMORY_SCOPE_WORKGROUP); }
    __syncthreads();
    if (F.tid < 32) { const int n = lcnt[F.tid]; gbase[F.tid] = tab[F.tid] * 256 + (n ? atomicAdd(wsp<int>(F, OFF_CTL) + CW_CUR + l * 32 + F.tid, n) : 0); }
    __syncthreads();
    if (act) { const int s0 = gbase[e0] + r0, s1 = gbase[e1] + r1; rec[tok].s0 = s0; rec[tok].s1 = s1; int* st = wsp<int>(F, OFF_SLOTTOK); st[s0] = tok; st[s1] = tok; }
}
template <bool NEXT>
DI void combine_rows(const Frame& F, int l, int r_begin, const float* gn, bf16_t* xn) {
    const int gw = F.bid * 8 + F.wid, nw = F.G * 8;
    const RouteRec* rec = wsp<RouteRec>(F, OFF_ROUTE); const bf16_t* YB = wsp<bf16_t>(F, OFF_YBUF); float* ctxb = wsp<float>(F, OFF_CTX);
    for (int r = r_begin + gw; r < MROWS; r += nw) {
        const RouteRec rc = rec[r]; const int cond = row_cond(r); const float* gate = modp(F, l, cond, 5);
        float* xr = r < NCTX ? ctxb + (size_t)r * DM : F.out + (size_t)(r - NCTX) * DM;
        f32x4 xv[2][2]; float ss = 0.f;
        u32x4 wy0[2], wy1[2]; f32x4 xa_[2], xb_[2], ga_[2], gb_[2], g4_[2][2], s4_[2][2], c4_[2][2];
        const float* sh = modp(F, l + 1, cond, 0); const float* sc = modp(F, l + 1, cond, 1);
#pragma unroll
        for (int j = 0; j < 2; ++j) { const int c0 = 8 * F.lane + 512 * j;
            wy0[j] = *(const u32x4*)(YB + (size_t)rc.s0 * DM + c0); wy1[j] = *(const u32x4*)(YB + (size_t)rc.s1 * DM + c0);
            xa_[j] = *(const f32x4*)(xr + c0); xb_[j] = *(const f32x4*)(xr + c0 + 4); ga_[j] = *(const f32x4*)(gate + c0); gb_[j] = *(const f32x4*)(gate + c0 + 4);
            if (NEXT) {
#pragma unroll
                for (int q = 0; q < 2; ++q) { g4_[j][q] = *(const f32x4*)(gn + c0 + 4 * q); s4_[j][q] = *(const f32x4*)(sh + c0 + 4 * q); c4_[j][q] = *(const f32x4*)(sc + c0 + 4 * q); } } }
#pragma unroll
        for (int j = 0; j < 2; ++j) { const int c0 = 8 * F.lane + 512 * j; float y0[8], y1[8];
            unpack8(wy0[j], y0); unpack8(wy1[j], y1);
            f32x4 xa = xa_[j], xb = xb_[j]; const f32x4 ga = ga_[j], gb = gb_[j];
#pragma unroll
            for (int e = 0; e < 4; ++e) { xa[e] += ga[e] * (rc.g0 * y0[e] + rc.g1 * y1[e]); xb[e] += gb[e] * (rc.g0 * y0[4 + e] + rc.g1 * y1[4 + e]); }
            *(f32x4*)(xr + c0) = xa; *(f32x4*)(xr + c0 + 4) = xb;
            if (NEXT) { xv[j][0] = xa; xv[j][1] = xb;
#pragma unroll
                for (int e = 0; e < 4; ++e) ss += xa[e] * xa[e] + xb[e] * xb[e]; } }
        if (NEXT) {
            ss = wave_sum(ss); const float inv = rsqrtf(ss * (1.0f / DM) + 1e-6f);
#pragma unroll
            for (int j = 0; j < 2; ++j) { const int c0 = 8 * F.lane + 512 * j; float o[8];
#pragma unroll
                for (int q = 0; q < 2; ++q) { const f32x4 g4 = g4_[j][q], s4 = s4_[j][q], c4 = c4_[j][q];
#pragma unroll
                    for (int e = 0; e < 4; ++e) o[4 * q + e] = (xv[j][q][e] * inv * g4[e]) * (1.0f + c4[e]) + s4[e]; }
                *(u32x4*)(xn + (size_t)r * DM + c0) = pack8(o); }
        }
    }
}

constexpr int PH_PER_LAYER = 19, N_PHASES = 1 + 2 * PH_PER_LAYER;
#if MK_ONE_LAUNCH
#define GRID_BAR() xcd_barrier(bar)
#else
#define GRID_BAR() do { } while (0)
#endif
#ifndef PH_MASK
#define PH_MASK 0xFFFFFFFFu
#endif
#define PON(j) (((PH_MASK) >> (j)) & 1u)
#ifndef REP_MASK
#define REP_MASK 0u
#endif
#define REPEAT(j) for (int rep_ = 0; rep_ < 1 + (int)(((REP_MASK) >> (j)) & 1u); ++rep_)
#define IN(k) (lo <= (k) && (k) < hi)
#define SEAM(k) do { if (IN((k) + 1)) GRID_BAR(); } while (0)
template <int l, class BarT>
DI void layer_phases(const Frame& F0, const int lo, const int hi, const BarT& bar) {
        const Frame& F = F0;
        constexpr bool LAST = (l == EN_LAYERS - 1);
        constexpr int RB = LAST ? NCTX : 0, PM0 = LAST ? 2 : 0;
        const int pb = 1 + l * PH_PER_LAYER;
        const float* xlat = l == 0 ? F.in[I_X] : F.out;
        const float* modl = wsp<const float>(F, OFF_MOD) + (size_t)l * 3 * 6144;
        if (PON(0) && IN(pb + 0)) { const Frame F = phase_frame(F0); REPEAT(0) {  if (l == 0) norm_rows(F, xlat, F.in[I_N1G] + (size_t)l * DM, l, 0, 1, wsp<bf16_t>(F, OFF_XN));  } if (l == 0) SEAM(pb + 0); }
        if (PON(1) && IN(pb + 1)) { const Frame F = phase_frame(F0); REPEAT(1) {  pg8::Gemm g{wsp<bf16_t>(F, OFF_XN), wsp<bf16_t>(F, OFF_WIN), DM, nullptr, nullptr}; pg8::StaticOrder S; S.init(MROWS, N_INP, F.G, F.bid); EpiInproj E{F.ws};
            pg8::gemm_phase(F.lds, g, S, E, F.tid);  } SEAM(pb + 1); }
        if (PON(2) && IN(pb + 2)) { const Frame F = phase_frame(F0); REPEAT(2) {  phaseC_rows(F, l); __syncthreads(); phaseC_vt(F);  } SEAM(pb + 2); }
        if (PON(3) && IN(pb + 3)) { const Frame F = phase_frame(F0); REPEAT(3) {  pg8::Gemm g{wsp<bf16_t>(F, OFF_ALORA), wsp<bf16_t>(F, OFF_WLORA), LORA_K, nullptr, nullptr}; pg8::StaticOrder S; S.init(MROWS, LORA_N, F.G, F.bid);
            EpiLora E{F.ws, F.in[I_DW0] + (size_t)l * 1024, F.in[I_AA0] + (size_t)l * 1024};
            pg8::gemm_phase(F.lds, g, S, E, F.tid);  } SEAM(pb + 3); }
        if (PON(4) && IN(pb + 4)) { const Frame F = phase_frame(F0); REPEAT(4) {  attn_phase(F, l, LAST ? 512 : 520);  } SEAM(pb + 4); }
        if (PON(5) && IN(pb + 5)) { const Frame F = phase_frame(F0); REPEAT(5) {  scan_pass1(F, l);  } SEAM(pb + 5); }
        if (PON(6) && IN(pb + 6)) { const Frame F = phase_frame(F0); REPEAT(6) {  scan_pass2(F);  } SEAM(pb + 6); }
        if (PON(7) && IN(pb + 7)) { const Frame F = phase_frame(F0); REPEAT(7) {  scan_pass3(F, l);  } SEAM(pb + 7); }
        if (PON(8) && IN(pb + 8)) { const Frame F = phase_frame(F0); REPEAT(8) {  rwkv_out_rows(F, l, RB); norm_rows(F, xlat, F.in[I_N1G] + (size_t)l * DM, l, 0, 1, wsp<bf16_t>(F, OFF_XN2), RB);  } SEAM(pb + 8); }
        if (PON(9) && IN(pb + 9)) { const Frame F = phase_frame(F0); REPEAT(9) {  pg8::Gemm g{wsp<bf16_t>(F, OFF_XN2), wsp<bf16_t>(F, OFF_WIN) + (size_t)N_INP * DM, DM, nullptr, nullptr}; pg8::StaticOrder S; S.init(MROWS, N_GATE, F.G, F.bid, PM0); EpiGates E{wsp<bf16_t>(F, OFF_G)};
            pg8::gemm_phase(F.lds, g, S, E, F.tid);  } SEAM(pb + 9); }
        if (PON(10) && IN(pb + 10)) { const Frame F = phase_frame(F0); REPEAT(10) {
            pg8::Gemm g{wsp<bf16_t>(F, OFF_PDIFF), wsp<bf16_t>(F, OFF_WMG), 1536, wsp<bf16_t>(F, OFF_POOL), wsp<bf16_t>(F, OFF_YF)}; pg8::StaticOrder S; S.init(MROWS, DM, F.G, F.bid, PM0);
            EpiMerge E{wsp<bf16_t>(F, OFF_G), wsp<bf16_t>(F, OFF_MERGED)};
            pg8::gemm_phase(F.lds, g, S, E, F.tid); } SEAM(pb + 10); }
        if (PON(11) && IN(pb + 11)) { const Frame F = phase_frame(F0); REPEAT(11) {  pg8::Gemm g{wsp<bf16_t>(F, OFF_MERGED), wsp<bf16_t>(F, OFF_WOUT), DM, nullptr, nullptr}; pg8::StaticOrder S; S.init(MROWS, DM, F.G, F.bid, PM0); EpiResid E{xlat, F.out, wsp<float>(F, OFF_CTX), modl};
            pg8::gemm_phase(F.lds, g, S, E, F.tid);  } SEAM(pb + 11); }
#if EN_MOE
        if (PON(12) && IN(pb + 12)) { const Frame F = phase_frame(F0); REPEAT(12) {  conv_router_weights(F, l); norm_rows(F, F.out, F.in[I_N2G] + (size_t)l * DM, l, 3, 4, wsp<bf16_t>(F, OFF_XN), RB);  } SEAM(pb + 12); }
        if (PON(13) && IN(pb + 13)) { const Frame F = phase_frame(F0); REPEAT(13) {  pg8::Gemm g{wsp<bf16_t>(F, OFF_XN), wsp<bf16_t>(F, OFF_WRT), DM, nullptr, nullptr}; pg8::StaticOrder S; S.init(MROWS, 256, F.G, F.bid, PM0); EpiLogits E{wsp<float>(F, OFF_LOGITS)};
            pg8::gemm_phase(F.lds, g, S, E, F.tid); asm volatile("s_waitcnt vmcnt(0)" ::: "memory"); __syncthreads(); conv_expert_weights(F, l);  } SEAM(pb + 13); }
        if (PON(14) && IN(pb + 14)) { const Frame F = phase_frame(F0); REPEAT(14) {  route_phase(F, l, RB);  } SEAM(pb + 14); }
        if (PON(15) && IN(pb + 15)) { const Frame F = phase_frame(F0); REPEAT(15) {  assign_gather_phase(F, l, RB);  } SEAM(pb + 15); }
        if (PON(16) && IN(pb + 16)) { const Frame F = phase_frame(F0); REPEAT(16) {  LAS int* tab = (LAS int*)(F.lds + MISC_OFF + 64); build_tab(F, l, tab);
            pg8::Gemm g{wsp<bf16_t>(F, OFF_XN), wsp<bf16_t>(F, OFF_WE1), DM, nullptr, nullptr}; pg8::MoeOrder<true> S{tab, 4, F.G, F.bid, wsp<int>(F, OFF_SLOTTOK)}; EpiAct E{wsp<bf16_t>(F, OFF_ACT)};
            pg8::gemm_phase(F.lds, g, S, E, F.tid);  } SEAM(pb + 16); }
        if (PON(17) && IN(pb + 17)) { const Frame F = phase_frame(F0); REPEAT(17) {  LAS int* tab = (LAS int*)(F.lds + MISC_OFF + 64); build_tab(F, l, tab);
            pg8::Gemm g{wsp<bf16_t>(F, OFF_ACT), wsp<bf16_t>(F, OFF_WE2), FF, nullptr, nullptr}; pg8::MoeOrder<false> S{tab, 4, F.G, F.bid, nullptr}; EpiY E{wsp<bf16_t>(F, OFF_YBUF)};
            pg8::gemm_phase(F.lds, g, S, E, F.tid);  } SEAM(pb + 17); }
        if (PON(18) && IN(pb + 18)) { const Frame F = phase_frame(F0); REPEAT(18) {  if constexpr (!LAST) { conv_small_weights(F, l + 1); combine_rows<true>(F, l, RB, F.in[I_N1G] + (size_t)(l + 1) * DM, wsp<bf16_t>(F, OFF_XN)); } else combine_rows<false>(F, l, RB, nullptr, nullptr);  } SEAM(pb + 18); }
#endif
}
__global__ void __launch_bounds__(512, 2) fwd(Args args) {
    extern __shared__ __attribute__((aligned(16))) unsigned char lds_raw[];
    Frame F0; F0.in = (kain_t)__builtin_amdgcn_kernarg_segment_ptr(); F0.out = args.out; F0.ws = args.ws; F0.lds = (LAS unsigned char*)lds_raw;
    F0.tid = threadIdx.x; F0.lane = F0.tid & 63; F0.wid = __builtin_amdgcn_readfirstlane(F0.tid >> 6); F0.G = gridDim.x; F0.bid = blockIdx.x;
    volatile LAS unsigned* MISC = (volatile LAS unsigned*)(F0.lds + MISC_OFF);
    if (F0.tid < 4) MISC[F0.tid] = 0u;
    __syncthreads();
#if MK_ONE_LAUNCH
    const XcdBarrier bar = xcd_barrier_post((unsigned*)(F0.ws + OFF_CTL) + CW_BAR, MISC);
#else
    const int bar = 0;
#endif
    const int lo = args.ph_lo, hi = args.ph_hi;
    if (PON(31) && IN(0)) { const Frame F = phase_frame(F0); p0_prologue(F); SEAM(0); }
    layer_phases<0>(F0, lo, hi, bar);
#if EN_LAYERS > 1
    layer_phases<1>(F0, lo, hi, bar);
#endif
}

extern "C" void kernel_launch(void* const* d_in, const int* in_sizes, int n_in, void* d_out, int out_size, void* d_ws, size_t ws_size, hipStream_t stream) {
    static int grid = 0;
    if (grid == 0) {
        if (n_in != 33 || out_size != NB * SEQ * DM || ws_size < WS_END) { fprintf(stderr, "kernel_launch: unexpected shapes (n_in %d out %d ws %zu need %zu)\n", n_in, out_size, ws_size, (size_t)WS_END); grid = -1; return; }
        int dev = 0, cus = 0, per_cu = 0;
        if (hipGetDevice(&dev) != hipSuccess || hipDeviceGetAttribute(&cus, hipDeviceAttributeMultiprocessorCount, dev) != hipSuccess) { grid = -1; return; }
        if (hipFuncSetAttribute((const void*)fwd, hipFuncAttributeMaxDynamicSharedMemorySize, LDS_BYTES) != hipSuccess) { fprintf(stderr, "kernel_launch: hipFuncSetAttribute failed\n"); grid = -1; return; }
        if (hipOccupancyMaxActiveBlocksPerMultiprocessor(&per_cu, (const void*)fwd, 512, LDS_BYTES) != hipSuccess || per_cu < 1) { fprintf(stderr, "kernel_launch: occupancy query says %d\n", per_cu); }
        (void)hipGetLastError();
        grid = cus;
    }
    if (grid < 0) return;
    (void)hipMemsetAsync((char*)d_ws + OFF_CTL, 0, 65536, stream);
    Args a{};
    for (int i = 0; i < 33; ++i) a.in[i] = (const float*)d_in[i];
    a.out = (float*)d_out; a.ws = (unsigned char*)d_ws;
#if MK_ONE_LAUNCH
    a.ph_lo = 0; a.ph_hi = N_PHASES;
    hipLaunchKernelGGL(fwd, dim3(grid), dim3(512), LDS_BYTES, stream, a);
#else
    for (int p = 0; p < N_PHASES; ++p) {
        if (p >= 1 + EN_LAYERS * PH_PER_LAYER) break;
#if !EN_MOE
        if (p >= 1 && ((p - 1) % PH_PER_LAYER) >= 12) continue;
#endif
        a.ph_lo = p; a.ph_hi = p + 1;
        hipLaunchKernelGGL(fwd, dim3(grid), dim3(512), LDS_BYTES, stream, a);
    }
#endif
}
```

```cpp
#include <hip/hip_runtime.h>
#include <stdint.h>
#include <stdio.h>
#include <stddef.h>
#include <utility>

#ifndef MK_ONE_LAUNCH
#define MK_ONE_LAUNCH 1
#endif
#ifndef EN_MOE
#define EN_MOE 1
#endif
#ifndef EN_LAYERS
#define EN_LAYERS 2
#endif

#define LAS __attribute__((address_space(3)))
#define DI __device__ __forceinline__
typedef unsigned short bf16_t;
typedef short bf16x8 __attribute__((ext_vector_type(8)));
typedef float f32x4 __attribute__((ext_vector_type(4)));
typedef float f32x2 __attribute__((ext_vector_type(2)));
typedef float f32x16 __attribute__((ext_vector_type(16)));
typedef unsigned u32x4 __attribute__((ext_vector_type(4)));
typedef unsigned u32x2 __attribute__((ext_vector_type(2)));
typedef __bf16 bfv2 __attribute__((ext_vector_type(2)));

constexpr int DM = 1024, NB = 2, SEQ = 16384, CTXL = 256, NCTX = NB * CTXL  , MROWS = NCTX + NB * SEQ  ;
constexpr int NPAN = MROWS / 256;
constexpr int IN_W = 7040, N_INP = 4096  , N_GATE = 3072, N_INT = N_INP + N_GATE  ;
constexpr int RW_IN = 1920, LORA_K = 384, LORA_N = 2560;
constexpr int NEXP = 32, FF = 512;
constexpr int PMAX = 74752;
constexpr int KEYS = CTXL + SEQ;
constexpr size_t U_EL = (size_t)MROWS * 512;
constexpr size_t U_B = U_EL * 2;
constexpr size_t OFF_CTL = 0, OFF_MOD = 65536, OFF_CTX = 327680, OFF_WIN = 2424832, OFF_WMG = 17104896, OFF_WOUT = 20250624, OFF_WLORA = 22347776, OFF_WRT = 24313856;
constexpr size_t R1 = 25165824, R2 = R1 + 4 * U_B, R3 = R2 + 5 * U_B, R4 = R3 + 4 * U_B, R6 = R4 + 2 * U_B, RVT = R6 + 2 * U_B, RTAIL = RVT + U_B;
constexpr size_t OFF_POOL = R1, OFF_Q = R1 + U_B, OFF_K = R1 + 2 * U_B, OFF_V = R1 + 3 * U_B;
constexpr size_t OFF_RWRAW = R2, OFF_EF = R2, OFF_EB = R2 + U_B, OFF_AF = R2 + 2 * U_B, OFF_AB = R2 + 3 * U_B, OFF_GG = R2 + 4 * U_B;
constexpr size_t OFF_RR = R3, OFF_RK = R3 + U_B, OFF_RV = R3 + 2 * U_B, OFF_RKK = R3 + 3 * U_B;
constexpr size_t OFF_YF = R1 + U_B, OFF_YB = R1 + 2 * U_B;
constexpr size_t OFF_MP = R1 + U_B;
constexpr size_t OFF_NS = R6 + U_B;
constexpr int NCHUNK = KEYS / 64;
constexpr size_t OFF_PDIFF = R6, OFF_ALORA = R6 + U_B, OFF_XN = R6;
constexpr size_t OFF_XNM = R4;
constexpr size_t OFF_G = R2;
constexpr size_t OFF_MERGED = R3 + U_B;
constexpr size_t OFF_WE1 = R3, OFF_WE2 = R1 + 3 * U_B;
constexpr size_t OFF_ACT = R1, OFF_YBUF = R2;
constexpr size_t OFF_LOGITS = RTAIL, OFF_ROUTE = RTAIL + (size_t)MROWS * 64 * 4, OFF_SLOTTOK = OFF_ROUTE + (size_t)MROWS * 32, WSET1 = OFF_SLOTTOK + (size_t)PMAX * 4, WS_END = WSET1 + (OFF_WRT - OFF_WIN);
constexpr int CW_BAR = 0, CW_CNT = 4096, CW_CUR = 4096 + 64, CW_DYN = 4096 + 128, CW_END = 4096 + 134;
constexpr int LDS_BYTES = 151552, MISC_OFF = 147456;
constexpr size_t WDELTA = WSET1 - OFF_WIN;
static_assert(WSET1 % 256 == 0, "alignment of the second weight set");

DI int launder(int x) { asm volatile("" : "+v"(x)); return x; }
DI int lane_id() { return (int)__builtin_amdgcn_mbcnt_hi(~0u, __builtin_amdgcn_mbcnt_lo(~0u, 0u)); }
DI float bf2f(bf16_t v) { return __uint_as_float(((unsigned)v) << 16); }
DI unsigned pk2(float lo, float hi) { f32x2 v = {lo, hi}; bfv2 r = __builtin_convertvector(v, bfv2); return __builtin_bit_cast(unsigned, r); }
DI bf16_t f2bf(float f) { return (bf16_t)(pk2(f, 0.f) & 0xffffu); }
DI float lo_f(unsigned w) { return __uint_as_float(w << 16); }
DI float hi_f(unsigned w) { return __uint_as_float(w & 0xffff0000u); }
DI void unpack8(const u32x4 w, float (&f)[8]) { f[0] = lo_f(w.x); f[1] = hi_f(w.x); f[2] = lo_f(w.y); f[3] = hi_f(w.y); f[4] = lo_f(w.z); f[5] = hi_f(w.z); f[6] = lo_f(w.w); f[7] = hi_f(w.w); }
DI u32x4 pack8(const float (&f)[8]) { u32x4 w; w.x = pk2(f[0], f[1]); w.y = pk2(f[2], f[3]); w.z = pk2(f[4], f[5]); w.w = pk2(f[6], f[7]); return w; }
DI float sigmoidf_(float x) { return __builtin_amdgcn_rcpf(1.0f + __expf(-x)); }
DI float wave_sum(float v) { v += __shfl_xor(v, 1); v += __shfl_xor(v, 2); v += __shfl_xor(v, 4); v += __shfl_xor(v, 8); v += __shfl_xor(v, 16); v += __shfl_xor(v, 32); return v; }
DI float sum8(float v) { v += __shfl_xor(v, 1); v += __shfl_xor(v, 2); v += __shfl_xor(v, 4); return v; }
template <int CTRL> DI float dppf(float v) { return __builtin_bit_cast(float, __builtin_amdgcn_update_dpp(0, __builtin_bit_cast(int, v), CTRL, 0xf, 0xf, true)); }
DI float allsum16(float v) { v += dppf<0xB1>(v); v += dppf<0x4E>(v); v += dppf<0x141>(v); v += dppf<0x140>(v); return v; }

#define XB_TMO      128
#define XB_XCNT(j)  (256  + 64 * (j))
#define XB_XSUB(j)  (1280 + 64 * (j))
#define XB_XGEN(j)  (2304 + 64 * (j))
#define XB_TOP      3328
#define XB_TOPGEN   3392
#define XCD_BAR_WORDS 3456
#define XB_SPIN_CAP (1u << 22)
DI unsigned xb_ld(unsigned* p)              { return __hip_atomic_load(p, __ATOMIC_RELAXED, __HIP_MEMORY_SCOPE_AGENT); }
DI unsigned xb_add(unsigned* p, unsigned v) { return __hip_atomic_fetch_add(p, v, __ATOMIC_RELAXED, __HIP_MEMORY_SCOPE_AGENT); }
DI unsigned xb_xcc_id() { return (unsigned)__builtin_amdgcn_s_getreg((3 << 11) | 20) & 0xFu; }
#define XB_SPIN(cond, bar) do { unsigned _sp = 0; while (cond) { __builtin_amdgcn_s_sleep(1); \
    if ((++_sp & 255u) == 0u) { if (xb_ld(&(bar)[XB_TMO])) break; if (_sp > XB_SPIN_CAP) { atomicAdd(&(bar)[XB_TMO], 1u); break; } } } } while (0)
struct XcdBarrier { unsigned* bar; unsigned x; volatile LAS unsigned* st; bool t0; };
DI XcdBarrier xcd_barrier_post(unsigned* bar, volatile LAS unsigned* st) {
    XcdBarrier b; b.bar = bar; b.x = xb_xcc_id(); b.st = st; b.t0 = threadIdx.x == 0;
    if (b.t0) (void)xb_add(&bar[XB_XCNT(b.x)], 1u);
    return b;
}
DI void xcd_barrier_complete(unsigned* bar, unsigned x, unsigned& nloc, unsigned& nx) {
    const unsigned G = gridDim.x * gridDim.y * gridDim.z;
    unsigned sum, cnt, mine, sp = 0u;
    for (;;) {
        sum = 0u; cnt = 0u; mine = 0u;
#pragma unroll
        for (unsigned j = 0; j < 16; ++j) { const unsigned c = xb_ld(&bar[XB_XCNT(j)]); sum += c; cnt += (c > 0u) ? 1u : 0u; mine = (j == x) ? c : mine; }
        if (sum == G) break;
        __builtin_amdgcn_s_sleep(1);
        if ((++sp & 255u) == 0u) { if (xb_ld(&bar[XB_TMO])) break; if (sp > XB_SPIN_CAP) { atomicAdd(&bar[XB_TMO], 1u); break; } }
    }
    nloc = mine > 0u ? mine : 1u; nx = cnt > 0u ? cnt : 1u;
}
DI void xcd_barrier(const XcdBarrier& b) {
    asm volatile("s_waitcnt vmcnt(0)" ::: "memory");
    __syncthreads();
    if (b.t0) {
        unsigned* bar = b.bar;
        __builtin_amdgcn_s_waitcnt(0);
        unsigned nloc = b.st[0], nx = b.st[1];
        if (nloc == 0u) { xcd_barrier_complete(bar, b.x, nloc, nx); b.st[0] = nloc; b.st[1] = nx; }
        const unsigned old = xb_add(&bar[XB_XSUB(b.x)], 1u);
        const unsigned gen = old / nloc;
        if (old + 1u == (gen + 1u) * nloc) {
            __builtin_amdgcn_fence(__ATOMIC_RELEASE, "agent");
            asm volatile("s_waitcnt vmcnt(0)" ::: "memory");
            const unsigned og = xb_add(&bar[XB_TOP], 1u);
            const unsigned tg = og / nx;
            if (og + 1u == (tg + 1u) * nx) xb_add(&bar[XB_TOPGEN], 1u);
            else XB_SPIN(xb_ld(&bar[XB_TOPGEN]) == tg, bar);
            __builtin_amdgcn_fence(__ATOMIC_ACQUIRE, "agent");
            xb_add(&bar[XB_XGEN(b.x)], 1u);
            asm volatile("s_waitcnt vmcnt(0)" ::: "memory");
        } else {
            XB_SPIN(xb_ld(&bar[XB_XGEN(b.x)]) == gen, bar);
            __builtin_amdgcn_fence(__ATOMIC_ACQUIRE, "agent");
            asm volatile("s_waitcnt vmcnt(0)" ::: "memory");
        }
    }
    __syncthreads();
}

namespace pg8 {
constexpr int BM = 256, BK = 64, HALF = 128, HTB = HALF * BK * 2, STAGE_BYTES = 8 * HTB, NXCD = 8, WGM = 8;
DI int lds_byte(int r, int c) { const int st = (r >> 4) * 2 + (c >> 5), rr = r & 15, cc = c & 31, ob = rr * 64 + cc * 2; return st * 1024 + (ob ^ (((ob >> 9) & 1) << 5)); }
DI void stage_rc(int b, int& R, int& C) { const int st = b / 1024, sb = b % 1024, swz = sb ^ (((sb >> 9) & 1) << 5); R = (st >> 1) * 16 + swz / 64; C = (st & 1) * 32 + (swz % 64) / 2; }
DI int perm32(int rho) { const int n = rho >> 4, i = rho & 15; return 8 * (i >> 2) + 4 * n + (i & 3); }
struct Unit { int pm, pn, pb; };
struct Gemm { const bf16_t* A; const bf16_t* Bt; int K; const bf16_t* A1; const bf16_t* A2; };
struct StaticOrder {
    static constexpr bool GATHER = false;
    int nM, nN, nwg, G, c, pm0;
    DI void init(int M, int N, int G_, int c_, int pm0_ = 0) { pm0 = pm0_; nM = M / BM - pm0_; nN = N / BM; nwg = nM * nN; G = G_; c = c_; }
    DI bool next(int i, Unit& u) const {
        const long L = (long)i * G + c; if (L >= nwg) return false;
        int wgid = (int)L; { const int q = nwg / NXCD, r = nwg % NXCD, xcd = wgid % NXCD, off = wgid / NXCD; wgid = (xcd < r ? xcd * (q + 1) : r * (q + 1) + (xcd - r) * q) + off; }
        const int nig = WGM * nN, gid = wgid / nig, fm = gid * WGM, gsz = (nM - fm) < WGM ? (nM - fm) : WGM;
        u.pm = pm0 + fm + ((wgid % nig) % gsz); u.pn = (wgid % nig) / gsz; u.pb = u.pn; return true;
    }
};
template <bool GATHER_> struct MoeOrder {
    static constexpr bool GATHER = GATHER_;
    const LAS int* tab; int NT, G, c; const int* slot_tok;
    DI bool next(int i, Unit& u) const {
        int L = i * G + c; const int np = tab[32], nwg = np * NT; if (L >= nwg) return false;
        { const int q = nwg / NXCD, r = nwg % NXCD, xcd = L % NXCD, off = L / NXCD; L = (xcd < r ? xcd * (q + 1) : r * (q + 1) + (xcd - r) * q) + off; }
        const int p = L / NT, pn = L % NT; int e = 0;
#pragma unroll 1
        for (int j = 1; j < 32; ++j) e = (tab[j] <= p) ? j : e;
        u.pm = p; u.pn = pn; u.pb = e * NT + pn; return true;
    }
};

template <class Epi, class Sched>
DI void gemm_phase(LAS unsigned char* lds, const Gemm g, const Sched& S, const Epi& E, int tid_) {
    const int tid = launder(tid_), wid = __builtin_amdgcn_readfirstlane(tid >> 6), lane = tid & 63, wr = wid >> 2, wc = wid & 3, fr = lane & 15, fq = lane >> 4;
    const int K = g.K, nt = K / BK, lda = Epi::SEG ? 512 : K;
    unsigned voffA[2], voffB[2];
#pragma unroll
    for (int i = 0; i < 2; ++i) { int R, C; stage_rc(tid * 16 + i * 8192, R, C); const int Rb = Epi::PERM ? ((R & ~31) + perm32(R & 31)) : R;
        voffA[i] = (unsigned)(R * lda + C) * 2u; voffB[i] = (unsigned)(Rb * K + C) * 2u; }
    const size_t kstep = (size_t)(BK * 2);
    const size_t hstep = (size_t)HALF * K * 2;
    const size_t tstep = 2 * hstep;
    const size_t hstepA = (size_t)HALF * lda * 2, tstepA = 2 * hstepA;
    constexpr bool GA = Sched::GATHER;
    unsigned cv[2][2], nv[2][2]; int gR[2], gC[2];
#pragma unroll
    for (int i = 0; i < 2; ++i) { stage_rc(tid * 16 + i * 8192, gR[i], gC[i]); cv[0][i] = cv[1][i] = nv[0][i] = nv[1][i] = 0u; }
#define PG8_GVOFF(v, pm_) do { _Pragma("unroll") for (int h_ = 0; h_ < 2; ++h_) _Pragma("unroll") for (int i_ = 0; i_ < 2; ++i_) \
        (v)[h_][i_] = ((unsigned)S.slot_tok[(pm_) * 256 + h_ * 128 + gR[i_]] * (unsigned)lda + (unsigned)gC[i_]) * 2u; } while (0)
#define PG8_ATILE(ub, t) (Epi::SEG ? (const char*)((t) < 8 ? g.A : ((t) < 16 ? g.A1 : g.A2)) + (ub) + (size_t)((t) & 7) * kstep : (const char*)g.A + (ub) + (size_t)(t) * kstep)
    const unsigned ldsw = (unsigned)wid * 1024u;
    const int aoff = lds_byte(wr * 64 + fr, fq * 8), boff = lds_byte(wc * 32 + fr, fq * 8);
#define PG8_SA(b, h) (((b) * 2 + (h)) * HTB)
#define PG8_SB(b, h) ((4 + (b) * 2 + (h)) * HTB)
#define PG8_STAGE(bufoff, gbase, voff) do { _Pragma("unroll") for (int _i = 0; _i < 2; ++_i) \
        __builtin_amdgcn_global_load_lds((const unsigned*)((const char*)(gbase) + (voff)[_i]), (LAS unsigned*)(lds + (bufoff) + ldsw + _i * 8192), 16, 0, 0); } while (0)
#define PG8_LDA(dst, b, h) do { _Pragma("unroll") for (int m = 0; m < 4; ++m) _Pragma("unroll") for (int k = 0; k < 2; ++k) dst[m][k] = *(const LAS bf16x8*)(lds + PG8_SA(b, h) + aoff + m * 2048 + k * 1024); } while (0)
#define PG8_LDB(dst, b, h) do { _Pragma("unroll") for (int n = 0; n < 2; ++n) _Pragma("unroll") for (int k = 0; k < 2; ++k) dst[n][k] = *(const LAS bf16x8*)(lds + PG8_SB(b, h) + boff + n * 2048 + k * 1024); } while (0)
#define PG8_MMA(ai, bj, At, Bt) do { __builtin_amdgcn_s_setprio(1); _Pragma("unroll") for (int m = 0; m < 4; ++m) _Pragma("unroll") for (int n = 0; n < 2; ++n) _Pragma("unroll") for (int k = 0; k < 2; ++k) \
        acc[ai][bj][m][n] = __builtin_amdgcn_mfma_f32_16x16x32_bf16(Bt[n][k], At[m][k], acc[ai][bj][m][n], 0, 0, 0); __builtin_amdgcn_s_setprio(0); } while (0)
#define PG8_WAIT_V(n) asm volatile("s_waitcnt vmcnt(" #n ")" ::: "memory")
#define PG8_WAIT_L(n) asm volatile("s_waitcnt lgkmcnt(" #n ")" ::: "memory")
#define PG8_BAR __builtin_amdgcn_s_barrier()
#define PG8_SCHED __builtin_amdgcn_sched_barrier(0)
    Unit cur, nxt; int ui = 0;
    if (!S.next(0, cur)) return;
    f32x4 acc[2][2][4][2];
#pragma unroll
    for (int a = 0; a < 2; ++a)
#pragma unroll
        for (int b = 0; b < 2; ++b)
#pragma unroll
            for (int m = 0; m < 4; ++m)
#pragma unroll
                for (int n = 0; n < 2; ++n) acc[a][b][m][n] = (f32x4){0.f, 0.f, 0.f, 0.f};
    bf16x8 At[4][2], B0[2][2], B1[2][2];
    size_t ubA = (size_t)cur.pm * tstepA; const char* cA = PG8_ATILE(ubA, 0); const char* cB = (const char*)g.Bt + (size_t)cur.pb * tstep;
    const char* const gA = (const char*)g.A;
    if constexpr (GA) { PG8_GVOFF(cv, cur.pm); }
    PG8_STAGE(PG8_SB(0, 0), cB, voffB);
    if constexpr (GA) PG8_STAGE(PG8_SA(0, 0), gA, cv[0]); else PG8_STAGE(PG8_SA(0, 0), cA, voffA);
    PG8_STAGE(PG8_SB(0, 1), cB + hstep, voffB);
    if constexpr (GA) PG8_STAGE(PG8_SA(0, 1), gA, cv[1]); else PG8_STAGE(PG8_SA(0, 1), cA + hstepA, voffA);
    if (wr == 1) PG8_BAR;
    PG8_WAIT_V(4); PG8_BAR;
    PG8_STAGE(PG8_SB(1, 0), cB + kstep, voffB);
    if constexpr (GA) PG8_STAGE(PG8_SA(1, 0), gA + kstep, cv[0]); else PG8_STAGE(PG8_SA(1, 0), cA + kstep, voffA);
    PG8_STAGE(PG8_SB(1, 1), cB + hstep + kstep, voffB);
    PG8_WAIT_V(6); PG8_BAR;
    for (;;) {
        const bool has_next = S.next(ui + 1, nxt);
        const size_t nubA = has_next ? (size_t)nxt.pm * tstepA : ubA;
        const char* nA = PG8_ATILE(nubA, 0); const char* nB = has_next ? (const char*)g.Bt + (size_t)nxt.pb * tstep : cB;
        if constexpr (GA) { if (has_next) { PG8_GVOFF(nv, nxt.pm); } else {
#pragma unroll
            for (int h_ = 0; h_ < 2; ++h_) { nv[h_][0] = cv[h_][0]; nv[h_][1] = cv[h_][1]; } } }
        for (int t = 0; t < nt; t += 2) {
            const bool last = (t == nt - 2);
            const char* a1 = PG8_ATILE(ubA, t + 1);
            const char* a2 = last ? nA : PG8_ATILE(ubA, t + 2); const char* b2 = last ? nB : cB + (size_t)(t + 2) * kstep;
            const char* a3 = a2 + kstep; const char* b3 = b2 + kstep;
            const char* gk2 = gA + (last ? (size_t)0 : (size_t)(t + 2) * kstep);
            unsigned s0[2] = {last ? nv[0][0] : cv[0][0], last ? nv[0][1] : cv[0][1]}, s1[2] = {last ? nv[1][0] : cv[1][0], last ? nv[1][1] : cv[1][1]};
            PG8_LDB(B0, 0, 0); PG8_SCHED; PG8_LDA(At, 0, 0);
            if constexpr (GA) PG8_STAGE(PG8_SA(1, 1), gA + (size_t)(t + 1) * kstep, cv[1]); else PG8_STAGE(PG8_SA(1, 1), a1 + hstepA, voffA);
            PG8_WAIT_L(8); PG8_BAR; PG8_WAIT_L(0); PG8_MMA(0, 0, At, B0); PG8_BAR; PG8_SCHED;
            PG8_LDB(B1, 0, 1); PG8_STAGE(PG8_SB(0, 0), b2, voffB);
            PG8_BAR; PG8_WAIT_L(0); PG8_MMA(0, 1, At, B1); PG8_BAR;
            PG8_LDA(At, 0, 1); if constexpr (GA) PG8_STAGE(PG8_SA(0, 0), gk2, s0); else PG8_STAGE(PG8_SA(0, 0), a2, voffA);
            PG8_BAR; PG8_WAIT_L(0); PG8_MMA(1, 0, At, B0); PG8_BAR; PG8_SCHED;
            PG8_STAGE(PG8_SB(0, 1), b2 + hstep, voffB);
            PG8_WAIT_V(6); PG8_BAR; PG8_MMA(1, 1, At, B1); PG8_BAR;
            PG8_LDB(B0, 1, 0); PG8_SCHED; PG8_LDA(At, 1, 0); if constexpr (GA) PG8_STAGE(PG8_SA(0, 1), gk2, s1); else PG8_STAGE(PG8_SA(0, 1), a2 + hstepA, voffA);
            PG8_WAIT_L(8); PG8_BAR; PG8_WAIT_L(0); PG8_MMA(0, 0, At, B0); PG8_BAR; PG8_SCHED;
            PG8_LDB(B1, 1, 1); PG8_STAGE(PG8_SB(1, 0), b3, voffB);
            PG8_BAR; PG8_WAIT_L(0); PG8_MMA(0, 1, At, B1); PG8_BAR;
            PG8_LDA(At, 1, 1); if constexpr (GA) PG8_STAGE(PG8_SA(1, 0), gk2 + kstep, s0); else PG8_STAGE(PG8_SA(1, 0), a3, voffA);
            PG8_BAR; PG8_WAIT_L(0); PG8_MMA(1, 0, At, B0); PG8_BAR; PG8_SCHED;
            PG8_STAGE(PG8_SB(1, 1), b3 + hstep, voffB);
            PG8_WAIT_V(6); PG8_BAR; PG8_MMA(1, 1, At, B1); PG8_BAR;
            if constexpr (Epi::SEG) { if (((t + 2) & 7) == 0 && !last) E.mid(acc, cur, (t + 2) >> 3, wr, wc, fr, fq); }
        }
        E(acc, cur, wr, wc, fr, fq);
        if (!has_next) break;
#pragma unroll
        for (int a = 0; a < 2; ++a)
#pragma unroll
            for (int b = 0; b < 2; ++b)
#pragma unroll
                for (int m = 0; m < 4; ++m)
#pragma unroll
                    for (int n = 0; n < 2; ++n) acc[a][b][m][n] = (f32x4){0.f, 0.f, 0.f, 0.f};
        cur = nxt; cA = nA; cB = nB; ubA = nubA; ++ui;
        if constexpr (GA) {
#pragma unroll
            for (int h_ = 0; h_ < 2; ++h_) { cv[h_][0] = nv[h_][0]; cv[h_][1] = nv[h_][1]; } }
    }
    PG8_WAIT_V(0);
    if (wr == 0) PG8_BAR;
    PG8_BAR;
#undef PG8_ATILE
#undef PG8_GVOFF
#undef PG8_SA
#undef PG8_SB
#undef PG8_STAGE
#undef PG8_LDA
#undef PG8_LDB
#undef PG8_MMA
#undef PG8_WAIT_V
#undef PG8_WAIT_L
#undef PG8_BAR
#undef PG8_SCHED
}
}

struct Args { const float* in[33]; float* out; unsigned char* ws; int ph_lo, ph_hi; };
static_assert(offsetof(Args, out) == 264 && offsetof(Args, ws) == 272, "kernarg layout");
typedef const float* cfptr_t;
typedef __attribute__((address_space(4))) const cfptr_t* kain_t;
typedef __attribute__((address_space(4))) const unsigned char* kab_t;
struct Frame {
    kain_t in; float* out; unsigned char* ws; LAS unsigned char* lds;
    int tid, lane, wid, G, bid;
};
enum { I_X = 0, I_C, I_CTX, I_CCTX, I_WADA, I_BADA, I_N1G, I_N2G, I_WIN, I_POOLW, I_POOLS, I_QNG, I_KNG, I_LAMQK, I_SUBLN, I_SHMU, I_DW0, I_DW2, I_AA0, I_AA2, I_GW2, I_KK, I_KA, I_RK, I_GNW, I_GNB,
       I_WBR, I_WOUT, I_WRG, I_WRE, I_WEG, I_WEU, I_WED };
template <class T> DI T* wsp(const Frame& F, size_t off) { return (T*)(F.ws + off); }
DI const float* xrow_ptr(const Frame& F, const float* xlat, int r) { return r < NCTX ? wsp<const float>(F, OFF_CTX) + (size_t)r * DM : xlat + (size_t)(r - NCTX) * DM; }
DI Frame phase_frame(const Frame& F0) { Frame F = F0; F.lane = launder(lane_id()); F.wid = F0.wid; F.tid = (F.wid << 6) | F.lane;
    kab_t ka = (kab_t)__builtin_amdgcn_kernarg_segment_ptr(); asm volatile("" : "+s"(ka));
    F.in = (kain_t)ka; F.out = *(float* const __attribute__((address_space(4)))*)(ka + 264); F.ws = *(unsigned char* const __attribute__((address_space(4)))*)(ka + 272); return F; }
DI int row_cond(int r) { return r < NCTX ? 2 : (r - NCTX) / SEQ; }
DI const float* modp(const Frame& F, int l, int cond, int j) { return wsp<const float>(F, OFF_MOD) + ((size_t)(l * 3 + cond) * 6 + j) * DM; }

DI void convT_tile(const Frame& F, const float* src, int src_ld, int k0, int n0, bf16_t* dst, int dst_ld, int drow0) {
    LAS float* tile = (LAS float*)F.lds;
    const int t = F.tid;
    { const int k = t >> 3, n8 = (t & 7) * 8; const float* p = src + (size_t)(k0 + k) * src_ld + n0 + n8;
      const f32x4 a = *(const f32x4*)p, b = *(const f32x4*)(p + 4);
      LAS float* q = tile + k * 65 + n8; q[0] = a[0]; q[1] = a[1]; q[2] = a[2]; q[3] = a[3]; q[4] = b[0]; q[5] = b[1]; q[6] = b[2]; q[7] = b[3]; }
    __syncthreads();
    { const int n = t >> 3, k8 = (t & 7) * 8; float f[8];
#pragma unroll
      for (int j = 0; j < 8; ++j) f[j] = tile[(k8 + j) * 65 + n];
      *(u32x4*)(dst + (size_t)(drow0 + n) * dst_ld + k0 + k8) = pack8(f); }
    __syncthreads();
}
DI void convT(const Frame& F, const float* src, int src_ld, int K, int n_lo, int n_hi, bf16_t* dst, int dst_ld, int drow_base, int rot) {
    const int tk = K / 64, tn = (n_hi - n_lo) / 64, ntile = tk * tn;
    for (int t = (F.bid + rot) % F.G; t < ntile; t += F.G) { const int kt = t % tk, nt_ = t / tk; convT_tile(F, src, src_ld, kt * 64, n_lo + nt_ * 64, dst, dst_ld, drow_base + nt_ * 64); }
}

DI void conv_small_weights(const Frame& F, int l) {
    const int gt = F.bid * 512 + F.tid, gn = F.G * 512;
    const size_t wo = (l & 1) ? WDELTA : 0;
    bf16_t* win = wsp<bf16_t>(F, OFF_WIN + wo);
    const float* w_in = F.in[I_WIN] + (size_t)l * DM * IN_W;
    convT(F, w_in, IN_W, DM, 0, 3968, win, DM, 0, 0);
    convT(F, w_in, IN_W, DM, 3968, IN_W, win, DM, 4096, 64);
    for (int i = gt; i < 128 * DM / 8; i += gn) *(u32x4*)(win + (size_t)3968 * DM + (size_t)i * 8) = (u32x4){0u, 0u, 0u, 0u};
    bf16_t* wmg = wsp<bf16_t>(F, OFF_WMG + wo);
    const float* w_br = F.in[I_WBR] + (size_t)l * 3 * 512 * DM;
    convT(F, w_br + (size_t)1 * 512 * DM, DM, 512, 0, DM, wmg + 512, 1536, 0, 128);
    convT(F, w_br + (size_t)2 * 512 * DM, DM, 512, 0, DM, wmg + 1024, 1536, 0, 192);
    {
        const float* pw = F.in[I_POOLW] + (size_t)l * 4 * 128 * 128; const float* ps = F.in[I_POOLS] + (size_t)l * 512;
        for (int i = gt; i < DM * 64; i += gn) {
            const int n = i & 1023, c8 = i >> 10, k0 = c8 * 8, g = k0 >> 7, c0 = k0 & 127; float acc[8];
#pragma unroll
            for (int j = 0; j < 8; ++j) acc[j] = 0.f;
            for (int d = 0; d < 128; ++d) { const float wb = ps[g * 128 + d] * w_br[(size_t)(g * 128 + d) * DM + n];
#pragma unroll
                for (int j = 0; j < 8; ++j) acc[j] += pw[(size_t)(g * 128 + c0 + j) * 128 + d] * wb; }
            *(u32x4*)(wmg + (size_t)n * 1536 + k0) = pack8(acc);
        }
    }
    convT(F, F.in[I_WOUT] + (size_t)l * DM * DM, DM, DM, 0, DM, wsp<bf16_t>(F, OFF_WOUT + wo), DM, 0, 32);
    {
        bf16_t* wl = wsp<bf16_t>(F, OFF_WLORA + wo);
        const float* dw2 = F.in[I_DW2] + (size_t)l * 2 * 64 * 512; const float* aa2 = F.in[I_AA2] + (size_t)l * 2 * 64 * 512; const float* gw2 = F.in[I_GW2] + (size_t)l * 128 * 512;
        for (int i = gt; i < LORA_N * (LORA_K / 8); i += gn) {
            const int n = i % LORA_N, k0 = (i / LORA_N) * 8, kind = n >> 9, c = n & 511; float f[8];
#pragma unroll
            for (int j = 0; j < 8; ++j) { const int k = k0 + j; float v = 0.f;
                if (kind < 2) { if (k >= kind * 64 && k < kind * 64 + 64) v = dw2[((size_t)kind * 64 + (k - kind * 64)) * 512 + c]; }
                else if (kind < 4) { const int d = kind - 2; if (k >= 128 + d * 64 && k < 192 + d * 64) v = aa2[((size_t)d * 64 + (k - 128 - d * 64)) * 512 + c]; }
                else { if (k >= 256) v = gw2[(size_t)(k - 256) * 512 + c]; }
                f[j] = v; }
            *(u32x4*)(wl + (size_t)n * LORA_K + k0) = pack8(f);
        }
    }
}
DI void conv_expert_weights(const Frame& F, int l, int part) {
    const int gt = F.bid * 512 + F.tid, gn = F.G * 512;
    bf16_t* w1 = wsp<bf16_t>(F, OFF_WE1); bf16_t* w2 = wsp<bf16_t>(F, OFF_WE2);
    const float* wg = F.in[I_WEG] + (size_t)l * NEXP * DM * FF; const float* wu = F.in[I_WEU] + (size_t)l * NEXP * DM * FF; const float* wd = F.in[I_WED] + (size_t)l * NEXP * FF * DM;
    const int tt = F.tid, lk = tt >> 3, l8 = (tt & 7) * 8;
    const int NT = part ? NEXP * 128 : NEXP * 256;
#define EXP_TILE(t_, srcp_, dstp_) do { const int e_ = part ? (t_) >> 7 : (t_) >> 8, r_ = part ? 256 + ((t_) & 127) : (t_) & 255; \
        if (r_ < 256) { const int up_ = r_ >> 7, q_ = r_ & 127, kt_ = q_ & 15, nt_ = q_ >> 4, ff0_ = nt_ * 64, drow_ = 256 * (ff0_ >> 7) + 128 * up_ + (ff0_ & 127); \
            srcp_ = (up_ ? wu : wg) + (size_t)e_ * DM * FF + (size_t)(kt_ * 64 + lk) * FF + ff0_ + l8; dstp_ = w1 + (size_t)e_ * 1024 * 1024 + (size_t)(drow_ + lk) * DM + kt_ * 64 + l8; } \
        else { const int q_ = r_ - 256, kt_ = q_ & 7, nt_ = q_ >> 3; \
            srcp_ = wd + (size_t)e_ * FF * DM + (size_t)(kt_ * 64 + lk) * DM + nt_ * 64 + l8; dstp_ = w2 + (size_t)e_ * 1024 * 512 + (size_t)(nt_ * 64 + lk) * FF + kt_ * 64 + l8; } } while (0)
    int* cursor = wsp<int>(F, OFF_CTL) + CW_DYN + 4 * part + l; LAS int* shb = (LAS int*)(F.lds + MISC_OFF + 3072);
    for (;;) {
        if (F.tid == 0) *shb = atomicAdd(cursor, 4);
        __syncthreads();
        const int base = *shb;
        if (base >= NT) break;
        f32x4 ra[4], rb[4]; bf16_t* dp[4];
#pragma unroll
        for (int s_ = 0; s_ < 4; ++s_) { const int t = base + s_; const float* sp; EXP_TILE(t, sp, dp[s_]); ra[s_] = *(const f32x4*)sp; rb[s_] = *(const f32x4*)(sp + 4); }
#pragma unroll
        for (int s_ = 0; s_ < 4; ++s_) { LAS float* q = (LAS float*)F.lds + s_ * (64 * 65) + lk * 65 + l8; const f32x4 a = ra[s_], b = rb[s_]; q[0] = a[0]; q[1] = a[1]; q[2] = a[2]; q[3] = a[3]; q[4] = b[0]; q[5] = b[1]; q[6] = b[2]; q[7] = b[3]; }
        __syncthreads();
#pragma unroll
        for (int s_ = 0; s_ < 4; ++s_) { const LAS float* tile = (const LAS float*)F.lds + s_ * (64 * 65); float f[8];
#pragma unroll
            for (int j = 0; j < 8; ++j) f[j] = tile[(l8 + j) * 65 + lk];
            *(u32x4*)dp[s_] = pack8(f); }
        __syncthreads();
    }
#undef EXP_TILE
}
DI void conv_router_weights(const Frame& F, int l) {
    const int gt = F.bid * 512 + F.tid, gn = F.G * 512;
    bf16_t* wr = wsp<bf16_t>(F, OFF_WRT);
    const float* wrg = F.in[I_WRG] + (size_t)l * DM * 4; const float* wre = F.in[I_WRE] + (size_t)l * DM * 32;
    for (int i = gt; i < 256 * (DM / 8); i += gn) { const int n = i & 255, k0 = (i >> 8) * 8; float f[8];
#pragma unroll
        for (int j = 0; j < 8; ++j) f[j] = n < 4 ? wrg[(size_t)(k0 + j) * 4 + n] : (n < 36 ? wre[(size_t)(k0 + j) * 32 + (n - 4)] : 0.f);
        *(u32x4*)(wr + (size_t)n * DM + k0) = pack8(f); }
}
DI void p0_prologue(const Frame& F) {
    LAS float* sl = (LAS float*)F.lds;
    LAS float* red = sl + 3 * DM;
    for (int i = F.tid; i < 3 * DM; i += 512) { const int cond = i >> 10, k = i & 1023; const float v = cond < 2 ? F.in[I_C][cond * DM + k] : F.in[I_CCTX][k]; sl[i] = v * sigmoidf_(v); }
    __syncthreads();
    for (int cg = F.bid; cg < 192; cg += F.G) {
        const int l = cg / 96, col = (cg % 96) * 64 + F.lane;
        const float* W = F.in[I_WADA] + (size_t)l * DM * 6144 + col;
        float s0 = 0.f, s1 = 0.f, s2 = 0.f;
        const int kb = F.wid * 128;
#pragma unroll 1
        for (int k0 = kb; k0 < kb + 128; k0 += 32) { float w[32];
#pragma unroll
            for (int j = 0; j < 32; ++j) w[j] = W[(size_t)(k0 + j) * 6144];
#pragma unroll
            for (int j = 0; j < 32; ++j) { s0 += sl[k0 + j] * w[j]; s1 += sl[DM + k0 + j] * w[j]; s2 += sl[2 * DM + k0 + j] * w[j]; } }
        red[(F.wid * 3 + 0) * 64 + F.lane] = s0; red[(F.wid * 3 + 1) * 64 + F.lane] = s1; red[(F.wid * 3 + 2) * 64 + F.lane] = s2;
        __syncthreads();
        if (F.tid < 192) { const int cond = F.tid >> 6, ln = F.tid & 63; float s = 0.f;
#pragma unroll
            for (int w = 0; w < 8; ++w) s += red[(w * 3 + cond) * 64 + ln];
            const int n = (cg % 96) * 64 + ln;
            wsp<float>(F, OFF_MOD)[(size_t)(l * 3 + cond) * 6144 + n] = s + F.in[I_BADA][(size_t)l * 6144 + n]; }
        __syncthreads();
    }
    { const int gt = F.bid * 512 + F.tid, gn = F.G * 512; float* cx = wsp<float>(F, OFF_CTX);
      for (int i = gt; i < NCTX * DM / 4; i += gn) ((f32x4*)cx)[i] = ((const f32x4*)F.in[I_CTX])[i]; }
    __syncthreads();
    conv_small_weights(F, 0);
}

DI void norm_rows(const Frame& F, const float* xlat, const float* g, int l, int j_shift, int j_scale, bf16_t* dst, int r_begin = 0, int r_end = MROWS, bool local = false) {
    const int gw = local ? F.wid : F.bid * 8 + F.wid, nw = local ? 8 : F.G * 8;
    f32x4 gv[4];
#pragma unroll
    for (int j = 0; j < 4; ++j) gv[j] = *(const f32x4*)(g + 4 * F.lane + 256 * j);
    for (int r0 = r_begin + gw * 4; r0 < r_end; r0 += nw * 4) {
        f32x4 v[4][4]; float ss[4];
#pragma unroll
        for (int q = 0; q < 4; ++q) { const float* xr = xrow_ptr(F, xlat, r0 + q);
#pragma unroll
            for (int j = 0; j < 4; ++j) v[q][j] = *(const f32x4*)(xr + 4 * F.lane + 256 * j); }
        const int cond = row_cond(r0); const float* sh = modp(F, l, cond, j_shift); const float* sc = modp(F, l, cond, j_scale);
        f32x4 s4v[4], c4v[4];
#pragma unroll
        for (int j = 0; j < 4; ++j) { s4v[j] = *(const f32x4*)(sh + 4 * F.lane + 256 * j); c4v[j] = *(const f32x4*)(sc + 4 * F.lane + 256 * j); }
#pragma unroll
        for (int q = 0; q < 4; ++q) { float a = 0.f;
#pragma unroll
            for (int j = 0; j < 4; ++j) a += v[q][j][0] * v[q][j][0] + v[q][j][1] * v[q][j][1] + v[q][j][2] * v[q][j][2] + v[q][j][3] * v[q][j][3];
            ss[q] = a; }
#pragma unroll
        for (int sft = 1; sft < 64; sft <<= 1) {
#pragma unroll
            for (int q = 0; q < 4; ++q) ss[q] += __shfl_xor(ss[q], sft); }
#pragma unroll
        for (int j = 0; j < 4; ++j) { const f32x4 s4 = s4v[j], c4 = c4v[j];
#pragma unroll
            for (int q = 0; q < 4; ++q) { const float inv = rsqrtf(ss[q] * (1.0f / DM) + 1e-6f); float o[4];
#pragma unroll
                for (int e = 0; e < 4; ++e) o[e] = (v[q][j][e] * inv * gv[j][e]) * (1.0f + c4[e]) + s4[e];
                u32x2 w; w.x = pk2(o[0], o[1]); w.y = pk2(o[2], o[3]);
                *(u32x2*)(dst + (size_t)(r0 + q) * DM + 4 * F.lane + 256 * j) = w; } }
    }
}

struct EpiInproj {
    static constexpr bool PERM = true, SEG = false;
    unsigned char* ws;
    DI void operator()(const f32x4 (&acc)[2][2][4][2], const pg8::Unit& u, int wr, int wc, int fr, int fq) const {
        bf16_t* dst; int ld, colt;
        if (u.pn < 8) { dst = (bf16_t*)(ws + R1) + (size_t)(u.pn >> 1) * U_EL; ld = 512; colt = (u.pn & 1) * 256; } else { dst = (bf16_t*)(ws + OFF_RWRAW); ld = 2048; colt = (u.pn - 8) * 256; }
        const int row0 = u.pm * 256 + wr * 64 + fr, col0 = colt + wc * 32 + 8 * fq;
#pragma unroll
        for (int ai = 0; ai < 2; ++ai)
#pragma unroll
            for (int m = 0; m < 4; ++m) { bf16_t* rowp = dst + (size_t)(row0 + ai * 128 + m * 16) * ld + col0;
#pragma unroll
                for (int bj = 0; bj < 2; ++bj) { const f32x4 v0 = acc[ai][bj][m][0], v1 = acc[ai][bj][m][1]; u32x4 w; w.x = pk2(v0[0], v0[1]); w.y = pk2(v0[2], v0[3]); w.z = pk2(v1[0], v1[1]); w.w = pk2(v1[2], v1[3]);
                    *(u32x4*)(rowp + bj * 128) = w; } }
    }
};
struct EpiLora {
    static constexpr bool PERM = true, SEG = false;
    unsigned char* ws; const float* w0; const float* a0;
    DI void operator()(const f32x4 (&acc)[2][2][4][2], const pg8::Unit& u, int wr, int wc, int fr, int fq) const {
        fr = launder(fr); fq = launder(fq);
        const int kind = u.pn >> 1; bf16_t* dst = (bf16_t*)(ws + R2) + (size_t)kind * U_EL; const int colt = (u.pn & 1) * 256;
        const int row0 = u.pm * 256 + wr * 64 + fr, col0 = colt + wc * 32 + 8 * fq;
        const float* bias = kind < 2 ? w0 + kind * 512 : a0 + ((kind - 2) & 1) * 512;
        const float mul = kind < 2 ? 0.60653065971f : 1.0f;
        if (kind < 4) {
#pragma unroll
            for (int bj = 0; bj < 2; ++bj) { const f32x4 b0 = *(const f32x4*)(bias + col0 + bj * 128), b1 = *(const f32x4*)(bias + col0 + bj * 128 + 4);
#pragma unroll
                for (int ai = 0; ai < 2; ++ai)
#pragma unroll
                    for (int m = 0; m < 4; ++m) { bf16_t* rowp = dst + (size_t)(row0 + ai * 128 + m * 16) * 512 + col0;
                        f32x4 v0 = acc[ai][bj][m][0], v1 = acc[ai][bj][m][1];
#pragma unroll
                        for (int e = 0; e < 4; ++e) { v0[e] = mul * sigmoidf_(v0[e] + b0[e]); v1[e] = mul * sigmoidf_(v1[e] + b1[e]); }
                        u32x4 w; w.x = pk2(v0[0], v0[1]); w.y = pk2(v0[2], v0[3]); w.z = pk2(v1[0], v1[1]); w.w = pk2(v1[2], v1[3]);
                        *(u32x4*)(rowp + bj * 128) = w; }
                asm volatile("" ::: "memory"); }
        } else {
#pragma unroll
            for (int bj = 0; bj < 2; ++bj)
#pragma unroll
                for (int ai = 0; ai < 2; ++ai)
#pragma unroll
                    for (int m = 0; m < 4; ++m) { bf16_t* rowp = dst + (size_t)(row0 + ai * 128 + m * 16) * 512 + col0;
                        const f32x4 v0 = acc[ai][bj][m][0], v1 = acc[ai][bj][m][1];
                        u32x4 w; w.x = pk2(v0[0], v0[1]); w.y = pk2(v0[2], v0[3]); w.z = pk2(v1[0], v1[1]); w.w = pk2(v1[2], v1[3]);
                        *(u32x4*)(rowp + bj * 128) = w; }
        }
    }
};
struct EpiGates {
    static constexpr bool PERM = true, SEG = false;
    bf16_t* G;
    DI void operator()(const f32x4 (&acc)[2][2][4][2], const pg8::Unit& u, int wr, int wc, int fr, int fq) const {
        const int row0 = u.pm * 256 + wr * 64 + fr, col0 = u.pn * 256 + wc * 32 + 8 * fq;
#pragma unroll
        for (int ai = 0; ai < 2; ++ai)
#pragma unroll
            for (int m = 0; m < 4; ++m) { bf16_t* rowp = G + (size_t)(row0 + ai * 128 + m * 16) * N_GATE + col0;
#pragma unroll
                for (int bj = 0; bj < 2; ++bj) { f32x4 v0 = acc[ai][bj][m][0], v1 = acc[ai][bj][m][1];
#pragma unroll
                    for (int e = 0; e < 4; ++e) { v0[e] = sigmoidf_(v0[e]); v1[e] = sigmoidf_(v1[e]); }
                    u32x4 w; w.x = pk2(v0[0], v0[1]); w.y = pk2(v0[2], v0[3]); w.z = pk2(v1[0], v1[1]); w.w = pk2(v1[2], v1[3]);
                    *(u32x4*)(rowp + bj * 128) = w; } }
    }
};
struct EpiMerge {
    static constexpr bool PERM = true, SEG = true;
    const bf16_t* G; bf16_t* mg;
    DI void mid(f32x4 (&acc)[2][2][4][2], const pg8::Unit& u, int seg, int wr, int wc, int fr, int fq) const {
        const int row0 = u.pm * 256 + wr * 64 + fr, col0 = u.pn * 256 + wc * 32 + 8 * fq;
#pragma unroll
        for (int ai = 0; ai < 2; ++ai)
#pragma unroll
            for (int m = 0; m < 4; ++m) { const bf16_t* gp = G + (size_t)(row0 + ai * 128 + m * 16) * N_GATE + (seg - 1) * DM + col0;
#pragma unroll
                for (int bj = 0; bj < 2; ++bj) { float ga[8], gb[8]; unpack8(*(const u32x4*)(gp + bj * 128), ga); unpack8(*(const u32x4*)(gp + DM + bj * 128), gb);
#pragma unroll
                    for (int e = 0; e < 4; ++e) { acc[ai][bj][m][0][e] *= fmaxf(ga[e], 1e-30f) * __builtin_amdgcn_rcpf(fmaxf(gb[e], 1e-30f)); acc[ai][bj][m][1][e] *= fmaxf(ga[4 + e], 1e-30f) * __builtin_amdgcn_rcpf(fmaxf(gb[4 + e], 1e-30f)); } }
                asm volatile("" ::: "memory"); }
    }
    DI void operator()(const f32x4 (&acc)[2][2][4][2], const pg8::Unit& u, int wr, int wc, int fr, int fq) const {
        const int row0 = u.pm * 256 + wr * 64 + fr, col0 = u.pn * 256 + wc * 32 + 8 * fq;
#pragma unroll
        for (int ai = 0; ai < 2; ++ai)
#pragma unroll
            for (int m = 0; m < 4; ++m) { const size_t row = (size_t)(row0 + ai * 128 + m * 16);
#pragma unroll
                for (int bj = 0; bj < 2; ++bj) { const f32x4 v0 = acc[ai][bj][m][0], v1 = acc[ai][bj][m][1];
                    float gv[8], o[8]; unpack8(*(const u32x4*)(G + row * N_GATE + 2 * DM + col0 + bj * 128), gv);
#pragma unroll
                    for (int e = 0; e < 4; ++e) { o[e] = fmaxf(gv[e], 1e-30f) * v0[e]; o[4 + e] = fmaxf(gv[4 + e], 1e-30f) * v1[e]; }
                    *(u32x4*)(mg + row * DM + col0 + bj * 128) = pack8(o); }
                asm volatile("" ::: "memory"); }
    }
};
struct EpiResid {
    static constexpr bool PERM = false, SEG = false;
    const float* xlat_in; float* xlat_out; float* ctxb; const float* modl;
    DI void operator()(const f32x4 (&acc)[2][2][4][2], const pg8::Unit& u, int wr, int wc, int fr, int fq) const {
        const int col0 = u.pn * 256 + wc * 32 + 4 * fq; const bool isctx = u.pm < 2; const int cond = isctx ? 2 : (u.pm - 2) / 64;
        const float* src = isctx ? ctxb + (size_t)u.pm * 256 * DM : xlat_in + (size_t)(u.pm - 2) * 256 * DM;
        float* dst = isctx ? ctxb + (size_t)u.pm * 256 * DM : xlat_out + (size_t)(u.pm - 2) * 256 * DM;
        const float* gate = modl + (size_t)(cond * 6 + 2) * DM + col0;
#pragma unroll
        for (int bj = 0; bj < 2; ++bj)
#pragma unroll
            for (int n = 0; n < 2; ++n) { const f32x4 gv = *(const f32x4*)(gate + bj * 128 + n * 16);
#pragma unroll
                for (int ai = 0; ai < 2; ++ai) { f32x4 xo[4];
#pragma unroll
                    for (int m = 0; m < 4; ++m) xo[m] = *(const f32x4*)(src + (size_t)(wr * 64 + fr + ai * 128 + m * 16) * DM + col0 + bj * 128 + n * 16);
#pragma unroll
                    for (int m = 0; m < 4; ++m) *(f32x4*)(dst + (size_t)(wr * 64 + fr + ai * 128 + m * 16) * DM + col0 + bj * 128 + n * 16) = xo[m] + gv * acc[ai][bj][m][n];
                    asm volatile("" ::: "memory"); } }
    }
};
struct EpiLogits {
    static constexpr bool PERM = false, SEG = false;
    float* lg;
    DI void operator()(const f32x4 (&acc)[2][2][4][2], const pg8::Unit& u, int wr, int wc, int fr, int fq) const {
        if (wc >= 2) return;
        const int row0 = u.pm * 256 + wr * 64 + fr, col0 = wc * 32 + 4 * fq;
#pragma unroll
        for (int ai = 0; ai < 2; ++ai)
#pragma unroll
            for (int m = 0; m < 4; ++m)
#pragma unroll
                for (int n = 0; n < 2; ++n) *(f32x4*)(lg + (size_t)(row0 + ai * 128 + m * 16) * 64 + col0 + n * 16) = acc[ai][0][m][n];
    }
};
struct EpiAct {
    static constexpr bool PERM = true, SEG = false;
    bf16_t* act;
    DI void operator()(const f32x4 (&acc)[2][2][4][2], const pg8::Unit& u, int wr, int wc, int fr, int fq) const {
        const int row0 = u.pm * 256 + wr * 64 + fr, col0 = u.pn * 128 + wc * 32 + 8 * fq;
#pragma unroll
        for (int ai = 0; ai < 2; ++ai)
#pragma unroll
            for (int m = 0; m < 4; ++m) { float o[8];
#pragma unroll
                for (int n = 0; n < 2; ++n)
#pragma unroll
                    for (int e = 0; e < 4; ++e) { const float gt = acc[ai][0][m][n][e], up = acc[ai][1][m][n][e]; o[4 * n + e] = gt * sigmoidf_(gt) * up; }
                *(u32x4*)(act + (size_t)(row0 + ai * 128 + m * 16) * FF + col0) = pack8(o); }
    }
};
struct EpiY {
    static constexpr bool PERM = true, SEG = false;
    bf16_t* y;
    DI void operator()(const f32x4 (&acc)[2][2][4][2], const pg8::Unit& u, int wr, int wc, int fr, int fq) const {
        const int row0 = u.pm * 256 + wr * 64 + fr, col0 = u.pn * 256 + wc * 32 + 8 * fq;
#pragma unroll
        for (int ai = 0; ai < 2; ++ai)
#pragma unroll
            for (int m = 0; m < 4; ++m) { bf16_t* rowp = y + (size_t)(row0 + ai * 128 + m * 16) * DM + col0;
#pragma unroll
                for (int bj = 0; bj < 2; ++bj) { const f32x4 v0 = acc[ai][bj][m][0], v1 = acc[ai][bj][m][1]; u32x4 w; w.x = pk2(v0[0], v0[1]); w.y = pk2(v0[2], v0[3]); w.z = pk2(v1[0], v1[1]); w.w = pk2(v1[2], v1[3]);
                    *(u32x4*)(rowp + bj * 128) = w; } }
    }
};

DI void seq_of_row(int r, int& t, int& len) { if (r < NCTX) { t = r & 255; len = CTXL; } else { t = (r - NCTX) & (SEQ - 1); len = SEQ; } }

DI void phaseC_rows(const Frame& F, int l) {
    const int gw = F.bid * 8 + F.wid, nw = F.G * 8, lane = F.lane;
    bf16_t* Q = wsp<bf16_t>(F, OFF_Q); bf16_t* Kp = wsp<bf16_t>(F, OFF_K);
    const bf16_t* POOL = wsp<bf16_t>(F, OFF_POOL); bf16_t* PD = wsp<bf16_t>(F, OFF_PDIFF);
    const bf16_t* RW = wsp<bf16_t>(F, OFF_RWRAW); bf16_t* AL = wsp<bf16_t>(F, OFF_ALORA);
    bf16_t* RR = wsp<bf16_t>(F, OFF_RR); bf16_t* RK = wsp<bf16_t>(F, OFF_RK); bf16_t* RV = wsp<bf16_t>(F, OFF_RV); bf16_t* RKK = wsp<bf16_t>(F, OFF_RKK);
    const int i8 = lane & 7, axis = i8 >> 2, sec = (i8 >> 1) & 1, fb = (i8 & 1) * 8;
    float qg[8], kg[8];
#pragma unroll
    for (int e = 0; e < 8; ++e) { qg[e] = F.in[I_QNG][l * 64 + i8 * 8 + e]; kg[e] = F.in[I_KNG][l * 64 + i8 * 8 + e]; }
    LAS float* mul_ = (LAS float*)(F.lds + 32768);
    { const float* mu = F.in[I_SHMU] + (size_t)l * 2 * RW_IN; const float* kkw = F.in[I_KK] + (size_t)l * 512;
      for (int i = F.tid; i < 2 * RW_IN + 512; i += 512) mul_[i] = i < 2 * RW_IN ? mu[i] : kkw[i - 2 * RW_IN]; }
    __syncthreads();
    const float QSCALE = 0.125f * 1.4426950408889634f;
    for (int r = gw; r < MROWS; r += nw) {
        int t, len; seq_of_row(r, t, len);
        const int half = 1 << (lane >> 4); const int lo = max(t - half, 0), hi = min(t + half - 1, len - 1);
        const bool hp = t > 0, hn = t < len - 1; const bf16_t* cur = RW + (size_t)r * 2048;
        u32x4 wq, wk, wself, xw[16], rc[4], rp[4], rn[4];
        __builtin_amdgcn_sched_barrier(0);
        wq = *(const u32x4*)(Q + (size_t)r * 512 + 8 * lane); wk = *(const u32x4*)(Kp + (size_t)r * 512 + 8 * lane);
        wself = *(const u32x4*)(POOL + (size_t)r * 512 + 8 * lane);
#pragma unroll
        for (int j = 0; j < 16; ++j) { const int tt = t - 8 + j; const bool ok = tt >= lo && tt <= hi; xw[j] = *(const u32x4*)(POOL + (size_t)(ok ? r + (tt - t) : r) * 512 + 8 * lane); }
#pragma unroll
        for (int ch = 0; ch < 4; ++ch) { const int c0 = ch * 512 + 8 * (ch == 3 ? min(lane, 47) : lane);
            rc[ch] = *(const u32x4*)(cur + c0); rp[ch] = *(const u32x4*)(cur - (hp ? 2048 : 0) + c0); rn[ch] = *(const u32x4*)(cur + (hn ? 2048 : 0) + c0); }
        __builtin_amdgcn_sched_barrier(0);
        float cs[8], sn[8];
        if (r >= NCTX) { const float pos = (float)(axis ? (t & 63) : (t >> 6));
#pragma unroll
            for (int e = 0; e < 8; ++e) { const float invf = __builtin_amdgcn_exp2f(-(float)(fb + e) * 0.83048202372184059f); const float rev = (pos * invf) * 0.15915494309189535f;
                cs[e] = __builtin_amdgcn_cosf(rev); sn[e] = __builtin_amdgcn_sinf(rev); }
        } else {
#pragma unroll
            for (int e = 0; e < 8; ++e) { cs[e] = 1.f; sn[e] = 0.f; } }
#pragma unroll
        for (int which = 0; which < 2; ++which) {
            bf16_t* p = (which ? Kp : Q) + (size_t)r * 512 + 8 * lane; float x[8]; unpack8(which ? wk : wq, x);
            float ss = 0.f;
#pragma unroll
            for (int e = 0; e < 8; ++e) ss += x[e] * x[e];
            ss = sum8(ss); const float rinv = rsqrtf(ss * (1.0f / 64.0f) + 1e-6f);
            float o[8];
#pragma unroll
            for (int e = 0; e < 8; ++e) { const float y = x[e] * rinv * (which ? kg[e] : qg[e]); const float yp = __shfl_xor(y, 2);
                o[e] = y * cs[e] + (sec ? yp : -yp) * sn[e]; if (!which) o[e] *= QSCALE; }
            *(u32x4*)p = pack8(o);
        }
        {
            float s[8], self[8];
#pragma unroll
            for (int e = 0; e < 8; ++e) s[e] = 0.f;
            unpack8(wself, self);
#pragma unroll
            for (int j = 0; j < 16; ++j) { const int tt = t - 8 + j; const float mk = (tt >= lo && tt <= hi) ? 1.0f : 0.0f; float x[8]; unpack8(xw[j], x);
#pragma unroll
                for (int e = 0; e < 8; ++e) s[e] += mk * x[e]; }
            const float ic = 1.0f / (float)(hi - lo + 1); float o[8];
#pragma unroll
            for (int e = 0; e < 8; ++e) o[e] = s[e] * ic - self[e];
            *(u32x4*)(PD + (size_t)r * 512 + 8 * lane) = pack8(o);
        }
        {
#pragma unroll
            for (int ch = 0; ch < 4; ++ch) {
                if (ch == 3 && lane >= 48) break;
                const int c0 = ch * 512 + 8 * lane; float x[8], xp[8], xn[8], u[8];
                unpack8(rc[ch], x); unpack8(rp[ch], xp); unpack8(rn[ch], xn);
                if (!hp) {
#pragma unroll
                    for (int e = 0; e < 8; ++e) xp[e] = 0.f; }
                if (!hn) {
#pragma unroll
                    for (int e = 0; e < 8; ++e) xn[e] = 0.f; }
                const f32x4 m0a = *(const LAS f32x4*)(mul_ + c0), m0b = *(const LAS f32x4*)(mul_ + c0 + 4), m1a = *(const LAS f32x4*)(mul_ + RW_IN + c0), m1b = *(const LAS f32x4*)(mul_ + RW_IN + c0 + 4);
#pragma unroll
                for (int e = 0; e < 8; ++e) { const float m0 = e < 4 ? m0a[e & 3] : m0b[e & 3], m1 = e < 4 ? m1a[e & 3] : m1b[e & 3]; u[e] = x[e] + (xp[e] - x[e]) * m0 + (xn[e] - x[e]) * m1; }
                if (ch == 0) *(u32x4*)(RR + (size_t)r * 512 + 8 * lane) = pack8(u);
                else if (ch == 2) *(u32x4*)(RV + (size_t)r * 512 + 8 * lane) = pack8(u);
                else if (ch == 1) {
                    *(u32x4*)(RK + (size_t)r * 512 + 8 * lane) = pack8(u);
                    const f32x4 kka = *(const LAS f32x4*)(mul_ + 2 * RW_IN + 8 * lane), kkb = *(const LAS f32x4*)(mul_ + 2 * RW_IN + 8 * lane + 4); float kk[8], ss = 0.f;
#pragma unroll
                    for (int e = 0; e < 8; ++e) { kk[e] = u[e] * (e < 4 ? kka[e & 3] : kkb[e & 3]); ss += kk[e] * kk[e]; }
                    ss = sum8(ss); const float inv = 1.0f / fmaxf(sqrtf(ss), 1e-12f);
#pragma unroll
                    for (int e = 0; e < 8; ++e) kk[e] *= inv;
                    *(u32x4*)(RKK + (size_t)r * 512 + 8 * lane) = pack8(kk);
                } else {
                    float o[8];
#pragma unroll
                    for (int e = 0; e < 8; ++e) { if (lane < 16) { const float ex = __expf(2.0f * u[e]); o[e] = 1.0f - 2.0f * __builtin_amdgcn_rcpf(ex + 1.0f); } else if (lane < 32) o[e] = u[e]; else o[e] = sigmoidf_(u[e]); }
                    *(u32x4*)(AL + (size_t)r * LORA_K + 8 * lane) = pack8(o);
                }
            }
        }
    }
}
DI void phaseC_vt(const Frame& F, int* cursor) {
    const bf16_t* V = wsp<bf16_t>(F, OFF_V); bf16_t* VT = wsp<bf16_t>(F, RVT);
    LAS bf16_t* T = (LAS bf16_t*)F.lds;
    LAS int* shb = (LAS int*)(F.lds + MISC_OFF + 3072);
    constexpr int NTASK = NB * 4 * (KEYS / 64);
    static_assert(NTASK % 4 == 0, "batches of four");
    for (;;) {
      if (F.tid == 0) *shb = atomicAdd(cursor, 4);
      __syncthreads();
      const int base = *shb;
      if (base >= NTASK) break;
      for (int task = base; task < base + 4; ++task) {
        const int kb = task % (KEYS / 64), bh = task / (KEYS / 64), b = bh >> 2, h = bh & 3;
        const int row0 = kb < 4 ? b * CTXL + kb * 64 : NCTX + b * SEQ + (kb - 4) * 64;
#pragma unroll
        for (int i = 0; i < 2; ++i) { const int ci = F.tid + 512 * i, j = ci >> 4, c = ci & 15;
            const u32x4 w = *(const u32x4*)(V + (size_t)(row0 + j) * 512 + h * 128 + c * 8);
            LAS unsigned* q = (LAS unsigned*)(T + j * 136 + c * 8); q[0] = w.x; q[1] = w.y; q[2] = w.z; q[3] = w.w; }
        __syncthreads();
#pragma unroll
        for (int i = 0; i < 2; ++i) { const int ci = F.tid + 512 * i, vd = ci >> 3, p8 = ci & 7; unsigned w[4];
#pragma unroll
            for (int e2 = 0; e2 < 4; ++e2) { unsigned pr = 0;
#pragma unroll
                for (int q = 0; q < 2; ++q) { const int p = p8 * 8 + e2 * 2 + q, gq = p >> 4, pp = p & 15, hh = pp >> 3, ee = pp & 7, ko = 8 * (ee >> 2) + 4 * hh + (ee & 3);
                    pr |= ((unsigned)T[(gq * 16 + ko) * 136 + vd]) << (16 * q); }
                w[e2] = pr; }
            *(u32x4*)(VT + ((size_t)bh * 128 + vd) * KEYS + kb * 64 + p8 * 8) = (u32x4){w[0], w[1], w[2], w[3]}; }
        __syncthreads();
      }
    }
}

#define MFMA32(a, b, c) __builtin_amdgcn_mfma_f32_32x32x16_bf16((a), (b), (c), 0, 0, 0)
constexpr int ATT_KB = 16384, ATT_STG = 32768;
DI void attn_phase(const Frame& F, int l, int nunits) {
    const int tid = F.tid, wid = F.wid, lane = F.lane, l32 = lane & 31, hh = lane >> 5, g = wid >> 1, m = wid & 1;
    const bf16_t* Q = wsp<bf16_t>(F, OFF_Q); const bf16_t* Kg = wsp<bf16_t>(F, OFF_K); const bf16_t* VT = wsp<bf16_t>(F, RVT); bf16_t* ATT = wsp<bf16_t>(F, OFF_POOL);
    const float* lq = F.in[I_LAMQK] + (size_t)l * 256;
    float d0 = lq[lane] * lq[64 + lane], d1 = lq[128 + lane] * lq[192 + lane]; d0 = wave_sum(d0); d1 = wave_sum(d1);
    const float lam_init = 0.8f - 0.6f * expf(-0.3f * (float)l);
    const float lam = expf(d0) - expf(d1) + lam_init, lamfac = 1.0f - lam_init;
    const float* sg = F.in[I_SUBLN] + (size_t)l * 128;
    LAS float* xch = (LAS float*)F.lds;
    LAS float* sgl = (LAS float*)(F.lds + MISC_OFF + 2048);
    if (wid < 2) sgl[wid * 64 + lane] = sg[wid * 64 + lane];
    (void)tid;
    for (int u = F.bid; u < nunits; u += F.G) {
        int b, h, qrow0, nkt;
        if (u < 512) { const int bh = u & 7, qt = ((u >> 3) & 31) + 32 * (u >> 8); b = bh >> 2; h = bh & 3; qrow0 = NCTX + b * SEQ + qt * 256; nkt = KEYS / 64; } else { const int uu = u - 512; b = uu >> 2; h = uu & 3; qrow0 = b * CTXL; nkt = 4; }
        bf16x8 qf[2][4];
#pragma unroll
        for (int qs = 0; qs < 2; ++qs) { const bf16_t* qp = Q + (size_t)(qrow0 + g * 64 + qs * 32 + l32) * 512 + h * 128 + m * 64 + hh * 8;
#pragma unroll
            for (int ks = 0; ks < 4; ++ks) qf[qs][ks] = *(const bf16x8*)(qp + ks * 16); }
        f32x16 o[2][4];
#pragma unroll
        for (int qs = 0; qs < 2; ++qs)
#pragma unroll
            for (int vt = 0; vt < 4; ++vt)
#pragma unroll
                for (int i = 0; i < 16; ++i) o[qs][vt][i] = 0.f;
        float lsum[2] = {0.f, 0.f};
        const bf16_t* vtb = VT + (size_t)(b * 4 + h) * 128 * KEYS;
#define KROW0(kt) ((kt) < 4 ? b * CTXL + (kt) * 64 : NCTX + b * SEQ + ((kt) - 4) * 64)
#define ISSUE_TILE(kt, buf) do { const int ln_ = launder(lane); const int kr0_ = KROW0(kt); _Pragma("unroll") for (int q_ = 0; q_ < 2; ++q_) { const int j_ = 2 * wid + q_; \
            { const int row_ = 4 * j_ + (ln_ >> 4), c_ = (ln_ & 15) ^ (row_ & 15); \
              __builtin_amdgcn_global_load_lds((const unsigned*)(Kg + (size_t)(kr0_ + row_) * 512 + h * 128 + c_ * 8), (LAS unsigned*)(F.lds + (buf) * ATT_STG + j_ * 1024), 16, 0, 0); } \
            { const int row_ = 8 * j_ + (ln_ >> 3), c_ = (ln_ & 7) ^ ((row_ >> 1) & 7); \
              __builtin_amdgcn_global_load_lds((const unsigned*)(vtb + (size_t)row_ * KEYS + (kt) * 64 + c_ * 8), (LAS unsigned*)(F.lds + (buf) * ATT_STG + ATT_KB + j_ * 1024), 16, 0, 0); } } } while (0)
        __syncthreads();
        ISSUE_TILE(0, 0);
        for (int kt = 0; kt < nkt; ++kt) {
            const int buf = kt & 1;
            asm volatile("s_waitcnt vmcnt(0)" ::: "memory");
            __syncthreads();
            const int ln = launder(lane); const int l32b = ln & 31, hb = ln >> 5;
            const LAS unsigned char* Kb = F.lds + buf * ATT_STG + l32b * 256; const int kx = l32b & 15;
            const LAS unsigned char* Vb = F.lds + buf * ATT_STG + ATT_KB + l32b * 128; const int vx = (l32b >> 1) & 7;
#define KFRAG(kk_, ks_) (*(const LAS bf16x8*)(Kb + (kk_) * 8192 + (((m * 8 + (ks_) * 2 + hb) ^ kx) << 4)))
#define VFRAG(kk_, i_) (*(const LAS bf16x8*)(Vb + ((i_) >> 1) * 4096 + ((((kk_) * 4 + ((i_) & 1) * 2 + hb) ^ vx) << 4)))
#define SBA_ __builtin_amdgcn_sched_barrier(0)
            bf16x8 kf[4];
#pragma unroll
            for (int ks = 0; ks < 4; ++ks) kf[ks] = KFRAG(0, ks);
            SBA_;
            if (kt + 1 < nkt) ISSUE_TILE(kt + 1, buf ^ 1);
            SBA_;
#pragma unroll
            for (int kk = 0; kk < 2; ++kk) {
                f32x16 sv[2];
#pragma unroll
                for (int qs = 0; qs < 2; ++qs)
#pragma unroll
                    for (int i = 0; i < 16; ++i) sv[qs][i] = 0.f;
#pragma unroll
                for (int ks = 0; ks < 4; ++ks) { sv[0] = MFMA32(kf[ks], qf[0][ks], sv[0]); sv[1] = MFMA32(kf[ks], qf[1][ks], sv[1]); }
                SBA_;
                bf16x8 vfr[3]; vfr[0] = VFRAG(kk, 0); vfr[1] = VFRAG(kk, 1);
                if (kk == 0) {
#pragma unroll
                    for (int ks = 0; ks < 4; ++ks) kf[ks] = KFRAG(1, ks); }
                SBA_;
                bf16x8 pb[2][2];
#pragma unroll
                for (int qs = 0; qs < 2; ++qs)
#pragma unroll
                    for (int jp = 0; jp < 2; ++jp) { u32x4 w; float p[8];
#pragma unroll
                        for (int e = 0; e < 8; ++e) { p[e] = __builtin_amdgcn_exp2f(sv[qs][8 * jp + e]); lsum[qs] += p[e]; }
                        w.x = pk2(p[0], p[1]); w.y = pk2(p[2], p[3]); w.z = pk2(p[4], p[5]); w.w = pk2(p[6], p[7]); pb[qs][jp] = __builtin_bit_cast(bf16x8, w); }
                SBA_;
#pragma unroll
                for (int i = 0; i < 8; ++i) { const int vt = i >> 1, jp = i & 1;
                    if (i + 2 < 8) vfr[(i + 2) % 3] = VFRAG(kk, i + 2);
                    SBA_;
                    o[0][vt] = MFMA32(vfr[i % 3], pb[0][jp], o[0][vt]); o[1][vt] = MFMA32(vfr[i % 3], pb[1][jp], o[1][vt]);
                    SBA_; }
            }
#undef KFRAG
#undef VFRAG
#undef SBA_
        }
#undef ISSUE_TILE
#undef KROW0
        __syncthreads();
        float cm[2];
#pragma unroll
        for (int qs = 0; qs < 2; ++qs) { const float lt = lsum[qs] + __shfl_xor(lsum[qs], 32); cm[qs] = m ? lam / lt : 1.0f / lt; }
        if (m) {
#pragma unroll
            for (int qs = 0; qs < 2; ++qs)
#pragma unroll
                for (int vt = 0; vt < 4; ++vt)
#pragma unroll
                    for (int i = 0; i < 16; ++i) xch[((g * 2 + qs) * 64 + vt * 16 + i) * 64 + lane] = o[qs][vt][i] * cm[qs];
        }
        __syncthreads();
        if (!m) {
#pragma unroll
            for (int qs = 0; qs < 2; ++qs) {
                float ss = 0.f;
#pragma unroll
                for (int vt = 0; vt < 4; ++vt)
#pragma unroll
                    for (int i = 0; i < 16; ++i) { const float v = o[qs][vt][i] * cm[qs] - xch[((g * 2 + qs) * 64 + vt * 16 + i) * 64 + lane]; o[qs][vt][i] = v; ss += v * v; }
                ss += __shfl_xor(ss, 32);
                const float rn = rsqrtf(ss * (1.0f / 128.0f) + 1e-6f) * lamfac;
                bf16_t* op = ATT + (size_t)(qrow0 + g * 64 + qs * 32 + l32) * 512 + h * 128;
#pragma unroll
                for (int vt = 0; vt < 4; ++vt)
#pragma unroll
                    for (int q4 = 0; q4 < 4; ++q4) { const int vd = vt * 32 + q4 * 8 + hh * 4; const f32x4 g4 = *(const LAS f32x4*)(sgl + vd);
                        u32x2 w; w.x = pk2(o[qs][vt][4 * q4] * rn * g4[0], o[qs][vt][4 * q4 + 1] * rn * g4[1]); w.y = pk2(o[qs][vt][4 * q4 + 2] * rn * g4[2], o[qs][vt][4 * q4 + 3] * rn * g4[3]);
                        *(u32x2*)(op + vd) = w; }
            }
        }
    }
}

DI int crow_(int reg, int h) { return (reg & 3) + 8 * (reg >> 2) + 4 * h; }
DI int swz(int row, int chunk) { return row * 128 + ((chunk ^ ((row >> 1) & 7)) << 4); }
constexpr int SL_A = 0, SL_B = 8192, SL_K = 16384, SL_V = 24576, SL_T = 32768, SL_R = 40960, WAVE_LDS = 49152;
typedef LAS unsigned char* lds_t;
DI bf16x8 fragN(lds_t base, int row, int k0, int h) { return *(const LAS bf16x8*)(base + swz(row, (k0 >> 3) + h)); }
DI bf16x8 fragK(lds_t base, int row, int kt, int s, int h) { const int c0 = 4 * kt + 2 * s; const u32x2 a = *(const LAS u32x2*)(base + swz(row, c0) + 8 * h), b = *(const LAS u32x2*)(base + swz(row, c0 + 1) + 8 * h);
    return __builtin_bit_cast(bf16x8, (u32x4){a.x, a.y, b.x, b.y}); }
DI void zero_acc(f32x16 (&acc)[2][2]) {
#pragma unroll
    for (int a = 0; a < 2; ++a)
#pragma unroll
        for (int b = 0; b < 2; ++b)
#pragma unroll
            for (int i = 0; i < 16; ++i) acc[a][b][i] = 0.f; }
DI void mm_nn(f32x16 (&acc)[2][2], lds_t A, lds_t B, int l32, int h) {
    l32 = launder(l32); h = launder(h);
    bf16x8 af[4][2], bf[4][2];
#pragma unroll
    for (int ks = 0; ks < 4; ++ks)
#pragma unroll
        for (int q = 0; q < 2; ++q) { af[ks][q] = fragN(A, 32 * q + l32, 16 * ks, h); bf[ks][q] = fragN(B, 32 * q + l32, 16 * ks, h); }
#pragma unroll
    for (int ks = 0; ks < 4; ++ks)
#pragma unroll
        for (int ra = 0; ra < 2; ++ra)
#pragma unroll
            for (int cb = 0; cb < 2; ++cb) if (!(ra == 1 && cb == 0)) acc[ra][cb] = MFMA32(af[ks][ra], bf[ks][cb], acc[ra][cb]);
}
DI void mm_nn_lp(f32x16 (&acc)[2][2], lds_t A, lds_t B, int l32, int h) {
    l32 = launder(l32); h = launder(h);
#pragma unroll
    for (int kp = 0; kp < 2; ++kp) { bf16x8 af[2][2], bf[2][2];
#pragma unroll
        for (int ks = 0; ks < 2; ++ks)
#pragma unroll
            for (int q = 0; q < 2; ++q) { af[ks][q] = fragN(A, 32 * q + l32, 16 * (2 * kp + ks), h); bf[ks][q] = fragN(B, 32 * q + l32, 16 * (2 * kp + ks), h); }
#pragma unroll
        for (int ks = 0; ks < 2; ++ks)
#pragma unroll
            for (int ra = 0; ra < 2; ++ra)
#pragma unroll
                for (int cb = 0; cb < 2; ++cb) acc[ra][cb] = MFMA32(af[ks][ra], bf[ks][cb], acc[ra][cb]); }
}
DI void mm_xt(f32x16 (&acc)[2][2], const bf16x8 (&xf)[2][2][2], lds_t Y, int l32, int h) {
    l32 = launder(l32); h = launder(h);
#pragma unroll
    for (int it = 0; it < 2; ++it)
#pragma unroll
        for (int s = 0; s < 2; ++s) { bf16x8 yf[2];
#pragma unroll
            for (int vt = 0; vt < 2; ++vt) yf[vt] = fragK(Y, 32 * vt + l32, it, s, h);
#pragma unroll
            for (int tt = 0; tt < 2; ++tt)
#pragma unroll
                for (int vt = 0; vt < 2; ++vt) if (!(it == 1 && tt == 0)) acc[vt][tt] = MFMA32(yf[vt], xf[it][tt][s], acc[vt][tt]); }
}
DI void mm_st(f32x16 (&acc)[2][2], lds_t A, const bf16x8 (&sf)[2][2][2], int l32, int h) {
    l32 = launder(l32); h = launder(h);
#pragma unroll
    for (int ct = 0; ct < 2; ++ct)
#pragma unroll
        for (int s = 0; s < 2; ++s) { bf16x8 af[2];
#pragma unroll
            for (int tt = 0; tt < 2; ++tt) af[tt] = fragK(A, 32 * tt + l32, ct, s, h);
#pragma unroll
            for (int tt = 0; tt < 2; ++tt)
#pragma unroll
                for (int vt = 0; vt < 2; ++vt) acc[vt][tt] = MFMA32(sf[ct][vt][s], af[tt], acc[vt][tt]); }
}
DI bf16x8 pack_regs(const f32x16& x, int s) { u32x4 w; w.x = pk2(x[8 * s], x[8 * s + 1]); w.y = pk2(x[8 * s + 2], x[8 * s + 3]); w.z = pk2(x[8 * s + 4], x[8 * s + 5]); w.w = pk2(x[8 * s + 6], x[8 * s + 7]); return __builtin_bit_cast(bf16x8, w); }
template <int INCL> DI void pack_masked(const f32x16 (&acc)[2][2], bf16x8 (&xf)[2][2][2], int l32, int h) {
    l32 = launder(l32); h = launder(h);
#pragma unroll
    for (int it = 0; it < 2; ++it)
#pragma unroll
        for (int tt = 0; tt < 2; ++tt) {
            if (it > tt) { xf[it][tt][0] = (bf16x8){0, 0, 0, 0, 0, 0, 0, 0}; xf[it][tt][1] = (bf16x8){0, 0, 0, 0, 0, 0, 0, 0}; continue; }
            if (it < tt) { xf[it][tt][0] = pack_regs(acc[it][tt], 0); xf[it][tt][1] = pack_regs(acc[it][tt], 1); continue; }
            f32x16 m;
#pragma unroll
            for (int r = 0; r < 16; ++r) { const int i = crow_(r, h); m[r] = (INCL ? i <= l32 : i < l32) ? acc[it][tt][r] : 0.f; }
            xf[it][tt][0] = pack_regs(m, 0); xf[it][tt][1] = pack_regs(m, 1); }
}
DI void store_tm(const f32x16 (&acc)[2][2], lds_t img, int l32, int h) {
    l32 = launder(l32); h = launder(h);
#pragma unroll
    for (int a = 0; a < 2; ++a)
#pragma unroll
        for (int b = 0; b < 2; ++b)
#pragma unroll
            for (int q = 0; q < 4; ++q) { u32x2 w; w.x = pk2(acc[a][b][4 * q], acc[a][b][4 * q + 1]); w.y = pk2(acc[a][b][4 * q + 2], acc[a][b][4 * q + 3]);
                *(LAS u32x2*)(img + swz(32 * b + l32, 4 * a + q) + 8 * h) = w; }
}
DI void solve_rows(lds_t rhs, lds_t tab, lds_t out, int lane) {
    lane = launder(lane);
    lds_t orow = out + lane * 128; const int sw = (lane >> 1) & 7; const int rb = ((lane >> 3) << 4), rl = (lane & 7) * 2;
    const int l32 = lane & 31, h = lane >> 5;
#define DOT4(a, cw, xw, j0) asm volatile("v_dot2c_f32_bf16 %0, %4, %20\n\tv_dot2c_f32_bf16 %1, %8, %20\n\tv_dot2c_f32_bf16 %2, %12, %20\n\tv_dot2c_f32_bf16 %3, %16, %20\n\t" \
                              "v_dot2c_f32_bf16 %0, %5, %21\n\tv_dot2c_f32_bf16 %1, %9, %21\n\tv_dot2c_f32_bf16 %2, %13, %21\n\tv_dot2c_f32_bf16 %3, %17, %21\n\t" \
                              "v_dot2c_f32_bf16 %0, %6, %22\n\tv_dot2c_f32_bf16 %1, %10, %22\n\tv_dot2c_f32_bf16 %2, %14, %22\n\tv_dot2c_f32_bf16 %3, %18, %22\n\t" \
                              "v_dot2c_f32_bf16 %0, %7, %23\n\tv_dot2c_f32_bf16 %1, %11, %23\n\tv_dot2c_f32_bf16 %2, %15, %23\n\tv_dot2c_f32_bf16 %3, %19, %23\n\ts_nop 3" \
                : "+v"(a[j0]), "+v"(a[j0 + 1]), "+v"(a[j0 + 2]), "+v"(a[j0 + 3]) \
                : "v"(cw[j0].x), "v"(cw[j0].y), "v"(cw[j0].z), "v"(cw[j0].w), "v"(cw[j0 + 1].x), "v"(cw[j0 + 1].y), "v"(cw[j0 + 1].z), "v"(cw[j0 + 1].w), \
                  "v"(cw[j0 + 2].x), "v"(cw[j0 + 2].y), "v"(cw[j0 + 2].z), "v"(cw[j0 + 2].w), "v"(cw[j0 + 3].x), "v"(cw[j0 + 3].y), "v"(cw[j0 + 3].z), "v"(cw[j0 + 3].w), \
                  "v"(xw.x), "v"(xw.y), "v"(xw.z), "v"(xw.w))
    f32x16 u0[2], u1[2], zero;
#pragma unroll
    for (int i = 0; i < 16; ++i) { zero[i] = 0.f; u1[0][i] = 0.f; u1[1][i] = 0.f; u0[0][i] = 0.f; u0[1][i] = 0.f; }
#pragma unroll
    for (int b = 0; b < 4; ++b) {
        const int tA = 16 * b, tB = tA + 8, cA = 2 * b, cB = cA + 1;
        float a[8], a2[8]; u32x4 dg0[8], cw[8], dg1[8];
#pragma unroll
        for (int j = 0; j < 8; ++j) { const int t = tA + j, u = tB + j;
            a[j] = bf2f(*(const LAS bf16_t*)(rhs + t * 128 + (rb ^ (((t >> 1) & 7) << 4)) + rl)); a2[j] = bf2f(*(const LAS bf16_t*)(rhs + u * 128 + (rb ^ (((u >> 1) & 7) << 4)) + rl)); }
#pragma unroll
        for (int j = 0; j < 8; ++j) { const int t = tA + j, u = tB + j;
            dg0[j] = *(const LAS u32x4*)(tab + t * 128 + ((cA ^ ((t >> 1) & 7)) << 4)); cw[j] = *(const LAS u32x4*)(tab + u * 128 + ((cA ^ ((u >> 1) & 7)) << 4)); dg1[j] = *(const LAS u32x4*)(tab + u * 128 + ((cB ^ ((u >> 1) & 7)) << 4)); }
        if (b > 0) { const int k0 = 16 * (b - 1); const bf16x8 xb0 = fragN(out, l32, k0, h), xb1 = fragN(out, 32 + l32, k0, h);
            if (b == 1) { const bf16x8 af0 = fragN(tab, l32, k0, h); u0[0] = MFMA32(af0, xb0, zero); u0[1] = MFMA32(af0, xb1, zero); }
            const bf16x8 af1 = fragN(tab, 32 + l32, k0, h); u1[0] = MFMA32(af1, xb0, u1[0]); u1[1] = MFMA32(af1, xb1, u1[1]);
            const int R0 = (b == 2) ? 0 : 8;
#pragma unroll
            for (int i = 0; i < 8; ++i) { const float X = (b == 1) ? u0[0][R0 + i] : u1[0][R0 + i], Y = (b == 1) ? u0[1][R0 + i] : u1[1][R0 + i];
                const auto r = __builtin_amdgcn_permlane32_swap(__float_as_uint(X), __float_as_uint(Y), false, false);
                const float lo = __uint_as_float(r[0]), hi = __uint_as_float(r[1]);
                if (i < 4) { a[i] += lo; a[4 + i] += hi; } else { a2[i - 4] += lo; a2[i] += hi; } }
        }
#pragma unroll
        for (int j = 1; j < 8; ++j) { float cf[8]; unpack8(dg0[j], cf);
#pragma unroll
            for (int q = 0; q < 8; ++q) if (q < j) a[j] += cf[q] * a[q]; }
        const u32x4 x0 = pack8(a);
        *(LAS u32x4*)(orow + ((cA ^ sw) << 4)) = x0;
        DOT4(a2, cw, x0, 0); DOT4(a2, cw, x0, 4);
#pragma unroll
        for (int j = 1; j < 8; ++j) { float cf[8]; unpack8(dg1[j], cf);
#pragma unroll
            for (int q = 0; q < 8; ++q) if (q < j) a2[j] += cf[q] * a2[q]; }
        *(LAS u32x4*)(orow + ((cB ^ sw) << 4)) = pack8(a2);
    }
#undef DOT4
}
struct ScanTask { int chain, h, r0, sgn; };
DI int scan_order(int q) { const int rbk = q >> 5, j = q & 31, dir = j & 1, bh = j >> 1, chain = dir * 16 + bh;
    const int ck = dir ? (rbk < 4 ? 3 - rbk : 4 + 255 - (rbk - 4)) : rbk; return chain * NCHUNK + ck; }
DI int scan_deal(int bid, int slot3, int trip, int G) {
    if (G != 256) { const int q = bid * 3 + slot3 + trip * G * 3; return q < 32 * NCHUNK ? scan_order(q) : -1; }
    const int xcd = bid & 7, sl = (bid >> 3) * 3 + slot3, grp = (trip * 8 + xcd) * 6 + sl / 16, mem = sl % 16;
    if (grp >= 2 * NCHUNK) return -1;
    const int rbk = grp >> 1, b = grp & 1, dir = mem & 1, hd = mem >> 1, chain = dir * 16 + b * 8 + hd;
    const int ck = dir ? (rbk < 4 ? 3 - rbk : 4 + 255 - (rbk - 4)) : rbk; return chain * NCHUNK + ck; }

DI ScanTask scan_task(int task) { ScanTask T; T.chain = task / NCHUNK; const int ck = task % NCHUNK, dir = T.chain >> 4, b = (T.chain >> 3) & 1; T.h = T.chain & 7;
    int base, len, c2; if (ck < 4) { base = b * CTXL; len = CTXL; c2 = ck; } else { base = NCTX + b * SEQ; len = SEQ; c2 = ck - 4; }
    T.r0 = dir ? base + len - 1 - 64 * c2 : base + 64 * c2; T.sgn = dir ? -1 : 1; return T; }
DI void write_cm_row(lds_t img, const unsigned (&pk)[32], int lane) {
    lane = launder(lane);
#pragma unroll
    for (int ch = 0; ch < 8; ++ch) *(LAS u32x4*)(img + swz(lane, ch)) = (u32x4){pk[4 * ch], pk[4 * ch + 1], pk[4 * ch + 2], pk[4 * ch + 3]};
}
DI void stage_raw(const bf16_t* src, const ScanTask& T, lds_t dst, int lane) {
    lane = launder(lane);
#pragma unroll
    for (int i = 0; i < 8; ++i) { const int q = lane + 64 * i, t = q >> 3, c8 = q & 7;
        *(LAS u32x4*)(dst + swz(t, c8)) = *(const u32x4*)(src + (size_t)(T.r0 + T.sgn * t) * 512 + T.h * 64 + c8 * 8); }
}
template <int N> DI void stage_raw_n(const bf16_t* const (&src)[N], const int (&slot)[N], const ScanTask& T, lds_t wl, int lane) {
    lane = launder(lane);
    u32x4 v[N][8];
    __builtin_amdgcn_sched_barrier(0);
#pragma unroll
    for (int p = 0; p < N; ++p)
#pragma unroll
        for (int i = 0; i < 8; ++i) { const int q = lane + 64 * i, t = q >> 3, c8 = q & 7; v[p][i] = *(const u32x4*)(src[p] + (size_t)(T.r0 + T.sgn * t) * 512 + T.h * 64 + c8 * 8); }
    __builtin_amdgcn_sched_barrier(0);
#pragma unroll
    for (int p = 0; p < N; ++p)
#pragma unroll
        for (int i = 0; i < 8; ++i) { const int q = lane + 64 * i, t = q >> 3, c8 = q & 7; *(LAS u32x4*)(wl + slot[p] + swz(t, c8)) = v[p][i]; }
    __builtin_amdgcn_sched_barrier(0);
}
DI void read_col(lds_t img, unsigned (&pk)[32], int lane) {
    lane = launder(lane);
    const int tw = ((lane >> 3) << 4), tb = (lane & 7) * 2;
    unsigned lo[32], hi[32];
#pragma unroll
    for (int t2 = 0; t2 < 32; ++t2) { const int ta = 2 * t2, tc = 2 * t2 + 1;
        lo[t2] = *(const LAS bf16_t*)(img + ta * 128 + (tw ^ (((ta >> 1) & 7) << 4)) + tb); hi[t2] = *(const LAS bf16_t*)(img + tc * 128 + (tw ^ (((tc >> 1) & 7) << 4)) + tb); }
#pragma unroll
    for (int t2 = 0; t2 < 32; ++t2) pk[t2] = lo[t2] | (hi[t2] << 16);
}
template <bool P3>
DI float scan_prep(const Frame& F, int l, const ScanTask& T, lds_t wl, int lane) {
    const int dir = T.chain >> 4;
    if (P3) { const bf16_t* const src[6] = {wsp<bf16_t>(F, OFF_RKK), wsp<bf16_t>(F, OFF_RK), wsp<bf16_t>(F, dir ? OFF_AB : OFF_AF), wsp<bf16_t>(F, dir ? OFF_EB : OFF_EF), wsp<bf16_t>(F, OFF_RV), wsp<bf16_t>(F, OFF_RR)};
        const int slot[6] = {SL_A, SL_K, SL_B, SL_T, SL_V, SL_R}; stage_raw_n<6>(src, slot, T, wl, lane); }
    else { const bf16_t* const src[5] = {wsp<bf16_t>(F, OFF_RKK), wsp<bf16_t>(F, OFF_RK), wsp<bf16_t>(F, dir ? OFF_AB : OFF_AF), wsp<bf16_t>(F, dir ? OFF_EB : OFF_EF), wsp<bf16_t>(F, OFF_RV)};
        const int slot[5] = {SL_A, SL_K, SL_B, SL_T, SL_V}; stage_raw_n<5>(src, slot, T, wl, lane); }
    const float ka = F.in[I_KA][(size_t)l * 512 + T.h * 64 + lane];
    float E2 = 0.f, gprev = 1.f;
    lane = launder(lane);
    const int tw = ((lane >> 3) << 4), tb = (lane & 7) * 2;
#pragma unroll 1
    for (int t8 = 0; t8 < 8; ++t8) {
        float kk_[8], k_[8], al_[8], e_[8], r_[8]; int off_[8];
#pragma unroll
        for (int j = 0; j < 8; ++j) { const int t = t8 * 8 + j; off_[j] = t * 128 + (tw ^ (((t >> 1) & 7) << 4)) + tb;
            kk_[j] = bf2f(*(const LAS bf16_t*)(wl + SL_A + off_[j])); k_[j] = bf2f(*(const LAS bf16_t*)(wl + SL_K + off_[j])); al_[j] = bf2f(*(const LAS bf16_t*)(wl + SL_B + off_[j]));
            e_[j] = bf2f(*(const LAS bf16_t*)(wl + SL_T + off_[j])); r_[j] = P3 ? bf2f(*(const LAS bf16_t*)(wl + SL_R + off_[j])) : 0.f; }
#pragma unroll
        for (int j = 0; j < 8; ++j) {
            E2 += e_[j] * 1.4426950408889634f;
            const float g = __builtin_amdgcn_exp2f(-E2), ex = __builtin_amdgcn_rcpf(g);
            const float at = -kk_[j] * gprev, bh = kk_[j] * al_[j] * ex, kh = k_[j] * (1.0f + (al_[j] - 1.0f) * ka) * ex;
            gprev = g;
            if (P3) *(LAS bf16_t*)(wl + SL_R + off_[j]) = f2bf(r_[j] * g);
            *(LAS bf16_t*)(wl + SL_A + off_[j]) = f2bf(at); *(LAS bf16_t*)(wl + SL_B + off_[j]) = f2bf(bh); *(LAS bf16_t*)(wl + SL_K + off_[j]) = f2bf(kh);
        }
    }
    { unsigned vcm[32]; read_col(wl + SL_V, vcm, lane); write_cm_row(wl + SL_V, vcm, lane); }
    return gprev;
}
DI void make_table(lds_t wl, int l32, int h, int slot_b = SL_B) {
    l32 = launder(l32); h = launder(h);
    f32x16 acc[2][2]; zero_acc(acc); mm_nn(acc, wl + slot_b, wl + SL_A, l32, h);
#pragma unroll
    for (int it = 0; it < 2; ++it)
#pragma unroll
        for (int tt = 0; tt < 2; ++tt)
#pragma unroll
            for (int q = 0; q < 4; ++q) { if (it > tt) continue;
                const int t = 32 * tt + l32, i0 = 8 * q + 4 * h; float v[4];
#pragma unroll
                for (int e = 0; e < 4; ++e) v[e] = (it < tt || i0 + e < l32) ? acc[it][tt][4 * q + e] : 0.f;
                u32x2 w; w.x = pk2(v[0], v[1]); w.y = pk2(v[2], v[3]);
                *(LAS u32x2*)(wl + SL_T + swz(t, 4 * it + q) + 8 * h) = w; }
}
DI void scan_pass1(const Frame& F, int l) {
    const int lane = F.lane, l32 = lane & 31, h = lane >> 5, pr = F.wid >> 1, role = F.wid & 1;
    lds_t wl = F.lds + (pr < 3 ? pr : 0) * WAVE_LDS; LAS float* gtab = (LAS float*)(F.lds + MISC_OFF + 512 + (pr < 3 ? pr : 0) * 256);
    u32x4* MP = wsp<u32x4>(F, OFF_MP); u32x4* NS = wsp<u32x4>(F, OFF_NS);
    const int ntrip = (32 * NCHUNK + F.G * 3 - 1) / (F.G * 3);
    u32x4 pf[3][8];
#define P1_REQUEST(task_) do { const ScanTask Tq_ = scan_task(task_); const int dq_ = Tq_.chain >> 4; const int ln_ = launder(lane); \
        const bf16_t* s0_ = role ? wsp<bf16_t>(F, OFF_RK) : wsp<bf16_t>(F, OFF_RKK); const bf16_t* s1_ = role ? wsp<bf16_t>(F, OFF_RV) : wsp<bf16_t>(F, dq_ ? OFF_AB : OFF_AF); const bf16_t* s2_ = wsp<bf16_t>(F, dq_ ? OFF_EB : OFF_EF); \
        __builtin_amdgcn_sched_barrier(0); \
        _Pragma("unroll") for (int i_ = 0; i_ < 8; ++i_) { const int q_ = ln_ + 64 * i_, t_ = q_ >> 3, c8_ = q_ & 7; const size_t ro_ = (size_t)(Tq_.r0 + Tq_.sgn * t_) * 512 + Tq_.h * 64 + c8_ * 8; \
            pf[0][i_] = *(const u32x4*)(s0_ + ro_); pf[1][i_] = *(const u32x4*)(s1_ + ro_); if (role == 0) pf[2][i_] = *(const u32x4*)(s2_ + ro_); else asm volatile("" : "=v"(pf[2][i_].x), "=v"(pf[2][i_].y), "=v"(pf[2][i_].z), "=v"(pf[2][i_].w)); } \
        __builtin_amdgcn_sched_barrier(0); } while (0)
#define P1_UNDEF() do { _Pragma("unroll") for (int p_ = 0; p_ < 3; ++p_) _Pragma("unroll") for (int i_ = 0; i_ < 8; ++i_) asm volatile("" : "=v"(pf[p_][i_].x), "=v"(pf[p_][i_].y), "=v"(pf[p_][i_].z), "=v"(pf[p_][i_].w)); } while (0)
    { const int t0_ = pr < 3 ? scan_deal(F.bid, pr, 0, F.G) : -1; if (t0_ >= 0) P1_REQUEST(t0_); else P1_UNDEF(); }
    for (int trip = 0; trip < ntrip; ++trip) {
        const int task_ = pr < 3 ? scan_deal(F.bid, pr, trip, F.G) : -1; const bool on = task_ >= 0; const int task = on ? task_ : 0;
        ScanTask T = scan_task(on ? task : 0); const int dir = T.chain >> 4; (void)dir;
        const int tw = ((launder(lane) >> 3) << 4), tb = (launder(lane) & 7) * 2;
        if (on) { const int ln_ = launder(lane);
#pragma unroll
            for (int i_ = 0; i_ < 8; ++i_) { const int q_ = ln_ + 64 * i_, t_ = q_ >> 3, c8_ = q_ & 7;
                *(LAS u32x4*)(wl + (role ? SL_K : SL_A) + swz(t_, c8_)) = pf[0][i_]; *(LAS u32x4*)(wl + (role ? SL_V : SL_B) + swz(t_, c8_)) = pf[1][i_]; if (role == 0) *(LAS u32x4*)(wl + SL_T + swz(t_, c8_)) = pf[2][i_]; } }
        __syncthreads();
        if (on) {
            const float ka = F.in[I_KA][(size_t)l * 512 + T.h * 64 + lane];
            float E2 = 0.f, gprev = 1.f;
#pragma unroll 1
            for (int t8 = 0; t8 < 8; ++t8) {
                float x_[8], al_[8], e_[8]; int off_[8];
#pragma unroll
                for (int j = 0; j < 8; ++j) { const int t = t8 * 8 + j; off_[j] = t * 128 + (tw ^ (((t >> 1) & 7) << 4)) + tb;
                    x_[j] = bf2f(*(const LAS bf16_t*)(wl + (role ? SL_K : SL_A) + off_[j])); al_[j] = bf2f(*(const LAS bf16_t*)(wl + SL_B + off_[j])); e_[j] = bf2f(*(const LAS bf16_t*)(wl + SL_T + off_[j])); }
#pragma unroll
                for (int j = 0; j < 8; ++j) {
                    E2 += e_[j] * 1.4426950408889634f;
                    const float g = __builtin_amdgcn_exp2f(-E2), ex = __builtin_amdgcn_rcpf(g);
                    if (role == 0) { *(LAS bf16_t*)(wl + SL_A + off_[j]) = f2bf(-x_[j] * gprev); *(LAS bf16_t*)(wl + SL_R + off_[j]) = f2bf(x_[j] * al_[j] * ex); }
                    else *(LAS bf16_t*)(wl + SL_K + off_[j]) = f2bf(x_[j] * (1.0f + (al_[j] - 1.0f) * ka) * ex);
                    gprev = g;
                }
            }
            if (role == 0) gtab[lane] = gprev;
            else { unsigned vcm[32]; read_col(wl + SL_V, vcm, lane); write_cm_row(wl + SL_V, vcm, lane); }
        }
        __syncthreads();
        if (on) {
            if (role == 0) make_table(wl, l32, h, SL_R);
            else { bf16x8 xf[2][2][2];
                { f32x16 acc[2][2]; zero_acc(acc); mm_nn(acc, wl + SL_K, wl + SL_A, l32, h); pack_masked<0>(acc, xf, l32, h); }
                __builtin_amdgcn_sched_barrier(0);
                { f32x16 acc[2][2]; zero_acc(acc); mm_xt(acc, xf, wl + SL_V, l32, h); store_tm(acc, wl + SL_B, l32, h); } }
        }
        __syncthreads();
        if (on) {
            if (role == 0) { unsigned bcm[32]; read_col(wl + SL_R, bcm, lane); __builtin_amdgcn_sched_barrier(0);
                solve_rows(wl + SL_A, wl + SL_T, wl + SL_R, lane); __builtin_amdgcn_sched_barrier(0);
                write_cm_row(wl + SL_A, bcm, lane); }
            else { unsigned kcm[32]; read_col(wl + SL_K, kcm, lane); __builtin_amdgcn_sched_barrier(0);
                solve_rows(wl + SL_B, wl + SL_T, wl + SL_K, lane); __builtin_amdgcn_sched_barrier(0);
                write_cm_row(wl + SL_B, kcm, lane); }
        }
        __syncthreads();
        { const int tn_ = (pr < 3 && trip + 1 < ntrip) ? scan_deal(F.bid, pr, trip + 1, F.G) : -1; if (tn_ >= 0) P1_REQUEST(tn_); else P1_UNDEF(); }
        if (on) {
            if (role == 0) { u32x4* mp = MP + (size_t)task * 512 + launder(lane);
                f32x16 acc[2][2]; zero_acc(acc); mm_nn_lp(acc, wl + SL_R, wl + SL_A, l32, h);
#pragma unroll
                for (int ct = 0; ct < 2; ++ct)
#pragma unroll
                    for (int cp = 0; cp < 2; ++cp) { const float gc = gtab[32 * cp + launder(l32)]; f32x16 m;
#pragma unroll
                        for (int r = 0; r < 16; ++r) m[r] = (acc[ct][cp][r] + ((ct == cp && crow_(r, h) == l32) ? 1.0f : 0.0f)) * gc;
                        mp[((ct * 2 + cp) * 2 + 0) * 64] = __builtin_bit_cast(u32x4, pack_regs(m, 0)); mp[((ct * 2 + cp) * 2 + 1) * 64] = __builtin_bit_cast(u32x4, pack_regs(m, 1)); }
            } else { u32x4* ns = NS + (size_t)task * 512 + launder(lane);
                f32x16 acc[2][2]; zero_acc(acc); mm_nn_lp(acc, wl + SL_A, wl + SL_K, l32, h); mm_nn_lp(acc, wl + SL_B, wl + SL_V, l32, h);
#pragma unroll
                for (int cp = 0; cp < 2; ++cp)
#pragma unroll
                    for (int vt = 0; vt < 2; ++vt) { f32x16 m;
#pragma unroll
                        for (int q = 0; q < 4; ++q) { const f32x4 g4 = *(const LAS f32x4*)(gtab + 32 * cp + 8 * q + 4 * h);
#pragma unroll
                            for (int e = 0; e < 4; ++e) m[4 * q + e] = acc[cp][vt][4 * q + e] * g4[e]; }
                        ns[((cp * 2 + vt) * 2 + 0) * 64] = __builtin_bit_cast(u32x4, pack_regs(m, 0)); ns[((cp * 2 + vt) * 2 + 1) * 64] = __builtin_bit_cast(u32x4, pack_regs(m, 1)); }
            }
        }
        __syncthreads();
    }
#undef P1_REQUEST
#undef P1_UNDEF
}
DI void scan_pass2(const Frame& F, int l) {
    if (F.bid >= 64) { conv_expert_weights(F, l, 1);
        return; }
    if (F.wid != 0) return;
    const int lane = F.lane;
    for (int task = F.bid; task < 64; task += F.G) {
        const int chain = task >> 1, vt = task & 1;
        const u32x4* MP = wsp<u32x4>(F, OFF_MP) + (size_t)chain * NCHUNK * 512 + lane; u32x4* NS = wsp<u32x4>(F, OFF_NS) + (size_t)chain * NCHUNK * 512 + lane;
        u32x4 sf[2][2], mA[8], nA[2][2], mB[8], nB[2][2], mC[8], nC[2][2];
#define P2_LOAD(m_, n_, ck_) do { _Pragma("unroll") for (int i_ = 0; i_ < 8; ++i_) m_[i_] = MP[(size_t)(ck_) * 512 + i_ * 64]; \
        _Pragma("unroll") for (int a_ = 0; a_ < 2; ++a_) _Pragma("unroll") for (int st_ = 0; st_ < 2; ++st_) n_[a_][st_] = NS[(size_t)(ck_) * 512 + ((a_ * 2 + vt) * 2 + st_) * 64]; } while (0)
#define P2_STEP(m_, n_, ck_) do { \
        _Pragma("unroll") for (int a_ = 0; a_ < 2; ++a_) _Pragma("unroll") for (int st_ = 0; st_ < 2; ++st_) NS[(size_t)(ck_) * 512 + ((a_ * 2 + vt) * 2 + st_) * 64] = sf[a_][st_];        \
        f32x16 acc_[2]; \
        _Pragma("unroll") for (int cp_ = 0; cp_ < 2; ++cp_) _Pragma("unroll") for (int st_ = 0; st_ < 2; ++st_) { float f_[8]; unpack8(n_[cp_][st_], f_); \
            _Pragma("unroll") for (int j_ = 0; j_ < 8; ++j_) acc_[cp_][8 * st_ + j_] = f_[j_]; } \
        _Pragma("unroll") for (int ct_ = 0; ct_ < 2; ++ct_) _Pragma("unroll") for (int st_ = 0; st_ < 2; ++st_) _Pragma("unroll") for (int cp_ = 0; cp_ < 2; ++cp_) \
            acc_[cp_] = MFMA32(__builtin_bit_cast(bf16x8, m_[(ct_ * 2 + cp_) * 2 + st_]), __builtin_bit_cast(bf16x8, sf[ct_][st_]), acc_[cp_]); \
        _Pragma("unroll") for (int ct_ = 0; ct_ < 2; ++ct_) { sf[ct_][0] = __builtin_bit_cast(u32x4, pack_regs(acc_[ct_], 0)); sf[ct_][1] = __builtin_bit_cast(u32x4, pack_regs(acc_[ct_], 1)); } } while (0)
#pragma unroll
        for (int a = 0; a < 2; ++a)
#pragma unroll
            for (int st = 0; st < 2; ++st) sf[a][st] = (u32x4){0u, 0u, 0u, 0u};
        P2_LOAD(mA, nA, 0); P2_LOAD(mB, nB, 1);
        for (int ck = 0; ck < NCHUNK; ck += 3) {
            { const int nx = ck + 2 < NCHUNK ? ck + 2 : NCHUNK - 1; P2_LOAD(mC, nC, nx); }
            P2_STEP(mA, nA, ck);
            if (ck + 1 < NCHUNK) { { const int nx = ck + 3 < NCHUNK ? ck + 3 : NCHUNK - 1; P2_LOAD(mA, nA, nx); } P2_STEP(mB, nB, ck + 1); }
            if (ck + 2 < NCHUNK) { { const int nx = ck + 4 < NCHUNK ? ck + 4 : NCHUNK - 1; P2_LOAD(mB, nB, nx); } P2_STEP(mC, nC, ck + 2); }
        }
#undef P2_LOAD
#undef P2_STEP
    }
}
DI void scan_pass3(const Frame& F, int l) {
    if (F.wid >= 3) return;
    const int lane = F.lane, l32 = lane & 31, h = lane >> 5;
    lds_t wl = F.lds + F.wid * WAVE_LDS;
    const u32x4* NS = wsp<u32x4>(F, OFF_NS);
    const int ntrip3 = (32 * NCHUNK + F.G * 3 - 1) / (F.G * 3);
    for (int trip = 0; trip < ntrip3; ++trip) {
        const int task = scan_deal(F.bid, F.wid, trip, F.G); if (task < 0) continue;
        const ScanTask T = scan_task(task);
        (void)scan_prep<true>(F, l, T, wl, lane);
        make_table(wl, l32, h);
#define SB_ __builtin_amdgcn_sched_barrier(0)
#define LOAD_SF() do { const u32x4* ns = NS + (size_t)task * 512 + lane; _Pragma("unroll") for (int i = 0; i < 8; ++i) sf[i >> 2][(i >> 1) & 1][i & 1] = __builtin_bit_cast(bf16x8, ns[i * 64]); } while (0)
        bf16x8 xf[2][2][2], xg[2][2][2];
        { f32x16 acc[2][2]; zero_acc(acc); mm_nn(acc, wl + SL_K, wl + SL_A, l32, h); pack_masked<0>(acc, xf, l32, h); }
        SB_;
        { bf16x8 sf[2][2][2]; LOAD_SF(); f32x16 acc[2][2]; zero_acc(acc); mm_st(acc, wl + SL_A, sf, l32, h); SB_; mm_xt(acc, xf, wl + SL_V, l32, h); SB_; store_tm(acc, wl + SL_A, l32, h); }
        SB_;
        { f32x16 acc[2][2]; zero_acc(acc); mm_nn(acc, wl + SL_B, wl + SL_R, l32, h); pack_masked<1>(acc, xf, l32, h); }
        SB_;
        solve_rows(wl + SL_A, wl + SL_T, wl + SL_B, lane);
        SB_;
        unsigned tch[7]; const int tn_ = trip + 1 < ntrip3 ? scan_deal(F.bid, F.wid, trip + 1, F.G) : -1;
        if (tn_ >= 0) { const ScanTask Tn = scan_task(tn_); const int dn = Tn.chain >> 4; const size_t ro = (size_t)(Tn.r0 + Tn.sgn * launder(lane)) * 512 + Tn.h * 64;
            tch[0] = *(const unsigned*)(wsp<bf16_t>(F, OFF_RKK) + ro); tch[1] = *(const unsigned*)(wsp<bf16_t>(F, OFF_RK) + ro); tch[2] = *(const unsigned*)(wsp<bf16_t>(F, dn ? OFF_AB : OFF_AF) + ro);
            tch[3] = *(const unsigned*)(wsp<bf16_t>(F, dn ? OFF_EB : OFF_EF) + ro); tch[4] = *(const unsigned*)(wsp<bf16_t>(F, OFF_RV) + ro); tch[5] = *(const unsigned*)(wsp<bf16_t>(F, OFF_RR) + ro);
            tch[6] = *((const unsigned*)(NS + (size_t)tn_ * 512) + launder(lane) * 32); }
        else {
#pragma unroll
            for (int i = 0; i < 7; ++i) tch[i] = 0u; }
        SB_;
        f32x16 y[2][2]; zero_acc(y);
        mm_xt(y, xf, wl + SL_B, l32, h);
        SB_;
        { bf16x8 sf[2][2][2]; LOAD_SF(); mm_st(y, wl + SL_R, sf, l32, h); }
        SB_;
        { f32x16 acc[2][2]; zero_acc(acc); mm_nn(acc, wl + SL_K, wl + SL_R, l32, h); pack_masked<1>(acc, xg, l32, h); }
        SB_;
        mm_xt(y, xg, wl + SL_V, l32, h);
        SB_;
#undef LOAD_SF
        bf16_t* Y = wsp<bf16_t>(F, (T.chain >> 4) ? OFF_YB : OFF_YF);
        store_tm(y, wl + SL_A, l32, h);
        { const int ln = launder(lane);
#pragma unroll
          for (int i = 0; i < 8; ++i) { const int q = ln + 64 * i, t = q >> 3, c8 = q & 7;
              *(u32x4*)(Y + (size_t)(T.r0 + T.sgn * t) * 512 + T.h * 64 + c8 * 8) = *(const LAS u32x4*)(wl + SL_A + swz(t, c8)); } }
#pragma unroll
        for (int i = 0; i < 7; ++i) asm volatile("" :: "v"(tch[i]));
    }
}
DI void rwkv_out_rows(const Frame& F, int l, int r_begin) {
    const int gw = F.bid * 8 + F.wid, nw = F.G * 8, lane = F.lane, c0 = 8 * lane;
    const bf16_t* RR = wsp<bf16_t>(F, OFF_RR); const bf16_t* RK = wsp<bf16_t>(F, OFF_RK); const bf16_t* RV = wsp<bf16_t>(F, OFF_RV);
    const bf16_t* AF = wsp<bf16_t>(F, OFF_AF); const bf16_t* AB = wsp<bf16_t>(F, OFF_AB); const bf16_t* GG = wsp<bf16_t>(F, OFF_GG);
    bf16_t* YF = wsp<bf16_t>(F, OFF_YF); const bf16_t* YB = wsp<bf16_t>(F, OFF_YB);
    float ka[8], rk[8], gw_[8], gb_[8];
#pragma unroll
    for (int e = 0; e < 8; ++e) { ka[e] = F.in[I_KA][(size_t)l * 512 + c0 + e]; rk[e] = F.in[I_RK][(size_t)l * 512 + c0 + e]; gw_[e] = F.in[I_GNW][(size_t)l * 512 + c0 + e]; gb_[e] = F.in[I_GNB][(size_t)l * 512 + c0 + e]; }
    for (int ra = r_begin + gw; ra < MROWS; ra += 2 * nw) {
        const bool two = ra + nw < MROWS; u32x4 w[2][8];
#pragma unroll
        for (int q = 0; q < 2; ++q) { const size_t ro = (size_t)(q && two ? ra + nw : ra) * 512 + c0;
            w[q][0] = *(const u32x4*)(YF + ro); w[q][1] = *(const u32x4*)(YB + ro); w[q][2] = *(const u32x4*)(RR + ro); w[q][3] = *(const u32x4*)(RK + ro); w[q][4] = *(const u32x4*)(RV + ro);
            w[q][5] = *(const u32x4*)(AF + ro); w[q][6] = *(const u32x4*)(AB + ro); w[q][7] = *(const u32x4*)(GG + ro); }
#pragma unroll
        for (int q = 0; q < 2; ++q) { if (q && !two) break;
            const size_t ro = (size_t)(q ? ra + nw : ra) * 512 + c0; float yf[8], yb[8], y[8], rr[8], k[8], v[8], af[8], ab[8], g[8];
            unpack8(w[q][0], yf); unpack8(w[q][1], yb); unpack8(w[q][2], rr); unpack8(w[q][3], k); unpack8(w[q][4], v); unpack8(w[q][5], af); unpack8(w[q][6], ab); unpack8(w[q][7], g);
            float s = 0.f;
#pragma unroll
            for (int e = 0; e < 8; ++e) { y[e] = yf[e] + yb[e]; s += y[e]; }
            const float mean = sum8(s) * (1.0f / 64.0f); float qq = 0.f, cf = 0.f;
#pragma unroll
            for (int e = 0; e < 8; ++e) { const float d = y[e] - mean; qq += d * d; const float kmf = k[e] * (1.0f + (af[e] - 1.0f) * ka[e]), kmb = k[e] * (1.0f + (ab[e] - 1.0f) * ka[e]); cf += rr[e] * (kmf + kmb) * rk[e]; }
            const float rstd = rsqrtf(sum8(qq) * (1.0f / 64.0f) + 64e-5f); cf = sum8(cf);
            float o[8];
#pragma unroll
            for (int e = 0; e < 8; ++e) o[e] = ((y[e] - mean) * rstd * gw_[e] + gb_[e] + cf * v[e]) * g[e];
            *(u32x4*)(YF + ro) = pack8(o); }
    }
}

struct RouteRec { int e0, e1; float g0, g1; int s0, s1; int pad0, pad1; };
DI void route_phase(const Frame& F, int l, int r_begin) {
    LAS int* hist = (LAS int*)(F.lds);
    if (F.tid < 32) hist[F.tid] = 0;
    __syncthreads();
    const float* lg = wsp<const float>(F, OFF_LOGITS); RouteRec* rec = wsp<RouteRec>(F, OFF_ROUTE);
    { int* st = wsp<int>(F, OFF_SLOTTOK); for (int i = F.bid * 512 + F.tid; i < PMAX; i += F.G * 512) st[i] = 0; }
    for (int tok = r_begin + F.bid * 512 + F.tid; tok < MROWS; tok += F.G * 512) {
        const float* p = lg + (size_t)tok * 64; const f32x4 g4 = *(const f32x4*)p;
        int grp = 0; float mx = g4[0];
#pragma unroll
        for (int i = 1; i < 4; ++i) if (g4[i] > mx) { mx = g4[i]; grp = i; }
        float den = 0.f;
#pragma unroll
        for (int i = 0; i < 4; ++i) den += __expf(g4[i] - mx);
        const float pg = 1.0f / den;
        const f32x4 ea = *(const f32x4*)(p + 4 + grp * 8), eb = *(const f32x4*)(p + 8 + grp * 8); float le[8] = {ea[0], ea[1], ea[2], ea[3], eb[0], eb[1], eb[2], eb[3]};
        int i1 = 0; float v1 = le[0];
#pragma unroll
        for (int i = 1; i < 8; ++i) if (le[i] > v1) { v1 = le[i]; i1 = i; }
        int i2 = -1; float v2 = -3.0e38f;
#pragma unroll
        for (int i = 0; i < 8; ++i) if (i != i1 && le[i] > v2) { v2 = le[i]; i2 = i; }
        const float ex = __expf(v2 - v1), w1 = 1.0f / (1.0f + ex), w2 = ex * w1;
        RouteRec rc; rc.e0 = grp * 8 + i1; rc.e1 = grp * 8 + i2; rc.g0 = pg * w1; rc.g1 = pg * w2; rc.s0 = 0; rc.s1 = 0; rc.pad0 = 0; rc.pad1 = 0;
        rec[tok] = rc;
        __hip_atomic_fetch_add(&hist[rc.e0], 1, __ATOMIC_RELAXED, __HIP_MEMORY_SCOPE_WORKGROUP); __hip_atomic_fetch_add(&hist[rc.e1], 1, __ATOMIC_RELAXED, __HIP_MEMORY_SCOPE_WORKGROUP);
    }
    __syncthreads();
    if (F.tid < 32 && hist[F.tid]) atomicAdd(wsp<int>(F, OFF_CTL) + CW_CNT + l * 32 + F.tid, hist[F.tid]);
}
template <class Order> DI void route_own(const Frame& F, int l, const Order& S) {
    LAS int* hist = (LAS int*)(F.lds);
    if (F.tid < 32) hist[F.tid] = 0;
    __syncthreads();
    const float* lg = wsp<const float>(F, OFF_LOGITS); RouteRec* rec = wsp<RouteRec>(F, OFF_ROUTE);
    { int* st = wsp<int>(F, OFF_SLOTTOK); for (int i = F.bid * 512 + F.tid; i < PMAX; i += F.G * 512) st[i] = 0; }
    pg8::Unit u_;
    for (int ui_ = 0; S.next(ui_, u_); ++ui_) { if (F.tid >= 256) continue; const int tok = u_.pm * 256 + F.tid; {
        const float* p = lg + (size_t)tok * 64; const f32x4 g4 = *(const f32x4*)p;
        int grp = 0; float mx = g4[0];
#pragma unroll
        for (int i = 1; i < 4; ++i) if (g4[i] > mx) { mx = g4[i]; grp = i; }
        float den = 0.f;
#pragma unroll
        for (int i = 0; i < 4; ++i) den += __expf(g4[i] - mx);
        const float pg = 1.0f / den;
        const f32x4 ea = *(const f32x4*)(p + 4 + grp * 8), eb = *(const f32x4*)(p + 8 + grp * 8); float le[8] = {ea[0], ea[1], ea[2], ea[3], eb[0], eb[1], eb[2], eb[3]};
        int i1 = 0; float v1 = le[0];
#pragma unroll
        for (int i = 1; i < 8; ++i) if (le[i] > v1) { v1 = le[i]; i1 = i; }
        int i2 = -1; float v2 = -3.0e38f;
#pragma unroll
        for (int i = 0; i < 8; ++i) if (i != i1 && le[i] > v2) { v2 = le[i]; i2 = i; }
        const float ex = __expf(v2 - v1), w1 = 1.0f / (1.0f + ex), w2 = ex * w1;
        RouteRec rc; rc.e0 = grp * 8 + i1; rc.e1 = grp * 8 + i2; rc.g0 = pg * w1; rc.g1 = pg * w2; rc.s0 = 0; rc.s1 = 0; rc.pad0 = 0; rc.pad1 = 0;
        rec[tok] = rc;
        __hip_atomic_fetch_add(&hist[rc.e0], 1, __ATOMIC_RELAXED, __HIP_MEMORY_SCOPE_WORKGROUP); __hip_atomic_fetch_add(&hist[rc.e1], 1, __ATOMIC_RELAXED, __HIP_MEMORY_SCOPE_WORKGROUP);
    } }
    __syncthreads();
    if (F.tid < 32 && hist[F.tid]) atomicAdd(wsp<int>(F, OFF_CTL) + CW_CNT + l * 32 + F.tid, hist[F.tid]);
}
DI void build_tab(const Frame& F, int l, LAS int* tab) {
    if (F.tid < 64) { const int* cnt = wsp<int>(F, OFF_CTL) + CW_CNT + l * 32; const int lane = F.tid;
        int v = lane < 32 ? ((__hip_atomic_load(cnt + lane, __ATOMIC_RELAXED, __HIP_MEMORY_SCOPE_AGENT) + 255) >> 8) : 0;
        int inc = v;
#pragma unroll
        for (int sft = 1; sft < 32; sft <<= 1) { const int o = __shfl_up(inc, sft); if (lane >= sft) inc += o; }
        if (lane < 32) tab[lane] = inc - v;
        if (lane == 31) tab[32] = inc; }
    __syncthreads();
}
DI void assign_gather_phase(const Frame& F, int l, int r_begin) {
    LAS int* tab = (LAS int*)(F.lds + MISC_OFF + 64); LAS int* lcnt = tab + 40; LAS int* gbase = lcnt + 32;
    build_tab(F, l, tab);
    if (F.tid < 32) lcnt[F.tid] = 0;
    __syncthreads();
    const int per = (MROWS - r_begin + F.G - 1) / F.G, t0 = r_begin + F.bid * per, t1 = min(MROWS, t0 + per);
    RouteRec* rec = wsp<RouteRec>(F, OFF_ROUTE);
    int e0 = 0, e1 = 0, r0 = 0, r1 = 0; const int tok = t0 + F.tid; const bool act = tok < t1;
    if (act) { e0 = rec[tok].e0; e1 = rec[tok].e1; r0 = __hip_atomic_fetch_add(&lcnt[e0], 1, __ATOMIC_RELAXED, __HIP_MEMORY_SCOPE_WORKGROUP); r1 = __hip_atomic_fetch_add(&lcnt[e1], 1, __ATOMIC_RELAXED, __HIP_MEMORY_SCOPE_WORKGROUP); }
    __syncthreads();
    if (F.tid < 32) { const int n = lcnt[F.tid]; gbase[F.tid] = tab[F.tid] * 256 + (n ? atomicAdd(wsp<int>(F, OFF_CTL) + CW_CUR + l * 32 + F.tid, n) : 0); }
    __syncthreads();
    if (act) { const int s0 = gbase[e0] + r0, s1 = gbase[e1] + r1; rec[tok].s0 = s0; rec[tok].s1 = s1; int* st = wsp<int>(F, OFF_SLOTTOK); st[s0] = tok; st[s1] = tok; }
}
template <bool NEXT>
DI void combine_rows(const Frame& F, int l, int r_begin, const float* gn, bf16_t* xn) {
    const int gw = F.bid * 8 + F.wid, nw = F.G * 8;
    const RouteRec* rec = wsp<RouteRec>(F, OFF_ROUTE); const bf16_t* YB = wsp<bf16_t>(F, OFF_YBUF); float* ctxb = wsp<float>(F, OFF_CTX);
    for (int r = r_begin + gw; r < MROWS; r += nw) {
        const RouteRec rc = rec[r]; const int cond = row_cond(r); const float* gate = modp(F, l, cond, 5);
        float* xr = r < NCTX ? ctxb + (size_t)r * DM : F.out + (size_t)(r - NCTX) * DM;
        f32x4 xv[2][2]; float ss = 0.f;
        u32x4 wy0[2], wy1[2]; f32x4 xa_[2], xb_[2], ga_[2], gb_[2], g4_[2][2], s4_[2][2], c4_[2][2];
        const float* sh = modp(F, l + 1, cond, 0); const float* sc = modp(F, l + 1, cond, 1);
#pragma unroll
        for (int j = 0; j < 2; ++j) { const int c0 = 8 * F.lane + 512 * j;
            wy0[j] = *(const u32x4*)(YB + (size_t)rc.s0 * DM + c0); wy1[j] = *(const u32x4*)(YB + (size_t)rc.s1 * DM + c0);
            xa_[j] = *(const f32x4*)(xr + c0); xb_[j] = *(const f32x4*)(xr + c0 + 4); ga_[j] = *(const f32x4*)(gate + c0); gb_[j] = *(const f32x4*)(gate + c0 + 4);
            if (NEXT) {
#pragma unroll
                for (int q = 0; q < 2; ++q) { g4_[j][q] = *(const f32x4*)(gn + c0 + 4 * q); s4_[j][q] = *(const f32x4*)(sh + c0 + 4 * q); c4_[j][q] = *(const f32x4*)(sc + c0 + 4 * q); } } }
#pragma unroll
        for (int j = 0; j < 2; ++j) { const int c0 = 8 * F.lane + 512 * j; float y0[8], y1[8];
            unpack8(wy0[j], y0); unpack8(wy1[j], y1);
            f32x4 xa = xa_[j], xb = xb_[j]; const f32x4 ga = ga_[j], gb = gb_[j];
#pragma unroll
            for (int e = 0; e < 4; ++e) { xa[e] += ga[e] * (rc.g0 * y0[e] + rc.g1 * y1[e]); xb[e] += gb[e] * (rc.g0 * y0[4 + e] + rc.g1 * y1[4 + e]); }
            *(f32x4*)(xr + c0) = xa; *(f32x4*)(xr + c0 + 4) = xb;
            if (NEXT) { xv[j][0] = xa; xv[j][1] = xb;
#pragma unroll
                for (int e = 0; e < 4; ++e) ss += xa[e] * xa[e] + xb[e] * xb[e]; } }
        if (NEXT) {
            ss = wave_sum(ss); const float inv = rsqrtf(ss * (1.0f / DM) + 1e-6f);
#pragma unroll
            for (int j = 0; j < 2; ++j) { const int c0 = 8 * F.lane + 512 * j; float o[8];
#pragma unroll
                for (int q = 0; q < 2; ++q) { const f32x4 g4 = g4_[j][q], s4 = s4_[j][q], c4 = c4_[j][q];
#pragma unroll
                    for (int e = 0; e < 4; ++e) o[4 * q + e] = (xv[j][q][e] * inv * g4[e]) * (1.0f + c4[e]) + s4[e]; }
                *(u32x4*)(xn + (size_t)r * DM + c0) = pack8(o); }
        }
    }
}

constexpr int PH_PER_LAYER = 19, N_PHASES = 1 + 2 * PH_PER_LAYER;
#if MK_ONE_LAUNCH
#define GRID_BAR() xcd_barrier(bar)
#else
#define GRID_BAR() do { } while (0)
#endif
#ifndef PH_MASK
#define PH_MASK 0xFFFFFFFFu
#endif
#define PON(j) (((PH_MASK) >> (j)) & 1u)
#ifndef REP_MASK
#define REP_MASK 0u
#endif
#define REPEAT(j) for (int rep_ = 0; rep_ < 1 + (int)(((REP_MASK) >> (j)) & 1u); ++rep_)
#define IN(k) (lo <= (k) && (k) < hi)
#define SEAM(k) do { if (IN((k) + 1)) GRID_BAR(); } while (0)
template <int l, class BarT>
DI void layer_phases(const Frame& F0, const int lo, const int hi, const BarT& bar) {
        const Frame& F = F0;
        constexpr bool LAST = (l == EN_LAYERS - 1);
        constexpr int RB = LAST ? NCTX : 0, PM0 = LAST ? 2 : 0; constexpr size_t WO = (l & 1) ? WDELTA : 0;
        const int pb = 1 + l * PH_PER_LAYER;
        const float* xlat = l == 0 ? F.in[I_X] : F.out;
        const float* modl = wsp<const float>(F, OFF_MOD) + (size_t)l * 3 * 6144;
        if (PON(0) && IN(pb + 0)) { const Frame F = phase_frame(F0); REPEAT(0) {  if (l == 0) norm_rows(F, xlat, F.in[I_N1G] + (size_t)l * DM, l, 0, 1, wsp<bf16_t>(F, OFF_XNM));  } if (l == 0) SEAM(pb + 0); }
        if (PON(1) && IN(pb + 1)) { const Frame F = phase_frame(F0); REPEAT(1) {  pg8::Gemm g{wsp<bf16_t>(F, OFF_XNM), wsp<bf16_t>(F, OFF_WIN + WO), DM, nullptr, nullptr}; pg8::StaticOrder S; S.init(MROWS, N_INP, F.G, F.bid); EpiInproj E{F.ws};
            pg8::gemm_phase(F.lds, g, S, E, F.tid);
            if constexpr (!LAST) {
                const int nwg_ = (MROWS / 256) * (N_INP / 256), extra_ = nwg_ % F.G;
                if (F.bid >= extra_) { asm volatile("s_waitcnt vmcnt(0)" ::: "memory"); __syncthreads(); Frame F2 = F; F2.bid = F.bid - extra_; F2.G = F.G - extra_; conv_small_weights(F2, l + 1); } }  } SEAM(pb + 1); }
        if (PON(2) && IN(pb + 2)) { const Frame F = phase_frame(F0); REPEAT(2) {  phaseC_rows(F, l);  } SEAM(pb + 2); }
        if (PON(3) && IN(pb + 3)) { const Frame F = phase_frame(F0); REPEAT(3) {  pg8::Gemm g{wsp<bf16_t>(F, OFF_ALORA), wsp<bf16_t>(F, OFF_WLORA + WO), LORA_K, nullptr, nullptr}; pg8::StaticOrder S; S.init(MROWS, LORA_N, F.G, F.bid);
            EpiLora E{F.ws, F.in[I_DW0] + (size_t)l * 1024, F.in[I_AA0] + (size_t)l * 1024};
            pg8::gemm_phase(F.lds, g, S, E, F.tid); asm volatile("s_waitcnt vmcnt(0)" ::: "memory"); __syncthreads(); phaseC_vt(F, wsp<int>(F, OFF_CTL) + CW_DYN + 2 + l);  } SEAM(pb + 3); }
        if (PON(4) && IN(pb + 4)) { const Frame F = phase_frame(F0); REPEAT(4) {  attn_phase(F, l, LAST ? 512 : 520);  } SEAM(pb + 4); }
        if (PON(5) && IN(pb + 5)) { const Frame F = phase_frame(F0); REPEAT(5) {  scan_pass1(F, l);  } SEAM(pb + 5); }
        if (PON(6) && IN(pb + 6)) { const Frame F = phase_frame(F0); REPEAT(6) {  scan_pass2(F, l);  } SEAM(pb + 6); }
        if (PON(7) && IN(pb + 7)) { const Frame F = phase_frame(F0); REPEAT(7) {  scan_pass3(F, l);  } SEAM(pb + 7); }
        if (PON(8) && IN(pb + 8)) { const Frame F = phase_frame(F0); REPEAT(8) {  rwkv_out_rows(F, l, RB);  } SEAM(pb + 8); }
        if (PON(9) && IN(pb + 9)) { const Frame F = phase_frame(F0); REPEAT(9) {  pg8::Gemm g{wsp<bf16_t>(F, OFF_XNM), wsp<bf16_t>(F, OFF_WIN + WO) + (size_t)N_INP * DM, DM, nullptr, nullptr}; pg8::StaticOrder S; S.init(MROWS, N_GATE, F.G, F.bid, PM0); EpiGates E{wsp<bf16_t>(F, OFF_G)};
            pg8::gemm_phase(F.lds, g, S, E, F.tid);  } SEAM(pb + 9); }
        if (PON(10) && IN(pb + 10)) { const Frame F = phase_frame(F0); REPEAT(10) {
            pg8::Gemm g{wsp<bf16_t>(F, OFF_PDIFF), wsp<bf16_t>(F, OFF_WMG + WO), 1536, wsp<bf16_t>(F, OFF_POOL), wsp<bf16_t>(F, OFF_YF)}; pg8::StaticOrder S; S.init(MROWS, DM, F.G, F.bid, PM0);
            EpiMerge E{wsp<bf16_t>(F, OFF_G), wsp<bf16_t>(F, OFF_MERGED)};
            pg8::gemm_phase(F.lds, g, S, E, F.tid); } SEAM(pb + 10); }
        if (PON(11) && IN(pb + 11)) { const Frame F = phase_frame(F0); REPEAT(11) {  pg8::Gemm g{wsp<bf16_t>(F, OFF_MERGED), wsp<bf16_t>(F, OFF_WOUT + WO), DM, nullptr, nullptr}; pg8::StaticOrder S; S.init(MROWS, DM, F.G, F.bid, PM0); EpiResid E{xlat, F.out, wsp<float>(F, OFF_CTX), modl};
            conv_router_weights(F, l);
            pg8::gemm_phase(F.lds, g, S, E, F.tid);  } SEAM(pb + 11); }
#if EN_MOE
        if (PON(13) && IN(pb + 13)) { const Frame F = phase_frame(F0); REPEAT(13) {  pg8::Gemm g{wsp<bf16_t>(F, OFF_XN), wsp<bf16_t>(F, OFF_WRT), DM, nullptr, nullptr}; pg8::StaticOrder S; S.init(MROWS, 256, F.G, F.bid, PM0); EpiLogits E{wsp<float>(F, OFF_LOGITS)};
            { pg8::Unit un_; for (int ui_ = 0; S.next(ui_, un_); ++ui_) norm_rows(F, F.out, F.in[I_N2G] + (size_t)l * DM, l, 3, 4, wsp<bf16_t>(F, OFF_XN), un_.pm * 256, un_.pm * 256 + 256, true); }
            asm volatile("s_waitcnt vmcnt(0)" ::: "memory"); __syncthreads();
            pg8::gemm_phase(F.lds, g, S, E, F.tid); asm volatile("s_waitcnt vmcnt(0)" ::: "memory"); __syncthreads(); route_own(F, l, S); __syncthreads(); conv_expert_weights(F, l, 0); __syncthreads(); conv_expert_weights(F, l, 1);  } SEAM(pb + 13); }
        if (PON(15) && IN(pb + 15)) { const Frame F = phase_frame(F0); REPEAT(15) {  assign_gather_phase(F, l, RB);  } SEAM(pb + 15); }
        if (PON(16) && IN(pb + 16)) { const Frame F = phase_frame(F0); REPEAT(16) {  LAS int* tab = (LAS int*)(F.lds + MISC_OFF + 64); build_tab(F, l, tab);
            pg8::Gemm g{wsp<bf16_t>(F, OFF_XN), wsp<bf16_t>(F, OFF_WE1), DM, nullptr, nullptr}; pg8::MoeOrder<true> S{tab, 4, F.G, F.bid, wsp<int>(F, OFF_SLOTTOK)}; EpiAct E{wsp<bf16_t>(F, OFF_ACT)};
            pg8::gemm_phase(F.lds, g, S, E, F.tid);  } SEAM(pb + 16); }
        if (PON(17) && IN(pb + 17)) { const Frame F = phase_frame(F0); REPEAT(17) {  LAS int* tab = (LAS int*)(F.lds + MISC_OFF + 64); build_tab(F, l, tab);
            pg8::Gemm g{wsp<bf16_t>(F, OFF_ACT), wsp<bf16_t>(F, OFF_WE2), FF, nullptr, nullptr}; pg8::MoeOrder<false> S{tab, 4, F.G, F.bid, nullptr}; EpiY E{wsp<bf16_t>(F, OFF_YBUF)};
            pg8::gemm_phase(F.lds, g, S, E, F.tid);  } SEAM(pb + 17); }
        if (PON(18) && IN(pb + 18)) { const Frame F = phase_frame(F0); REPEAT(18) {  if constexpr (!LAST) { combine_rows<true>(F, l, RB, F.in[I_N1G] + (size_t)(l + 1) * DM, wsp<bf16_t>(F, OFF_XNM)); } else combine_rows<false>(F, l, RB, nullptr, nullptr);  } SEAM(pb + 18); }
#endif
}
__global__ void __launch_bounds__(512, 2) fwd(Args args) {
    extern __shared__ __attribute__((aligned(16))) unsigned char lds_raw[];
    Frame F0; F0.in = (kain_t)__builtin_amdgcn_kernarg_segment_ptr(); F0.out = args.out; F0.ws = args.ws; F0.lds = (LAS unsigned char*)lds_raw;
    F0.tid = threadIdx.x; F0.lane = F0.tid & 63; F0.wid = __builtin_amdgcn_readfirstlane(F0.tid >> 6); F0.G = gridDim.x; F0.bid = blockIdx.x;
    volatile LAS unsigned* MISC = (volatile LAS unsigned*)(F0.lds + MISC_OFF);
    if (F0.tid < 4) MISC[F0.tid] = 0u;
    __syncthreads();
#if MK_ONE_LAUNCH
    const XcdBarrier bar = xcd_barrier_post((unsigned*)(F0.ws + OFF_CTL) + CW_BAR, MISC);
#else
    const int bar = 0;
#endif
    const int lo = args.ph_lo, hi = args.ph_hi;
    if (PON(31) && IN(0)) { const Frame F = phase_frame(F0); p0_prologue(F); SEAM(0); }
    layer_phases<0>(F0, lo, hi, bar);
#if EN_LAYERS > 1
    layer_phases<1>(F0, lo, hi, bar);
#endif
}

extern "C" void kernel_launch(void* const* d_in, const int* in_sizes, int n_in, void* d_out, int out_size, void* d_ws, size_t ws_size, hipStream_t stream) {
    static int grid = 0;
    if (grid == 0) {
        if (n_in != 33 || out_size != NB * SEQ * DM || ws_size < WS_END) { fprintf(stderr, "kernel_launch: unexpected shapes (n_in %d out %d ws %zu need %zu)\n", n_in, out_size, ws_size, (size_t)WS_END); grid = -1; return; }
        int dev = 0, cus = 0, per_cu = 0;
        if (hipGetDevice(&dev) != hipSuccess || hipDeviceGetAttribute(&cus, hipDeviceAttributeMultiprocessorCount, dev) != hipSuccess) { grid = -1; return; }
        if (hipFuncSetAttribute((const void*)fwd, hipFuncAttributeMaxDynamicSharedMemorySize, LDS_BYTES) != hipSuccess) { fprintf(stderr, "kernel_launch: hipFuncSetAttribute failed\n"); grid = -1; return; }
        if (hipOccupancyMaxActiveBlocksPerMultiprocessor(&per_cu, (const void*)fwd, 512, LDS_BYTES) != hipSuccess || per_cu < 1) { fprintf(stderr, "kernel_launch: occupancy query says %d\n", per_cu); }
        (void)hipGetLastError();
        grid = cus;
    }
    if (grid < 0) return;
    (void)hipMemsetAsync((char*)d_ws + OFF_CTL, 0, 65536, stream);
    Args a{};
    for (int i = 0; i < 33; ++i) a.in[i] = (const float*)d_in[i];
    a.out = (float*)d_out; a.ws = (unsigned char*)d_ws;
#if MK_ONE_LAUNCH
    a.ph_lo = 0; a.ph_hi = N_PHASES;
    hipLaunchKernelGGL(fwd, dim3(grid), dim3(512), LDS_BYTES, stream, a);
#else
    for (int p = 0; p < N_PHASES; ++p) {
        if (p >= 1 + EN_LAYERS * PH_PER_LAYER) break;
#if !EN_MOE
        if (p >= 1 && ((p - 1) % PH_PER_LAYER) >= 12) continue;
#endif
        a.ph_lo = p; a.ph_hi = p + 1;
        hipLaunchKernelGGL(fwd, dim3(grid), dim3(512), LDS_BYTES, stream, a);
    }
#endif
}
```
